# Optimizing an MI355X kernel written in HIP

```python
import math
import numpy as np
import jax
import jax.numpy as jnp
from jax import lax

D_MODEL = 1024
BATCH = 2
SEQ = 8192
DEPTH = 2

GRID_W = 64
CTX_LEN = 256
HEAD_DIM = 64
ATTN_SCALE = HEAD_DIM ** -0.5
ROPE_THETA = 10000.0
Q_BLOCK = 128
NA_HEADS = 8
NA_KH = 8
NA_KW = 16
NA_QCB = 8
NA_KCB = NA_QCB + NA_KW
DIFF_HEADS = 4
GQA_HEADS = 8
GQA_KV_HEADS = 2
SWA_HEADS = 8
SWA_KV_HEADS = 2
SWA_WINDOW = 128
N_EXPERTS = 32
TOP_K = 4
D_EXPERT = D_MODEL
SWIGLU_LIMIT = 7.0
SWIGLU_ALPHA = 1.702
MOE_BLOCK = 256
N_EVEN = (DEPTH + 1) // 2
N_ODD = DEPTH // 2
AB_COLS = 3 * NA_HEADS * HEAD_DIM + 3 * DIFF_HEADS * 2 * HEAD_DIM
CD_COLS = (GQA_HEADS + 2 * GQA_KV_HEADS + SWA_HEADS + 2 * SWA_KV_HEADS) * HEAD_DIM
DEEPNORM_ALPHA = (2.0 * DEPTH) ** 0.25
DEEPNORM_BETA = (8.0 * DEPTH) ** -0.25
LN_EPS = 1e-5
RMS_EPS = 1e-6
NEG_INF = -1e30

kernel_name = 'hybrid_natten_diff_gqa_swa_moe_dit'


def _layernorm(x, g, b):
    xf = x.astype(jnp.float32)
    mu = jnp.mean(xf, axis=-1, keepdims=True)
    var = jnp.mean(jnp.square(xf - mu), axis=-1, keepdims=True)
    return ((xf - mu) * lax.rsqrt(var + LN_EPS) * g + b).astype(x.dtype)


def _rmsnorm(x, g):
    xf = x.astype(jnp.float32)
    return (xf * lax.rsqrt(jnp.mean(xf * xf, axis=-1, keepdims=True) + RMS_EPS) * g).astype(x.dtype)


def _axial_rope_tables(n_tokens):
    t = jnp.arange(n_tokens, dtype=jnp.int32)
    row = (t // GRID_W).astype(jnp.float32)
    col = (t % GRID_W).astype(jnp.float32)
    axis_dim = HEAD_DIM // 2
    freqs = ROPE_THETA ** (-jnp.arange(0, axis_dim, 2, dtype=jnp.float32) / axis_dim)
    ang = jnp.concatenate([row[:, None] * freqs, col[:, None] * freqs], axis=-1)
    return jnp.cos(ang), jnp.sin(ang)


def _apply_rope(x, cos, sin):
    xf = x.astype(jnp.float32).reshape(x.shape[:-1] + (-1, 2))
    x0, x1 = xf[..., 0], xf[..., 1]
    out = jnp.stack([x0 * cos - x1 * sin, x0 * sin + x1 * cos], axis=-1)
    return out.reshape(x.shape).astype(x.dtype)


def _to_heads(t, n_heads):
    return t.reshape(t.shape[0], t.shape[1], n_heads, -1).transpose(0, 2, 1, 3)


def _to_gqa_q(t, n_kv, group):
    return t.reshape(t.shape[0], t.shape[1], n_kv, group, -1).transpose(0, 2, 3, 1, 4)


def _merge_heads(t):
    return t.transpose(0, 2, 1, 3).reshape(t.shape[0], t.shape[2], -1)


def _merge_gqa(t):
    return t.transpose(0, 3, 1, 2, 4).reshape(t.shape[0], t.shape[3], -1)


def _sweep_query_blocks(fn, *qs):
    s = qs[0].shape[-2]
    nb = s // Q_BLOCK
    blocks = tuple(jnp.moveaxis(q.reshape(q.shape[:-2] + (nb, Q_BLOCK, q.shape[-1])), -3, 0) for q in qs)
    out = lax.map(lambda bs: fn(*bs), blocks)
    out = jnp.moveaxis(out, 0, -3)
    return out.reshape(out.shape[:-3] + (s, out.shape[-1]))


def _attend(q, k, v, sink=None):
    s = jnp.einsum('bhgqd,bhkd->bhgqk', q, k).astype(jnp.float32) * ATTN_SCALE
    if sink is not None:
        sk = jnp.broadcast_to(sink[None, :, :, None, None].astype(jnp.float32), s.shape[:-1] + (1,))
        p = jax.nn.softmax(jnp.concatenate([s, sk], axis=-1), axis=-1)[..., :-1]
    else:
        p = jax.nn.softmax(s, axis=-1)
    return jnp.einsum('bhgqk,bhkd->bhgqd', p.astype(v.dtype), v)


def _diff_attend(q1, q2, k1, k2, v, lam):
    s1 = jnp.einsum('bhqd,bhkd->bhqk', q1, k1).astype(jnp.float32) * ATTN_SCALE
    s2 = jnp.einsum('bhqd,bhkd->bhqk', q2, k2).astype(jnp.float32) * ATTN_SCALE
    w = jax.nn.softmax(s1, axis=-1) - lam * jax.nn.softmax(s2, axis=-1)
    return jnp.einsum('bhqk,bhkv->bhqv', w.astype(v.dtype), v)


def _na_tables(rows):
    kh = min(NA_KH, rows)
    ncb = GRID_W // NA_QCB
    blk_start = np.clip(np.arange(ncb) * NA_QCB - NA_KW // 2, 0, GRID_W - NA_KCB)
    kcol = blk_start[:, None] + np.arange(NA_KCB)[None, :]
    qcol = np.arange(ncb)[:, None] * NA_QCB + np.arange(NA_QCB)[None, :]
    ws = np.clip(qcol - NA_KW // 2, 0, GRID_W - NA_KW)
    valid = (kcol[:, None, :] >= ws[:, :, None]) & (kcol[:, None, :] < ws[:, :, None] + NA_KW)
    dc_idx = np.clip(kcol[:, None, :] - qcol[:, :, None] + NA_KW - 1, 0, 2 * NA_KW - 2)
    mask = np.broadcast_to(valid[:, :, None, :], (ncb, NA_QCB, kh, NA_KCB)).reshape(ncb, NA_QCB, kh * NA_KCB)
    return kh, ncb, kcol, mask, dc_idx


def _neighbourhood_attend(q, k, v, kc, vc, rpb):
    b, nh, s, d = q.shape
    rows = s // GRID_W
    kh, ncb, kcol, mask, dc_idx = _na_tables(rows)
    n_ctx = kc.shape[2]
    qg = q.reshape(b, nh, rows, GRID_W, d)
    kg = k.reshape(b, nh, rows, GRID_W, d)
    vg = v.reshape(b, nh, rows, GRID_W, d)

    def row_fn(r):
        rs = jnp.clip(r - kh // 2, 0, rows - kh)
        q_r = lax.dynamic_index_in_dim(qg, r, axis=2, keepdims=False).reshape(b, nh, ncb, NA_QCB, d)

        def gather(t):
            t_rows = lax.dynamic_slice_in_dim(t, rs, kh, axis=2)
            t_blk = t_rows[:, :, :, kcol]
            return t_blk.transpose(0, 1, 3, 2, 4, 5).reshape(b, nh, ncb, kh * NA_KCB, d)

        kb, vb = gather(kg), gather(vg)
        dr_idx = rs + jnp.arange(kh) - r + NA_KH - 1
        bias = jnp.take(rpb, dr_idx, axis=1)[:, :, dc_idx]
        bias = bias.transpose(0, 2, 3, 1, 4).reshape(nh, ncb, NA_QCB, kh * NA_KCB)
        s_win = jnp.einsum('bhjqd,bhjkd->bhjqk', q_r, kb).astype(jnp.float32) * ATTN_SCALE + bias.astype(jnp.float32)
        s_win = jnp.where(mask, s_win, NEG_INF)
        s_ctx = jnp.einsum('bhjqd,bhkd->bhjqk', q_r, kc).astype(jnp.float32) * ATTN_SCALE
        p = jax.nn.softmax(jnp.concatenate([s_ctx, s_win], axis=-1), axis=-1)
        out = (jnp.einsum('bhjqk,bhkd->bhjqd', p[..., :n_ctx].astype(vc.dtype), vc)
               + jnp.einsum('bhjqk,bhjkd->bhjqd', p[..., n_ctx:].astype(vb.dtype), vb))
        return out.reshape(b, nh, GRID_W, d)

    out = lax.map(row_fn, jnp.arange(rows, dtype=jnp.int32))
    return out.transpose(1, 2, 0, 3, 4).reshape(b, nh, s, d)


def _window_attend(q, k, v, kc, vc, sink):
    b, nkv, grp, s, d = q.shape
    w = SWA_WINDOW
    nb = s // w
    n_ctx = kc.shape[2]
    qb = q.reshape(b, nkv, grp, nb, w, d)

    def band(t):
        tp = jnp.pad(t, ((0, 0), (0, 0), (w, w), (0, 0))).reshape(b, nkv, nb + 2, w, t.shape[-1])
        return jnp.concatenate([tp[:, :, :-2], tp[:, :, 1:-1], tp[:, :, 2:]], axis=3)

    kb, vb = band(k), band(v)
    qi = np.arange(w)[:, None]
    kj = np.arange(3 * w)[None, :]
    kpos = np.arange(nb)[:, None] * w - w + np.arange(3 * w)[None, :]
    mask = (np.abs(qi - kj + w) <= w)[None] & ((kpos >= 0) & (kpos < s))[:, None, :]
    s_band = jnp.einsum('bhgnqd,bhnkd->bhgnqk', qb, kb).astype(jnp.float32) * ATTN_SCALE
    s_band = jnp.where(mask, s_band, NEG_INF)
    s_ctx = jnp.einsum('bhgnqd,bhkd->bhgnqk', qb, kc).astype(jnp.float32) * ATTN_SCALE
    s_sink = jnp.broadcast_to(sink[None, :, :, None, None, None].astype(jnp.float32), s_band.shape[:-1] + (1,))
    p = jax.nn.softmax(jnp.concatenate([s_ctx, s_band, s_sink], axis=-1), axis=-1)
    out = (jnp.einsum('bhgnqk,bhkd->bhgnqd', p[..., :n_ctx].astype(vc.dtype), vc)
           + jnp.einsum('bhgnqk,bhnkd->bhgnqd', p[..., n_ctx:n_ctx + 3 * w].astype(vb.dtype), vb))
    return out.reshape(b, nkv, grp, s, d)


def _mix_ab(h, hc, cos, sin, w_in, w_out, rpb, lq1, lk1, lq2, lk2, subln, lam_init, ctx_out):
    na_w = NA_HEADS * HEAD_DIM
    df_w = DIFF_HEADS * 2 * HEAD_DIM
    cuts = [na_w, 2 * na_w, 3 * na_w, 3 * na_w + df_w, 3 * na_w + 2 * df_w]
    nq, nk, nv, dq, dk, dv = jnp.split(h @ w_in, cuts, axis=-1)
    nqc, nkc, nvc, dqc, dkc, dvc = jnp.split(hc @ w_in, cuts, axis=-1)
    nkc_h, nvc_h = _to_heads(nkc, NA_HEADS), _to_heads(nvc, NA_HEADS)
    y_na = _neighbourhood_attend(_to_heads(nq, NA_HEADS), _to_heads(nk, NA_HEADS), _to_heads(nv, NA_HEADS), nkc_h, nvc_h, rpb)

    def pair(t):
        t = _to_heads(t, 2 * DIFF_HEADS)
        t = t.reshape(t.shape[0], DIFF_HEADS, 2, t.shape[2], t.shape[3])
        return t[:, :, 0], t[:, :, 1]

    lam = (jnp.exp(jnp.sum(lq1.astype(jnp.float32) * lk1.astype(jnp.float32)))
           - jnp.exp(jnp.sum(lq2.astype(jnp.float32) * lk2.astype(jnp.float32))) + lam_init)
    q1, q2 = pair(dq)
    k1, k2 = pair(dk)
    q1, q2 = _apply_rope(q1, cos, sin), _apply_rope(q2, cos, sin)
    k1, k2 = _apply_rope(k1, cos, sin), _apply_rope(k2, cos, sin)
    k1c, k2c = pair(dkc)
    dvc_h = _to_heads(dvc, DIFF_HEADS)
    k1_all = jnp.concatenate([k1c, k1], axis=2)
    k2_all = jnp.concatenate([k2c, k2], axis=2)
    v_all = jnp.concatenate([dvc_h, _to_heads(dv, DIFF_HEADS)], axis=2)
    y_df = _sweep_query_blocks(lambda a, bq: _diff_attend(a, bq, k1_all, k2_all, v_all, lam), q1, q2)
    y_df = _rmsnorm(y_df, subln) * (1.0 - lam_init)
    y = jnp.concatenate([_merge_heads(y_na), _merge_heads(y_df)], axis=-1) @ w_out
    if not ctx_out:
        return y, None
    y_na_c = _attend(_to_heads(nqc, NA_HEADS)[:, :, None], nkc_h, nvc_h)[:, :, 0]
    q1c, q2c = pair(dqc)
    y_df_c = _rmsnorm(_diff_attend(q1c, q2c, k1c, k2c, dvc_h, lam), subln) * (1.0 - lam_init)
    yc = jnp.concatenate([_merge_heads(y_na_c), _merge_heads(y_df_c)], axis=-1) @ w_out
    return y, yc


def _mix_cd(h, hc, cos, sin, w_in, w_out, q_norm, k_norm, sink, ctx_out):
    sizes = [GQA_HEADS * HEAD_DIM, GQA_KV_HEADS * HEAD_DIM, GQA_KV_HEADS * HEAD_DIM,
             SWA_HEADS * HEAD_DIM, SWA_KV_HEADS * HEAD_DIM, SWA_KV_HEADS * HEAD_DIM]
    cuts = [int(v) for v in np.cumsum(sizes)[:-1]]
    gq, gk, gv, wq, wk, wv = jnp.split(h @ w_in, cuts, axis=-1)
    gqc, gkc, gvc, wqc, wkc, wvc = jnp.split(hc @ w_in, cuts, axis=-1)
    g_c = GQA_HEADS // GQA_KV_HEADS
    g_d = SWA_HEADS // SWA_KV_HEADS
    q = _apply_rope(_rmsnorm(_to_gqa_q(gq, GQA_KV_HEADS, g_c), q_norm), cos, sin)
    k = _apply_rope(_rmsnorm(_to_heads(gk, GQA_KV_HEADS), k_norm), cos, sin)
    kc = _rmsnorm(_to_heads(gkc, GQA_KV_HEADS), k_norm)
    vc = _to_heads(gvc, GQA_KV_HEADS)
    k_all = jnp.concatenate([kc, k], axis=2)
    v_all = jnp.concatenate([vc, _to_heads(gv, GQA_KV_HEADS)], axis=2)
    y_c = _sweep_query_blocks(lambda qb: _attend(qb, k_all, v_all), q)
    sink_d = sink.reshape(SWA_KV_HEADS, g_d)
    qd = _apply_rope(_to_gqa_q(wq, SWA_KV_HEADS, g_d), cos, sin)
    kd = _apply_rope(_to_heads(wk, SWA_KV_HEADS), cos, sin)
    kdc, vdc = _to_heads(wkc, SWA_KV_HEADS), _to_heads(wvc, SWA_KV_HEADS)
    y_d = _window_attend(qd, kd, _to_heads(wv, SWA_KV_HEADS), kdc, vdc, sink_d)
    y = jnp.concatenate([_merge_gqa(y_c), _merge_gqa(y_d)], axis=-1) @ w_out
    if not ctx_out:
        return y, None
    y_cc = _attend(_rmsnorm(_to_gqa_q(gqc, GQA_KV_HEADS, g_c), q_norm), kc, vc)
    y_dc = _attend(_to_gqa_q(wqc, SWA_KV_HEADS, g_d), kdc, vdc, sink_d)
    yc = jnp.concatenate([_merge_gqa(y_cc), _merge_gqa(y_dc)], axis=-1) @ w_out
    return y, yc


def _moe(x, router_w, router_b, w_in, b_in, w_out, b_out):
    n, d = x.shape
    logits = (x @ router_w).astype(jnp.float32) + router_b.astype(jnp.float32)
    top_val, top_idx = lax.top_k(logits, TOP_K)
    gates = jax.nn.softmax(top_val, axis=-1)
    nk = n * TOP_K
    flat_e = top_idx.reshape(-1).astype(jnp.int32)
    flat_tok = jnp.arange(nk, dtype=jnp.int32) // TOP_K
    order = jnp.argsort(flat_e)
    e_sorted = flat_e[order]
    tok_sorted = flat_tok[order]
    gate_sorted = gates.reshape(-1)[order]
    counts = jnp.zeros((N_EXPERTS,), jnp.int32).at[flat_e].add(1)
    padded = (counts + MOE_BLOCK - 1) // MOE_BLOCK * MOE_BLOCK
    start = jnp.cumsum(counts) - counts
    pend = jnp.cumsum(padded)
    pstart = pend - padded
    dest = pstart[e_sorted] + jnp.arange(nk, dtype=jnp.int32) - start[e_sorted]
    n_blocks = -(-nk // MOE_BLOCK) + N_EXPERTS
    slot_tok = jnp.full((n_blocks * MOE_BLOCK,), n, jnp.int32).at[dest].set(tok_sorted)
    block_e = jnp.clip(jnp.searchsorted(pend, jnp.arange(n_blocks, dtype=jnp.int32) * MOE_BLOCK, side='right'), 0, N_EXPERTS - 1)
    x_pad = jnp.concatenate([x, jnp.zeros((1, d), x.dtype)], axis=0)
    xb = x_pad[slot_tok].reshape(n_blocks, MOE_BLOCK, d)

    def expert_block(args):
        xs, e = args
        hh = xs @ w_in[e] + b_in[e]
        gate = jnp.minimum(hh[:, :D_EXPERT], SWIGLU_LIMIT)
        up = jnp.clip(hh[:, D_EXPERT:], -SWIGLU_LIMIT, SWIGLU_LIMIT)
        act = gate * jax.nn.sigmoid(SWIGLU_ALPHA * gate) * (up + 1.0)
        return act @ w_out[e] + b_out[e]

    yb = lax.map(expert_block, (xb, block_e)).reshape(-1, d)
    return jax.ops.segment_sum(yb[dest] * gate_sorted[:, None].astype(yb.dtype), tok_sorted, num_segments=n)


def _modulation(cvec, w_mod, b_mod):
    m = jax.nn.silu(cvec) @ w_mod + b_mod
    return jnp.split(m, 6, axis=-1)


def setup_inputs(seed: int = 0) -> dict:
    key = jax.random.key(seed)
    ks = jax.random.split(key, 32)
    f32 = jnp.float32
    D = D_MODEL

    def nrm(k, shape, scale):
        return jax.random.normal(k, shape, f32) * scale

    return {
        'x': nrm(ks[0], (BATCH, SEQ, D), 1.0),
        'c': nrm(ks[1], (BATCH, D), 1.0),
        'ctx': nrm(ks[2], (BATCH, CTX_LEN, D), 1.0),
        'c_ctx': nrm(ks[3], (D,), 1.0),
        'mod_w': nrm(ks[4], (DEPTH, D, 6 * D), 0.5 * D ** -0.5),
        'mod_b': nrm(ks[5], (DEPTH, 6 * D), 0.02),
        'ln1_g': 1.0 + nrm(ks[6], (DEPTH, D), 0.02),
        'ln1_b': nrm(ks[7], (DEPTH, D), 0.02),
        'ln2_g': 1.0 + nrm(ks[8], (DEPTH, D), 0.02),
        'ln2_b': nrm(ks[9], (DEPTH, D), 0.02),
        'router_w': nrm(ks[10], (DEPTH, D, N_EXPERTS), D ** -0.5),
        'router_b': nrm(ks[11], (DEPTH, N_EXPERTS), 0.01),
        'moe_w_in': nrm(ks[12], (DEPTH, N_EXPERTS, D, 2 * D_EXPERT), D ** -0.5),
        'moe_b_in': nrm(ks[13], (DEPTH, N_EXPERTS, 2 * D_EXPERT), 0.02),
        'moe_w_out': nrm(ks[14], (DEPTH, N_EXPERTS, D_EXPERT, D), D_EXPERT ** -0.5 * DEEPNORM_BETA),
        'moe_b_out': nrm(ks[15], (DEPTH, N_EXPERTS, D), 0.02),
        'ab_w_in': nrm(ks[16], (N_EVEN, D, AB_COLS), D ** -0.5),
        'ab_w_out': nrm(ks[17], (N_EVEN, D, D), D ** -0.5 * DEEPNORM_BETA),
        'na_rpb': nrm(ks[18], (N_EVEN, NA_HEADS, 2 * NA_KH - 1, 2 * NA_KW - 1), 0.1),
        'diff_lq1': nrm(ks[19], (N_EVEN, HEAD_DIM), 0.1),
        'diff_lk1': nrm(ks[20], (N_EVEN, HEAD_DIM), 0.1),
        'diff_lq2': nrm(ks[21], (N_EVEN, HEAD_DIM), 0.1),
        'diff_lk2': nrm(ks[22], (N_EVEN, HEAD_DIM), 0.1),
        'diff_subln': 1.0 + nrm(ks[23], (N_EVEN, 2 * HEAD_DIM), 0.02),
        'cd_w_in': nrm(ks[24], (N_ODD, D, CD_COLS), D ** -0.5),
        'cd_w_out': nrm(ks[25], (N_ODD, D, D), D ** -0.5 * DEEPNORM_BETA),
        'gqa_q_norm': 1.0 + nrm(ks[26], (N_ODD, HEAD_DIM), 0.02),
        'gqa_k_norm': 1.0 + nrm(ks[27], (N_ODD, HEAD_DIM), 0.02),
        'swa_sink': nrm(ks[28], (N_ODD, SWA_HEADS), 1.0),
    }


def reference(x, c, ctx, c_ctx, mod_w, mod_b, ln1_g, ln1_b, ln2_g, ln2_b, router_w, router_b,
              moe_w_in, moe_b_in, moe_w_out, moe_b_out, ab_w_in, ab_w_out, na_rpb,
              diff_lq1, diff_lk1, diff_lq2, diff_lk2, diff_subln, cd_w_in, cd_w_out,
              gqa_q_norm, gqa_k_norm, swa_sink):
    b, s, d = x.shape
    n_lat = b * s
    cos, sin = _axial_rope_tables(s)
    xc = ctx
    for i in range(DEPTH):
        last = i == DEPTH - 1
        j = i // 2
        sh1, sc1, g1, sh2, sc2, g2 = _modulation(c, mod_w[i], mod_b[i])
        ch1, cs1, cg1, ch2, cs2, cg2 = _modulation(c_ctx, mod_w[i], mod_b[i])
        h = x * (1.0 + sc1[:, None]) + sh1[:, None]
        hc = xc * (1.0 + cs1) + ch1
        if i % 2 == 0:
            y, yc = _mix_ab(h, hc, cos, sin, ab_w_in[j], ab_w_out[j], na_rpb[j], diff_lq1[j], diff_lk1[j],
                            diff_lq2[j], diff_lk2[j], diff_subln[j], 0.8 - 0.6 * math.exp(-0.3 * i), not last)
        else:
            y, yc = _mix_cd(h, hc, cos, sin, cd_w_in[j], cd_w_out[j], gqa_q_norm[j], gqa_k_norm[j],
                            swa_sink[j], not last)
        x = _layernorm(DEEPNORM_ALPHA * x + g1[:, None] * y, ln1_g[i], ln1_b[i])
        tokens = (x * (1.0 + sc2[:, None]) + sh2[:, None]).reshape(n_lat, d)
        if not last:
            xc = _layernorm(DEEPNORM_ALPHA * xc + cg1 * yc, ln1_g[i], ln1_b[i])
            tokens = jnp.concatenate([tokens, (xc * (1.0 + cs2) + ch2).reshape(-1, d)], axis=0)
        f = _moe(tokens, router_w[i], router_b[i], moe_w_in[i], moe_b_in[i], moe_w_out[i], moe_b_out[i])
        x = _layernorm(DEEPNORM_ALPHA * x + g2[:, None] * f[:n_lat].reshape(b, s, d), ln2_g[i], ln2_b[i])
        if not last:
            xc = _layernorm(DEEPNORM_ALPHA * xc + cg2 * f[n_lat:].reshape(xc.shape), ln2_g[i], ln2_b[i])
    return x
```

```cpp
#include <hip/hip_runtime.h>
#include <hip/hip_cooperative_groups.h>
#include <cstdio>
#include <cstdint>
namespace cg = cooperative_groups;

typedef unsigned short bf16_t;

constexpr int D = 1024, NB = 2, S = 8192, NLAT = NB * S, CTX = 256, NCTX = NB * CTX, NTOK = NLAT + NCTX;
constexpr int SP = S + CTX;
constexpr int NE = 32, TOPK = 4;
constexpr int CNT_STRIDE = 32;
constexpr int MAXSLOT = (NTOK * TOPK / 256 + NE) * 256;
constexpr int NQH = 16;
constexpr float ALPHA = 1.41421356237309515f;
constexpr float LN_EPS = 1e-5f, RMS_EPS = 1e-6f, SCALE = 0.125f;
constexpr float SW_LIMIT = 7.0f, SW_ALPHA = 1.702f;
constexpr float W8O_SCALE = 128.0f, ACT8_SCALE = 4.0f;
constexpr float WQKV8_SCALE = 64.0f, WO8_SCALE = 128.0f, Y8_SCALE = 64.0f;
constexpr float YP8_SCALE = 16.0f;
constexpr float W8_SCALE = 64.0f;

constexpr size_t MiB = 1ull << 20;
constexpr size_t WS_CTL = 0;
constexpr size_t WS_MOD = 1 * MiB;
constexpr size_t WS_SCAL = 2 * MiB;
constexpr size_t WS_ROPE = 3 * MiB;
constexpr size_t WS_PAIR = 6 * MiB;
constexpr size_t WS_SLOTG = 8 * MiB;
constexpr size_t WS_H = 10 * MiB;
constexpr size_t WS_Q = 150 * MiB;
constexpr size_t WS_K = 186 * MiB;
constexpr size_t WS_VT = 222 * MiB;
constexpr size_t WS_Y = 258 * MiB;
constexpr size_t WS_YO = 294 * MiB;
constexpr size_t WS_X1 = 364 * MiB;
constexpr size_t WS_X2 = 434 * MiB;
constexpr size_t WS_TOK = 504 * MiB;
constexpr size_t WS_XB = 540 * MiB;
constexpr size_t WS_ACT = 696 * MiB;
constexpr size_t WS_YP = 852 * MiB;
constexpr size_t WS_SCR = 1008 * MiB;
constexpr size_t WS_WT_ABIN = WS_H + 66 * 262144;
constexpr size_t WS_WT_ABOUT = 1054 * MiB;
constexpr size_t WS_WT_CDIN = WS_H + 78 * 262144;
constexpr size_t WS_WT_CDOUT = 1059 * MiB;
constexpr size_t WS_WT_MIN = 1062 * MiB;
constexpr size_t WS_WT_MOUT = 1318 * MiB;
constexpr size_t WS_END = 1446 * MiB;

struct Params {
    const float *x, *c, *ctx, *c_ctx, *mod_w, *mod_b, *ln1_g, *ln1_b, *ln2_g, *ln2_b, *router_w, *router_b;
    const float *moe_w_in, *moe_b_in, *moe_w_out, *moe_b_out, *ab_w_in, *ab_w_out, *na_rpb;
    const float *lq1, *lk1, *lq2, *lk2, *subln, *cd_w_in, *cd_w_out, *q_norm, *k_norm, *sink;
    float* out;
    unsigned char* ws;
};

__device__ __forceinline__ float bf2f(unsigned v) { return __uint_as_float(v << 16); }
__device__ __forceinline__ unsigned f2bf(float f) { unsigned u = __float_as_uint(f); return (u + 0x7fffu + ((u >> 16) & 1u)) >> 16; }
__device__ __forceinline__ unsigned pk2(float lo, float hi) { return f2bf(lo) | (f2bf(hi) << 16); }
template <int CTRL> __device__ __forceinline__ float dpp_xadd(float v) { const int t = __builtin_amdgcn_update_dpp(0, __float_as_int(v), CTRL, 0xf, 0xf, true); return v + __int_as_float(t); }
__device__ __forceinline__ float wave_sum(float v) {
    v = dpp_xadd<0xB1>(v); v = dpp_xadd<0x4E>(v); v = dpp_xadd<0x141>(v); v = dpp_xadd<0x140>(v);
    v += __int_as_float(__builtin_amdgcn_ds_swizzle(__float_as_int(v), 0x401f));
    auto rr = __builtin_amdgcn_permlane32_swap(__float_as_uint(v), __float_as_uint(v), false, false);
    return __uint_as_float(rr[0]) + __uint_as_float(rr[1]);
}
typedef float f2v __attribute__((ext_vector_type(2)));
__device__ __forceinline__ float silu_f(float v) { return v / (1.f + __expf(-v)); }
#define LAS __attribute__((address_space(3)))
typedef float float4v __attribute__((ext_vector_type(4)));

namespace pg8 {
#define PG8_LAS __attribute__((address_space(3)))
typedef unsigned short bf16_t;
typedef short bf16x8 __attribute__((ext_vector_type(8)));
typedef float f32x4 __attribute__((ext_vector_type(4)));
typedef unsigned u32x4 __attribute__((ext_vector_type(4)));
constexpr int BM = 256, BK = 64, HALF = 128, HTB = HALF * BK * 2  , STAGE_BYTES = 8 * HTB, NXCD = 8, WGM = 8;

__host__ __device__ __forceinline__ int lds_byte(int r, int c) { const int st = (r >> 4) * 2 + (c >> 5), rr = r & 15, cc = c & 31, ob = rr * 64 + cc * 2; return st * 1024 + (ob ^ (((ob >> 9) & 1) << 5)); }
__host__ __device__ __forceinline__ void stage_rc(int b, int& R, int& C) { const int st = b / 1024, sb = b % 1024, swz = sb ^ (((sb >> 9) & 1) << 5); R = (st >> 1) * 16 + swz / 64; C = (st & 1) * 32 + (swz % 64) / 2; }
__host__ __device__ __forceinline__ int perm32(int rho) { const int n = rho >> 4, i = rho & 15; return 8 * (i >> 2) + 4 * n + (i & 3); }

struct Unit { int pm, pn; };
struct Gemm { const bf16_t* A; const bf16_t* Bt; int M, N, K; const int* arow; };

struct StaticOrder {
    int nM, nN, nwg, G, c;
    __host__ __device__ void init(int M, int N, int G_, int c_) { nM = M / BM; nN = N / BM; nwg = nM * nN; G = G_; c = c_; }
    __host__ __device__ bool next(int i, Unit& u) const {
        const long L = (long)i * G + c; if (L >= nwg) return false;
        int wgid = (int)L; { const int q = nwg / NXCD, r = nwg % NXCD, xcd = wgid % NXCD, off = wgid / NXCD; wgid = (xcd < r ? xcd * (q + 1) : r * (q + 1) + (xcd - r) * q) + off; }
        const int nig = WGM * nN, gid = wgid / nig, fm = gid * WGM, gsz = (nM - fm) < WGM ? (nM - fm) : WGM;
        u.pm = fm + ((wgid % nig) % gsz); u.pn = (wgid % nig) / gsz; return true;
    }
    __device__ __forceinline__ void a_ready(const Unit&) const {}
    __device__ __forceinline__ void done(const Unit&) const {}
};

typedef int v8i_t __attribute__((ext_vector_type(8)));
typedef int v4i_t __attribute__((ext_vector_type(4)));
__device__ __forceinline__ v8i_t cat8(bf16x8 a, bf16x8 b) { const v4i_t x = __builtin_bit_cast(v4i_t, a), y = __builtin_bit_cast(v4i_t, b); return __builtin_shufflevector(x, y, 0, 1, 2, 3, 4, 5, 6, 7); }
template <bool FP8>
__device__ __forceinline__ void mma_block(f32x4 (&c)[4][2], const bf16x8 (&At)[4][2], const bf16x8 (&Bt)[2][2], const v8i_t (&a8)[4], const v8i_t (&b8)[2]) {
    if constexpr (FP8) {
#pragma unroll
        for (int m = 0; m < 4; ++m)
#pragma unroll
            for (int n = 0; n < 2; ++n)
                asm volatile("s_nop 1\n\tv_mfma_f32_16x16x128_f8f6f4 %0, %1, %2, %0" : "+v"(c[m][n]) : "v"(b8[n]), "v"(a8[m]));
    } else {
#pragma unroll
        for (int m = 0; m < 4; ++m)
#pragma unroll
            for (int n = 0; n < 2; ++n)
#pragma unroll
                for (int k = 0; k < 2; ++k) c[m][n] = __builtin_amdgcn_mfma_f32_16x16x32_bf16(Bt[n][k], At[m][k], c[m][n], 0, 0, 0);
    }
}
template <class Epi, class Sched, bool ALIGN_EPI = false, bool SP2 = false, bool FP8 = false, bool GATHER = false>
__device__ __forceinline__ void gemm_phase(PG8_LAS unsigned char* lds, const Gemm g, const Sched& S, const Epi& E) {
    int tid_ = threadIdx.x; asm volatile("" : "+v"(tid_));
    const int tid = tid_, wid = __builtin_amdgcn_readfirstlane(tid >> 6), lane = tid & 63, wr = wid >> 2, wc = wid & 3, fr = lane & 15, fq = lane >> 4;
    const int K = g.K, nt = K / BK;
    unsigned voffA[2], voffB[2];
#pragma unroll
    for (int i = 0; i < 2; ++i) { int R, C; stage_rc(tid * 16 + i * 8192, R, C); const int Rb = Epi::PERM ? ((R & ~31) + perm32(R & 31)) : R;
        voffA[i] = (unsigned)(R * K + C) * 2u; voffB[i] = (unsigned)(Rb * K + C) * 2u; }
    const size_t kstep = (size_t)(BK * 2);
    const size_t hstep = (size_t)HALF * K * 2;
    const size_t tstep = 2 * hstep;
    const unsigned ldsw = (unsigned)wid * 1024u;
    const int aoff = lds_byte(wr * 64 + fr, fq * 8), boff = lds_byte(wc * 32 + fr, fq * 8);
#define PG8_SA(b, h) (((b) * 2 + (h)) * HTB)
#define PG8_SB(b, h) ((4 + (b) * 2 + (h)) * HTB)
#define PG8_STAGE(bufoff, gbase, voff) do { _Pragma("unroll") for (int _i = 0; _i < 2; ++_i) \
        __builtin_amdgcn_global_load_lds((const unsigned*)((const char*)(gbase) + (voff)[_i]), (PG8_LAS unsigned*)(lds + (bufoff) + ldsw + _i * 8192), 16, 0, 0); } while (0)
#define PG8_STAGE_A(bufoff, gbase, HALF_, NEXT_) do { if constexpr (GATHER) { _Pragma("unroll") for (int _i = 0; _i < 2; ++_i) \
        __builtin_amdgcn_global_load_lds((const unsigned*)((const char*)(gbase) + ((NEXT_) ? gN[HALF_][_i] : gC[HALF_][_i])), (PG8_LAS unsigned*)(lds + (bufoff) + ldsw + _i * 8192), 16, 0, 0); } \
    else { PG8_STAGE(bufoff, (gbase) + ((HALF_) ? hstep : 0), voffA); } } while (0)
#define PG8_LDA(dst, b, h) do { if constexpr (FP8) { _Pragma("unroll") for (int m = 0; m < 4; ++m) dst##8[m] = cat8(*(const PG8_LAS bf16x8*)(lds + PG8_SA(b, h) + aoff + m * 2048), *(const PG8_LAS bf16x8*)(lds + PG8_SA(b, h) + aoff + m * 2048 + 1024)); } \
        else { _Pragma("unroll") for (int m = 0; m < 4; ++m) _Pragma("unroll") for (int k = 0; k < 2; ++k) dst[m][k] = *(const PG8_LAS bf16x8*)(lds + PG8_SA(b, h) + aoff + m * 2048 + k * 1024); } } while (0)
#define PG8_LDB(dst, b, h) do { if constexpr (FP8) { _Pragma("unroll") for (int n = 0; n < 2; ++n) dst##8[n] = cat8(*(const PG8_LAS bf16x8*)(lds + PG8_SB(b, h) + boff + n * 2048), *(const PG8_LAS bf16x8*)(lds + PG8_SB(b, h) + boff + n * 2048 + 1024)); } \
        else { _Pragma("unroll") for (int n = 0; n < 2; ++n) _Pragma("unroll") for (int k = 0; k < 2; ++k) dst[n][k] = *(const PG8_LAS bf16x8*)(lds + PG8_SB(b, h) + boff + n * 2048 + k * 1024); } } while (0)
#define PG8_MMA(ai, bj, At, Bt) do { __builtin_amdgcn_s_setprio(1); mma_block<FP8>(acc[ai][bj], At, Bt, At##8, Bt##8); __builtin_amdgcn_s_setprio(0); } while (0)
#define PG8_WAIT_V(n) asm volatile("s_waitcnt vmcnt(" #n ")" ::: "memory")
#define PG8_WAIT_L(n) asm volatile("s_waitcnt lgkmcnt(" #n ")" ::: "memory")
#define PG8_BAR __builtin_amdgcn_s_barrier()
#define PG8_SCHED __builtin_amdgcn_sched_barrier(0)
    Unit cur, nxt; int ui = 0;
    if (!S.next(0, cur)) return;
    static_assert(!GATHER || SP2, "GATHER is wired into the SP2 loop only");
    unsigned gC[2][2] = {{0u, 0u}, {0u, 0u}}, gN[2][2] = {{0u, 0u}, {0u, 0u}}; int gR[2] = {0, 0}; unsigned gCc[2] = {0u, 0u};
    if constexpr (GATHER) {
#pragma unroll
        for (int i = 0; i < 2; ++i) { int R, C; stage_rc(tid * 16 + i * 8192, R, C); gR[i] = R; gCc[i] = (unsigned)C * 2u; }
#pragma unroll
        for (int h = 0; h < 2; ++h)
#pragma unroll
            for (int i = 0; i < 2; ++i) gC[h][i] = (unsigned)g.arow[S.aoff(cur.pm) + cur.pm * BM + h * HALF + gR[i]] * (unsigned)(K * 2) + gCc[i];
        asm volatile("s_waitcnt vmcnt(0)" ::: "memory"); asm volatile("" : "+v"(gC[0][0]), "+v"(gC[0][1]), "+v"(gC[1][0]), "+v"(gC[1][1]));
    }
    f32x4 acc[2][2][4][2];
#pragma unroll
    for (int a = 0; a < 2; ++a)
#pragma unroll
        for (int b = 0; b < 2; ++b)
#pragma unroll
            for (int m = 0; m < 4; ++m)
#pragma unroll
                for (int n = 0; n < 2; ++n) acc[a][b][m][n] = (f32x4){0.f, 0.f, 0.f, 0.f};
    bf16x8 At[4][2], B0[2][2], B1[2][2]; v8i_t At8[4], B08[2], B18[2];
    const char* cA = (const char*)g.A + (GATHER ? (size_t)0 : (size_t)cur.pm * tstep); const char* cB = (const char*)g.Bt + (size_t)cur.pn * tstep;
    S.a_ready(cur);
    if constexpr (SP2) {
        PG8_STAGE(PG8_SB(0, 0), cB, voffB); PG8_STAGE(PG8_SB(0, 1), cB + hstep, voffB); PG8_STAGE_A(PG8_SA(0, 0), cA, 0, false); PG8_STAGE_A(PG8_SA(0, 1), cA, 1, false);
        if (wr == 1) PG8_BAR;
        PG8_WAIT_V(2); PG8_BAR;
        PG8_STAGE(PG8_SB(1, 0), cB + kstep, voffB); PG8_STAGE_A(PG8_SA(1, 0), cA + kstep, 0, false); PG8_STAGE(PG8_SB(1, 1), cB + hstep + kstep, voffB);
        PG8_WAIT_V(6); PG8_BAR;
    } else {
        PG8_STAGE(PG8_SB(0, 0), cB, voffB); PG8_STAGE(PG8_SA(0, 0), cA, voffA); PG8_STAGE(PG8_SB(0, 1), cB + hstep, voffB); PG8_STAGE(PG8_SA(0, 1), cA + hstep, voffA);
        if (wr == 1) PG8_BAR;
        PG8_WAIT_V(4); PG8_BAR;
        PG8_STAGE(PG8_SB(1, 0), cB + kstep, voffB); PG8_STAGE(PG8_SA(1, 0), cA + kstep, voffA); PG8_STAGE(PG8_SB(1, 1), cB + hstep + kstep, voffB);
        PG8_WAIT_V(6); PG8_BAR;
    }
    for (;;) {
        const bool has_next = S.next(ui + 1, nxt);
        const char* nA = (has_next && !GATHER) ? (const char*)g.A + (size_t)nxt.pm * tstep : cA; const char* nB = has_next ? (const char*)g.Bt + (size_t)nxt.pn * tstep : cB;
        if constexpr (GATHER) {
            const int npm = has_next ? nxt.pm : cur.pm;
#pragma unroll
            for (int h = 0; h < 2; ++h)
#pragma unroll
                for (int i = 0; i < 2; ++i) gN[h][i] = (unsigned)g.arow[S.aoff(npm) + npm * BM + h * HALF + gR[i]] * (unsigned)(K * 2) + gCc[i];
            asm volatile("s_waitcnt vmcnt(0)" ::: "memory"); asm volatile("" : "+v"(gN[0][0]), "+v"(gN[0][1]), "+v"(gN[1][0]), "+v"(gN[1][1]));
        }
        for (int t = 0; t < nt; t += 2) {
            const bool last = (t == nt - 2);
            const char* a1 = cA + (size_t)(t + 1) * kstep;
            const char* a2 = last ? nA : cA + (size_t)(t + 2) * kstep; const char* b2 = last ? nB : cB + (size_t)(t + 2) * kstep;
            const char* a3 = a2 + kstep; const char* b3 = b2 + kstep;
            if (last && has_next) S.a_ready(nxt);
            if constexpr (SP2) {
            PG8_LDB(B0, 0, 0); PG8_LDB(B1, 0, 1); PG8_SCHED; PG8_LDA(At, 0, 0); PG8_STAGE_A(PG8_SA(1, 1), a1, 1, false);
            PG8_WAIT_V(8); PG8_WAIT_L(0); PG8_BAR; PG8_MMA(0, 0, At, B0); PG8_MMA(0, 1, At, B1); PG8_BAR; PG8_SCHED;
            PG8_LDA(At, 0, 1); PG8_STAGE(PG8_SB(0, 0), b2, voffB); PG8_STAGE(PG8_SB(0, 1), b2 + hstep, voffB); PG8_STAGE_A(PG8_SA(0, 0), a2, 0, last);
            PG8_WAIT_V(8); PG8_WAIT_L(0); PG8_BAR; PG8_MMA(1, 0, At, B0); PG8_MMA(1, 1, At, B1); PG8_BAR; PG8_SCHED;
            PG8_LDB(B0, 1, 0); PG8_LDB(B1, 1, 1); PG8_SCHED; PG8_LDA(At, 1, 0); PG8_STAGE_A(PG8_SA(0, 1), a2, 1, last);
            PG8_WAIT_V(8); PG8_WAIT_L(0); PG8_BAR; PG8_MMA(0, 0, At, B0); PG8_MMA(0, 1, At, B1); PG8_BAR; PG8_SCHED;
            PG8_LDA(At, 1, 1); PG8_STAGE(PG8_SB(1, 0), b3, voffB); PG8_STAGE(PG8_SB(1, 1), b3 + hstep, voffB); PG8_STAGE_A(PG8_SA(1, 0), a3, 0, last);
            PG8_WAIT_V(8); PG8_WAIT_L(0); PG8_BAR; PG8_MMA(1, 0, At, B0); PG8_MMA(1, 1, At, B1); PG8_BAR; PG8_SCHED;
            } else {
            PG8_LDB(B0, 0, 0); PG8_SCHED; PG8_LDA(At, 0, 0); PG8_STAGE(PG8_SA(1, 1), a1 + hstep, voffA);
            PG8_WAIT_L(8); PG8_BAR; PG8_WAIT_L(0); PG8_MMA(0, 0, At, B0); PG8_BAR; PG8_SCHED;
            PG8_LDB(B1, 0, 1); PG8_STAGE(PG8_SB(0, 0), b2, voffB);
            PG8_BAR; PG8_WAIT_L(0); PG8_MMA(0, 1, At, B1); PG8_BAR;
            PG8_LDA(At, 0, 1); PG8_STAGE(PG8_SA(0, 0), a2, voffA);
            PG8_BAR; PG8_WAIT_L(0); PG8_MMA(1, 0, At, B0); PG8_BAR; PG8_SCHED;
            PG8_STAGE(PG8_SB(0, 1), b2 + hstep, voffB);
            PG8_WAIT_V(6); PG8_BAR; PG8_MMA(1, 1, At, B1); PG8_BAR;
            PG8_LDB(B0, 1, 0); PG8_SCHED; PG8_LDA(At, 1, 0); PG8_STAGE(PG8_SA(0, 1), a2 + hstep, voffA);
            PG8_WAIT_L(8); PG8_BAR; PG8_WAIT_L(0); PG8_MMA(0, 0, At, B0); PG8_BAR; PG8_SCHED;
            PG8_LDB(B1, 1, 1); PG8_STAGE(PG8_SB(1, 0), b3, voffB);
            PG8_BAR; PG8_WAIT_L(0); PG8_MMA(0, 1, At, B1); PG8_BAR;
            PG8_LDA(At, 1, 1); PG8_STAGE(PG8_SA(1, 0), a3, voffA);
            PG8_BAR; PG8_WAIT_L(0); PG8_MMA(1, 0, At, B0); PG8_BAR; PG8_SCHED;
            PG8_STAGE(PG8_SB(1, 1), b3 + hstep, voffB);
            PG8_WAIT_V(6); PG8_BAR; PG8_MMA(1, 1, At, B1); PG8_BAR;
            }
        }
        if constexpr (ALIGN_EPI) { if (wr == 0) PG8_BAR; }
        if constexpr (!Epi::AFTER_DRAIN) { E(acc, cur, wr, wc, fr, fq); S.done(cur); }
        if (!has_next) break;
#pragma unroll
        for (int a = 0; a < 2; ++a)
#pragma unroll
            for (int b = 0; b < 2; ++b)
#pragma unroll
                for (int m = 0; m < 4; ++m)
#pragma unroll
                    for (int n = 0; n < 2; ++n) acc[a][b][m][n] = (f32x4){0.f, 0.f, 0.f, 0.f};
        cur = nxt; cA = nA; cB = nB; ++ui;
        if constexpr (GATHER) { gC[0][0] = gN[0][0]; gC[0][1] = gN[0][1]; gC[1][0] = gN[1][0]; gC[1][1] = gN[1][1]; }
        if constexpr (ALIGN_EPI) { if (wr == 1) PG8_BAR; }
    }
    PG8_WAIT_V(0);
    if constexpr (!ALIGN_EPI) { if (wr == 0) PG8_BAR; }
    PG8_BAR;
    if constexpr (Epi::AFTER_DRAIN) { E.fused(acc, cur, wr, wc, fr, fq, lds, wid, lane); S.done(cur); }
#undef PG8_SA
#undef PG8_SB
#undef PG8_STAGE
#undef PG8_STAGE_A
#undef PG8_LDA
#undef PG8_LDB
#undef PG8_MMA
#undef PG8_WAIT_V
#undef PG8_WAIT_L
#undef PG8_BAR
#undef PG8_SCHED
}
}
__device__ __forceinline__ unsigned pk4_fp8(float a, float b, float c, float d) { int r = __builtin_amdgcn_cvt_pk_fp8_f32(a, b, 0, false); r = __builtin_amdgcn_cvt_pk_fp8_f32(c, d, r, true); return (unsigned)r; }

constexpr int ECAP = NTOK;
constexpr int TOFF_AT = 700, PSTART_AT = 330;
namespace pg8 {
__device__ __forceinline__ unsigned cvt_pk_bf16(float lo, float hi) { unsigned r; asm volatile("v_cvt_pk_bf16_f32 %0, %1, %2" : "=v"(r) : "v"(lo), "v"(hi)); return r; }

struct EpiStoreBf16 {
    static constexpr bool PERM = true, AFTER_DRAIN = false;
    bf16_t* O; int ldc;
    __device__ __forceinline__ void operator()(const f32x4 (&acc)[2][2][4][2], const Unit& u, int wr, int wc, int fr, int fq) const {
        const int row0 = u.pm * BM + wr * 64 + fr, col0 = u.pn * BM + wc * 32 + 8 * fq;
#pragma unroll
        for (int ai = 0; ai < 2; ++ai)
#pragma unroll
            for (int m = 0; m < 4; ++m) { bf16_t* rowp = O + (size_t)(row0 + ai * HALF + m * 16) * ldc + col0;
#pragma unroll
                for (int bj = 0; bj < 2; ++bj) { const f32x4 v0 = acc[ai][bj][m][0], v1 = acc[ai][bj][m][1];
                    u32x4 w; w.x = cvt_pk_bf16(v0[0], v0[1]); w.y = cvt_pk_bf16(v0[2], v0[3]); w.z = cvt_pk_bf16(v1[0], v1[1]); w.w = cvt_pk_bf16(v1[2], v1[3]);
                    *(u32x4*)(rowp + bj * HALF) = w; } }
    }
};
struct EpiStoreF32 {
    static constexpr bool PERM = false, AFTER_DRAIN = false;
    float* O; int ldc; float wsc;
    __device__ __forceinline__ void operator()(const f32x4 (&acc)[2][2][4][2], const Unit& u, int wr, int wc, int fr_in, int fq_in) const {
        int fr = fr_in, fq = fq_in; asm volatile("s_nop 15\n\ts_nop 15" : "+v"(fr), "+v"(fq)); __builtin_amdgcn_sched_barrier(0);
        const int row0 = u.pm * BM + wr * 64 + fr, col0 = u.pn * BM + wc * 32 + 4 * fq;
#pragma unroll
        for (int ai = 0; ai < 2; ++ai)
#pragma unroll
            for (int m = 0; m < 4; ++m) { float* rowp = O + (size_t)(row0 + ai * HALF + m * 16) * ldc + col0;
#pragma unroll
                for (int bj = 0; bj < 2; ++bj)
#pragma unroll
                    for (int n = 0; n < 2; ++n) *(f32x4*)(rowp + bj * HALF + n * 16) = acc[ai][bj][m][n] * wsc; }
    }
};
__device__ __forceinline__ float swiglu1(float g, float u) {
    g = fminf(g, SW_LIMIT); u = fminf(fmaxf(u, -SW_LIMIT), SW_LIMIT);
    return g * __builtin_amdgcn_rcpf(1.f + __builtin_amdgcn_exp2f(-SW_ALPHA * 1.4426950408889634f * g)) * (u + 1.f);
}
struct EpiMoe1 {
    static constexpr bool PERM = true, AFTER_DRAIN = false;
    bf16_t* ACT; const float* b_in; float wsc;
    __device__ __forceinline__ void operator()(const f32x4 (&acc)[2][2][4][2], const Unit& u, int wr, int wc, int fr, int fq) const {
        int fr_ = fr, fq_ = fq; asm volatile("s_nop 15\n\ts_nop 15" : "+v"(fr_), "+v"(fq_)); __builtin_amdgcn_sched_barrier(0);
        const int e = u.pn >> 3, pnl = u.pn & 7;
        const int row0 = u.pm * BM + wr * 64 + fr_, c0 = pnl * 128 + wc * 32 + 8 * fq_;
        f32x4 bg[2], bu[2];
#pragma unroll
        for (int n = 0; n < 2; ++n) { bg[n] = *(const f32x4*)(b_in + e * 2048 + c0 + 4 * n); bu[n] = *(const f32x4*)(b_in + e * 2048 + 1024 + c0 + 4 * n); }
#pragma unroll
        for (int ai = 0; ai < 2; ++ai)
#pragma unroll
            for (int m = 0; m < 4; ++m) {
                float a[8];
#pragma unroll
                for (int n = 0; n < 2; ++n) { const f32x4 g = acc[ai][0][m][n] * wsc + bg[n], uu = acc[ai][1][m][n] * wsc + bu[n];
#pragma unroll
                    for (int i = 0; i < 4; ++i) a[4 * n + i] = swiglu1(g[i], uu[i]); }
                uint2 w; w.x = pk4_fp8(a[0] * ACT8_SCALE, a[1] * ACT8_SCALE, a[2] * ACT8_SCALE, a[3] * ACT8_SCALE); w.y = pk4_fp8(a[4] * ACT8_SCALE, a[5] * ACT8_SCALE, a[6] * ACT8_SCALE, a[7] * ACT8_SCALE);
                *(uint2*)((unsigned char*)ACT + (size_t)(row0 + ai * HALF + m * 16) * D + c0) = w;
            }
    }
};
struct EpiMoe2 {
    static constexpr bool PERM = true, AFTER_DRAIN = false;
    bf16_t* YP; const float* b_out; const float* slot_gate; float wsc; const PG8_LAS int* tile_off;
    __device__ __forceinline__ void operator()(const f32x4 (&acc)[2][2][4][2], const Unit& u, int wr, int wc, int fr, int fq) const {
        int fr_ = fr, fq_ = fq; asm volatile("s_nop 15\n\ts_nop 15" : "+v"(fr_), "+v"(fq_)); __builtin_amdgcn_sched_barrier(0);
        const int e = u.pn >> 2, pnl = u.pn & 3;
        const int row0 = u.pm * BM + wr * 64 + fr_, c0 = pnl * 256 + wc * 32 + 8 * fq_;
        f32x4 bv[2][2];
#pragma unroll
        for (int bj = 0; bj < 2; ++bj)
#pragma unroll
            for (int n = 0; n < 2; ++n) bv[bj][n] = *(const f32x4*)(b_out + e * 1024 + c0 + bj * HALF + 4 * n);
#pragma unroll
        for (int ai = 0; ai < 2; ++ai)
#pragma unroll
            for (int m = 0; m < 4; ++m) { const int row = row0 + ai * HALF + m * 16; const float gt = slot_gate[tile_off[u.pm] + row] * YP8_SCALE;
#pragma unroll
                for (int bj = 0; bj < 2; ++bj) { const f32x4 v0 = (acc[ai][bj][m][0] * wsc + bv[bj][0]) * gt, v1 = (acc[ai][bj][m][1] * wsc + bv[bj][1]) * gt;
                    uint2 w; w.x = pk4_fp8(v0[0], v0[1], v0[2], v0[3]); w.y = pk4_fp8(v1[0], v1[1], v1[2], v1[3]);
                    *(uint2*)((unsigned char*)YP + (size_t)row * D + c0 + bj * HALF) = w; } }
    }
};
struct MoeSched {
    int T, NTN, tb, te, j, MR, G, c;
    const PG8_LAS int* tile_e;
    __device__ __forceinline__ int aoff(int pm) const { return tile_e[TOFF_AT + pm]; }
    __device__ void init(int T_, int NTN_, int G_, int bx, const PG8_LAS int* te_) {
        T = T_; NTN = NTN_; G = G_; c = bx; tile_e = te_;
        const int ngrp = (G % 8 == 0) ? 8 : 1, per = G / ngrp;
        const int x = bx % ngrp; j = bx / ngrp;
        tb = (int)((long)x * T / ngrp); te = (int)((long)(x + 1) * T / ngrp); MR = per / NTN;
    }
    __device__ bool next(int i, Unit& u) const {
        if (MR == 0) { const long Lx = (long)i * G + c; if (Lx >= (long)T * NTN) return false; u.pm = (int)(Lx / NTN); u.pn = tile_e[u.pm] * NTN + (int)(Lx % NTN); return true; }
        if (j >= MR * NTN) return false;
        const int pm = tb + i * MR + j / NTN; if (pm >= te) return false;
        u.pm = pm; u.pn = tile_e[pm] * NTN + j % NTN; return true;
    }
    __device__ __forceinline__ void a_ready(const Unit&) const {}
    __device__ __forceinline__ void done(const Unit&) const {}
};
}

__device__ __forceinline__ int tid_fresh() { int t = threadIdx.x; asm volatile("" : "+v"(t)); return t; }
constexpr int LDS_GEMM = 131072, LDS_MISC = 131072, LDS_PAR = 131072 + 4096, LDS_TOTAL = 131072 + 4096 + 20480;

__device__ __forceinline__ void conv_item(const float* W, int ldw, int k0, int n0, bf16_t* WT, int dst_row, LAS float* scr, int lane) {
    float4 v[16];
    const float* src = W + (size_t)(k0 + (lane >> 4)) * ldw + n0 + 4 * (lane & 15);
#pragma unroll
    for (int j = 0; j < 16; ++j) v[j] = *(const float4*)(src + (size_t)(4 * j) * ldw);
    LAS float* d = scr + (lane >> 4) * 65 + 4 * (lane & 15);
#pragma unroll
    for (int j = 0; j < 16; ++j) { d[(4 * j) * 65 + 0] = v[j].x; d[(4 * j) * 65 + 1] = v[j].y; d[(4 * j) * 65 + 2] = v[j].z; d[(4 * j) * 65 + 3] = v[j].w; }
    asm volatile("s_waitcnt lgkmcnt(0)" ::: "memory");
    const int kc = lane & 7;
#pragma unroll
    for (int j = 0; j < 8; ++j) { const int n = 8 * j + (lane >> 3); const LAS float* sp = scr + (8 * kc) * 65 + n;
        uint4 o; o.x = pk2(sp[0 * 65], sp[1 * 65]); o.y = pk2(sp[2 * 65], sp[3 * 65]); o.z = pk2(sp[4 * 65], sp[5 * 65]); o.w = pk2(sp[6 * 65], sp[7 * 65]);
        *(uint4*)(WT + (size_t)(dst_row + n) * 1024 + k0 + 8 * kc) = o; }
    asm volatile("s_waitcnt lgkmcnt(0)" ::: "memory");
}
__device__ __forceinline__ void conv_item8(const float* W, int ldw, int k0, int n0, unsigned char* WT8, int dst_row, LAS float* scr, int lane, float wscale) {
    float4 v[16];
    const float* src = W + (size_t)(k0 + (lane >> 4)) * ldw + n0 + 4 * (lane & 15);
#pragma unroll
    for (int j = 0; j < 16; ++j) v[j] = *(const float4*)(src + (size_t)(4 * j) * ldw);
    LAS float* d = scr + (lane >> 4) * 65 + 4 * (lane & 15);
#pragma unroll
    for (int j = 0; j < 16; ++j) { d[(4 * j) * 65 + 0] = v[j].x * wscale; d[(4 * j) * 65 + 1] = v[j].y * wscale; d[(4 * j) * 65 + 2] = v[j].z * wscale; d[(4 * j) * 65 + 3] = v[j].w * wscale; }
    asm volatile("s_waitcnt lgkmcnt(0)" ::: "memory");
    const int kc = lane & 3;
#pragma unroll
    for (int j = 0; j < 4; ++j) { const int n = 16 * j + (lane >> 2); const LAS float* sp = scr + (16 * kc) * 65 + n;
        uint4 o; o.x = pk4_fp8(sp[0 * 65], sp[1 * 65], sp[2 * 65], sp[3 * 65]); o.y = pk4_fp8(sp[4 * 65], sp[5 * 65], sp[6 * 65], sp[7 * 65]);
        o.z = pk4_fp8(sp[8 * 65], sp[9 * 65], sp[10 * 65], sp[11 * 65]); o.w = pk4_fp8(sp[12 * 65], sp[13 * 65], sp[14 * 65], sp[15 * 65]);
        *(uint4*)(WT8 + (size_t)(dst_row + n) * 1024 + k0 + 16 * kc) = o; }
    asm volatile("s_waitcnt lgkmcnt(0)" ::: "memory");
}
__device__ __forceinline__ void conv8_load(float4 (&v)[16], const float* W, int ldw, int k0, int n0, int lane) {
    const float* src = W + (size_t)(k0 + (lane >> 4)) * ldw + n0 + 4 * (lane & 15);
#pragma unroll
    for (int j = 0; j < 16; ++j) v[j] = *(const float4*)(src + (size_t)(4 * j) * ldw);
}
__device__ __forceinline__ void conv8_store(const float4 (&v)[16], unsigned char* WT8, int dst_row, int k0, LAS float* scr, int lane, float wscale) {
    LAS float* d = scr + (lane >> 4) * 65 + 4 * (lane & 15);
#pragma unroll
    for (int j = 0; j < 16; ++j) { d[(4 * j) * 65 + 0] = v[j].x * wscale; d[(4 * j) * 65 + 1] = v[j].y * wscale; d[(4 * j) * 65 + 2] = v[j].z * wscale; d[(4 * j) * 65 + 3] = v[j].w * wscale; }
    asm volatile("s_waitcnt lgkmcnt(0)" ::: "memory");
    const int kc = lane & 3;
#pragma unroll
    for (int j = 0; j < 4; ++j) { const int n = 16 * j + (lane >> 2); const LAS float* sp = scr + (16 * kc) * 65 + n;
        uint4 o; o.x = pk4_fp8(sp[0 * 65], sp[1 * 65], sp[2 * 65], sp[3 * 65]); o.y = pk4_fp8(sp[4 * 65], sp[5 * 65], sp[6 * 65], sp[7 * 65]);
        o.z = pk4_fp8(sp[8 * 65], sp[9 * 65], sp[10 * 65], sp[11 * 65]); o.w = pk4_fp8(sp[12 * 65], sp[13 * 65], sp[14 * 65], sp[15 * 65]);
        *(uint4*)(WT8 + (size_t)(dst_row + n) * 1024 + k0 + 16 * kc) = o; }
    asm volatile("s_waitcnt lgkmcnt(0)" ::: "memory");
}
__device__ __forceinline__ void conv8h_load(float4 (&v)[16], const float* W, int ldw, int k0, int n0, int lane) {
    const float* src = W + (size_t)(k0 + 4 * (lane >> 4)) * ldw + n0 + 4 * (lane & 15);
#pragma unroll
    for (int j = 0; j < 4; ++j)
#pragma unroll
        for (int i = 0; i < 4; ++i) v[4 * j + i] = *(const float4*)(src + (size_t)(16 * j + i) * ldw);
}
__device__ __forceinline__ void conv8h_stage(const float4 (&v)[16], LAS unsigned* img, int half, int lane, float s) {
    const int kq = lane >> 4, nq = lane & 15;
#pragma unroll
    for (int j = 0; j < 4; ++j) {
        LAS unsigned* d = img + (4 * nq) * 33 + 16 * half + 4 * j + kq;
        d[0 * 33] = pk4_fp8(v[4 * j].x * s, v[4 * j + 1].x * s, v[4 * j + 2].x * s, v[4 * j + 3].x * s);
        d[1 * 33] = pk4_fp8(v[4 * j].y * s, v[4 * j + 1].y * s, v[4 * j + 2].y * s, v[4 * j + 3].y * s);
        d[2 * 33] = pk4_fp8(v[4 * j].z * s, v[4 * j + 1].z * s, v[4 * j + 2].z * s, v[4 * j + 3].z * s);
        d[3 * 33] = pk4_fp8(v[4 * j].w * s, v[4 * j + 1].w * s, v[4 * j + 2].w * s, v[4 * j + 3].w * s);
    }
}
__device__ __forceinline__ void conv8h_flush(const LAS unsigned* img, unsigned char* WT8, int dst_row, int k0, int lane) {
    asm volatile("s_waitcnt lgkmcnt(0)" ::: "memory");
    const int ch = lane & 7;
#pragma unroll
    for (int j = 0; j < 8; ++j) { const int n = 8 * j + (lane >> 3); const LAS unsigned* sp = img + n * 33 + 4 * ch;
        uint4 o; o.x = sp[0]; o.y = sp[1]; o.z = sp[2]; o.w = sp[3];
        *(uint4*)(WT8 + (size_t)(dst_row + n) * 1024 + k0 + 16 * ch) = o; }
    asm volatile("s_waitcnt lgkmcnt(0)" ::: "memory");
}
struct MoeConvItem { const float* W; unsigned char* WT8; int ldw, k0, n0, drow; float scale; };
__device__ __forceinline__ MoeConvItem moe_conv_item(const Params& p, int r) {
    MoeConvItem it; const int le = r / 384, q = r % 384;
    if (q < 256) { it.n0 = (q % 32) * 64; it.k0 = (q / 32) * 128; it.ldw = 2048; it.W = p.moe_w_in + (size_t)le * 1024 * 2048; it.WT8 = p.ws + WS_WT_MIN + (size_t)le * 2048 * 1024;
        const int nn = it.n0 & 1023; it.drow = 256 * (nn >> 7) + (nn & 127) + (it.n0 >= 1024 ? 128 : 0); it.scale = W8_SCALE; }
    else { const int q2 = q - 256; it.n0 = (q2 % 16) * 64; it.k0 = (q2 / 16) * 128; it.ldw = 1024; it.W = p.moe_w_out + (size_t)le * 1024 * 1024; it.WT8 = p.ws + WS_WT_MOUT + (size_t)le * 1024 * 1024;
        it.drow = it.n0; it.scale = W8O_SCALE; }
    return it;
}
__device__ __forceinline__ void phase_pre(const Params& p, int bid, int nb, unsigned char* smem) {
    const int nth = blockDim.x, tid = threadIdx.x;
    const int lane = tid & 63, wv = tid >> 6, nw = nth / 64;
    float* MOD = (float*)(p.ws + WS_MOD);
    {
        LAS float* sl = (LAS float*)smem;
        LAS float* part = (LAS float*)(smem + 12288);
        for (int it = bid; it < 192; it += nb) {
            for (int i = tid; i < 3072; i += nth) { const float cv = i < 2048 ? p.c[i] : p.c_ctx[i - 2048]; sl[i] = silu_f(cv); }
            __syncthreads();
            const int L = it / 96, n = (it % 96) * 64 + lane;
            const float* W = p.mod_w + (size_t)L * 1024 * 6144 + n;
            float a0 = 0.f, a1 = 0.f, a2 = 0.f;
#pragma unroll 8
            for (int k = 128 * wv; k < 128 * wv + 128; ++k) { const float w = W[(size_t)k * 6144]; a0 += sl[k] * w; a1 += sl[1024 + k] * w; a2 += sl[2048 + k] * w; }
            part[(wv * 3 + 0) * 64 + lane] = a0; part[(wv * 3 + 1) * 64 + lane] = a1; part[(wv * 3 + 2) * 64 + lane] = a2;
            __syncthreads();
            if (tid < 192) { const int r = tid >> 6, nn = (it % 96) * 64 + (tid & 63); float sum = p.mod_b[L * 6144 + nn];
                for (int q = 0; q < nw; ++q) sum += part[(q * 3 + r) * 64 + (tid & 63)];
                MOD[(L * 3 + r) * 6144 + nn] = sum; }
            __syncthreads();
        }
    }
    const int gt = bid * nth + tid, gs = nb * nth;
    float2* ROPE = (float2*)(p.ws + WS_ROPE);
    for (int idx = gt; idx < 8192 * 32; idx += gs) {
        const int t = idx >> 5, i = idx & 31;
        const float pos = (i < 16) ? (float)(t >> 6) : (float)(t & 63);
        const float fr = powf(10000.0f, -(float)(i & 15) / 16.0f);
        const float ang = pos * fr;
        ROPE[idx] = make_float2(cosf(ang), sinf(ang));
    }
    if (gt == 0) {
        float s1 = 0.f, s2 = 0.f;
        for (int k = 0; k < 64; ++k) { s1 += p.lq1[k] * p.lk1[k]; s2 += p.lq2[k] * p.lk2[k]; }
        ((float*)(p.ws + WS_SCAL))[0] = expf(s1) - expf(s2) + 0.2f;
    }
    LAS float* scr = (LAS float*)(smem + wv * 16640);
    constexpr int I_ABIN = 16 * 48, I_ABOUT = 16 * 16, I_CDIN = 16 * 24, I_CDOUT = 16 * 16, I_MIN = 16 * 32, I_MOUT = 16 * 16;
    constexpr int I_SMALL = I_ABIN + I_ABOUT + I_CDIN + I_CDOUT;
    for (int it = bid * nw + wv; it < I_SMALL; it += nb * nw) {
        int r = it;
        if (r < I_ABIN) { conv_item8(p.ab_w_in, 3072, (r / 48) * 64, (r % 48) * 64, p.ws + WS_WT_ABIN, (r % 48) * 64, scr, lane, WQKV8_SCALE); continue; } r -= I_ABIN;
        if (r < I_ABOUT) { conv_item(p.ab_w_out, 1024, (r / 16) * 64, (r % 16) * 64, (bf16_t*)(p.ws + WS_WT_ABOUT), (r % 16) * 64, scr, lane); continue; } r -= I_ABOUT;
        if (r < I_CDIN) { const int n0 = (r % 24) * 64; const int np = n0 < 512 ? n0 : n0 < 640 ? 1024 + (n0 - 512) : n0 < 768 ? 1280 + (n0 - 640) : n0 < 1280 ? 512 + (n0 - 768) : n0 < 1408 ? 1152 + (n0 - 1280) : n0;
            conv_item8(p.cd_w_in, 1536, (r / 24) * 64, n0, p.ws + WS_WT_CDIN, np, scr, lane, WQKV8_SCALE); continue; } r -= I_CDIN;
        conv_item(p.cd_w_out, 1024, (r / 16) * 64, (r % 16) * 64, (bf16_t*)(p.ws + WS_WT_CDOUT), (r % 16) * 64, scr, lane);
    }
    {
        uint4* z0 = (uint4*)(p.ws + WS_XB); uint4* z1 = (uint4*)(p.ws + WS_XB + 4 * MiB);
        for (int i = gt; i < NE * ECAP / 4; i += gs) { z0[i] = make_uint4(0u, 0u, 0u, 0u); z1[i] = make_uint4(0u, 0u, 0u, 0u); }
    }
}

__device__ __forceinline__ void phase_h0(const Params& p, int bid, int nb) {
    const float* MOD = (const float*)(p.ws + WS_MOD);
    unsigned char* H8 = p.ws + WS_H;
    const int lane = threadIdx.x & 63, wv = threadIdx.x >> 6, nw = blockDim.x / 64;
    for (int rq = bid * nw + wv; rq < NTOK / 4; rq += nb * nw) {
        const int row0 = rq * 4;
        const bool lat = row0 < NLAT; const int r = lat ? (row0 >> 13) : 2;
        const float* xin = lat ? p.x + (size_t)row0 * D : p.ctx + (size_t)(row0 - NLAT) * D;
        const float* sh = MOD + (0 * 3 + r) * 6144; const float* sc = sh + 1024;
        float4 v[4][4];
#pragma unroll
        for (int q = 0; q < 4; ++q)
#pragma unroll
            for (int j = 0; j < 4; ++j) v[q][j] = *(const float4*)(xin + (size_t)q * D + 4 * lane + 256 * j);
#pragma unroll
        for (int j = 0; j < 4; ++j) {
            const int k = 4 * lane + 256 * j;
            const float4 a = *(const float4*)(sc + k), b = *(const float4*)(sh + k);
#pragma unroll
            for (int q = 0; q < 4; ++q)
                *(unsigned*)(H8 + (size_t)(row0 + q) * D + k) = pk4_fp8(v[q][j].x * (1.f + a.x) + b.x, v[q][j].y * (1.f + a.y) + b.y, v[q][j].z * (1.f + a.z) + b.z, v[q][j].w * (1.f + a.w) + b.w);
        }
    }
}

__device__ __forceinline__ void chunk_desc(int L, int ch, int& kind, int& idx, int& flags) {
    if (L == 0) {
        const int g = ch >> 3, u = ch & 7;
        kind = g % 3; idx = (g >= 3 ? 8 : 0) + u; flags = (g == 3 || g == 4) ? 1 : 0;
    } else {
        if (ch < 8) { kind = 0; idx = ch; flags = 0; }
        else if (ch < 16) { kind = 0; idx = ch; flags = 1; }
        else if (ch < 18) { kind = 1; idx = ch - 16; flags = 0; }
        else if (ch < 20) { kind = 1; idx = ch - 16; flags = 1; }
        else { kind = 2; idx = ch - 20; flags = 0; }
    }
}
namespace pg8 {
struct QkvSched {
    int L, nwg, G, c;
    __device__ __forceinline__ void init(int L_, int G_, int c_) { L = L_; G = G_; c = c_; nwg = 66 * (L_ == 0 ? 12 : 6); }
    __device__ __forceinline__ bool next(int i, Unit& u) const {
        const long Lx = (long)i * G + c; if (Lx >= nwg) return false;
        int wgid = (int)Lx; { const int q = nwg / NXCD, r = nwg % NXCD, xcd = wgid % NXCD, off = wgid / NXCD; wgid = (xcd < r ? xcd * (q + 1) : r * (q + 1) + (xcd - r) * q) + off; }
        if (L == 0) { const int t = wgid / 12, j = wgid % 12;
            if (j < 8) { u.pm = t; u.pn = 66 + (j < 4 ? j : j + 2); } else { u.pm = 66 + (j < 10 ? j - 4 : j); u.pn = t; } }
        else { const int t = wgid / 6, j = wgid % 6;
            if (j < 5) { u.pm = t; u.pn = 78 + j; } else { u.pm = 78 + 5; u.pn = t; } }
        return true;
    }
    __device__ __forceinline__ void a_ready(const Unit&) const {}
    __device__ __forceinline__ void done(const Unit&) const {}
};
struct EpiQkv {
    static constexpr bool PERM = true, AFTER_DRAIN = false;
    int L; bf16_t* Q; bf16_t* Kb; bf16_t* VT; const float2* ROPE; float wsc;
    __device__ __forceinline__ void operator()(const f32x4 (&acc)[2][2][4][2], const Unit& u, int wr, int wc, int fr_in, int fq_in) const {
        int fr = fr_in, fq = fq_in; asm volatile("s_nop 15\n\ts_nop 15" : "+v"(fr), "+v"(fq)); __builtin_amdgcn_sched_barrier(0);
        const int WT0 = L == 0 ? 66 : 78, NKH = L == 0 ? 16 : 4, NVR = L == 0 ? 1024 : 256;
        if (u.pm < 66) {
            const int wt = u.pn - WT0, cic = (wc & 1) * 32 + 8 * fq;
#pragma unroll
            for (int bj = 0; bj < 2; ++bj) {
                int kind, idx, flags; chunk_desc(L, wt * 4 + bj * 2 + (wc >> 1), kind, idx, flags);
                bf16_t* base = kind == 0 ? Q + (size_t)idx * SP * 64 : Kb + (size_t)idx * SP * 64;
                const size_t bstride = (size_t)(kind == 0 ? NQH : NKH) * SP * 64;
#pragma unroll
                for (int ai = 0; ai < 2; ++ai)
#pragma unroll
                    for (int m = 0; m < 4; ++m) {
                        const int row = u.pm * BM + ai * HALF + wr * 64 + m * 16 + fr;
                        const bool lat = row < NLAT;
                        const int b = lat ? (row >> 13) : ((row - NLAT) >> 8), t = row & 8191, pos = lat ? 256 + t : ((row - NLAT) & 255);
                        f32x4 v0 = acc[ai][bj][m][0] * wsc, v1 = acc[ai][bj][m][1] * wsc;
                        if ((flags & 1) && lat) {
                            const f32x4 c01 = *(const f32x4*)(ROPE + t * 32 + (cic >> 1)), c23 = *(const f32x4*)(ROPE + t * 32 + (cic >> 1) + 2);
                            const f32x4 a = v0, bq = v1;
                            v0[0] = a[0] * c01[0] - a[1] * c01[1]; v0[1] = a[0] * c01[1] + a[1] * c01[0];
                            v0[2] = a[2] * c01[2] - a[3] * c01[3]; v0[3] = a[2] * c01[3] + a[3] * c01[2];
                            v1[0] = bq[0] * c23[0] - bq[1] * c23[1]; v1[1] = bq[0] * c23[1] + bq[1] * c23[0];
                            v1[2] = bq[2] * c23[2] - bq[3] * c23[3]; v1[3] = bq[2] * c23[3] + bq[3] * c23[2];
                        }
                        u32x4 w; w.x = cvt_pk_bf16(v0[0], v0[1]); w.y = cvt_pk_bf16(v0[2], v0[3]); w.z = cvt_pk_bf16(v1[0], v1[1]); w.w = cvt_pk_bf16(v1[2], v1[3]);
                        *(u32x4*)(base + (size_t)b * bstride + (size_t)pos * 64 + cic) = w;
                    }
            }
        } else {
            const int wt = u.pm - WT0;
            const int vbase = L == 0 ? (wt == 4 ? 0 : wt == 5 ? 256 : wt == 10 ? 512 : 768) : 0;
            const int t = u.pn, b = t < 64 ? (t >> 5) : (t - 64), pos0 = t < 64 ? 256 + (t & 31) * 256 : 0;
#pragma unroll
            for (int ai = 0; ai < 2; ++ai)
#pragma unroll
                for (int m = 0; m < 4; ++m) {
                    bf16_t* rowp = VT + ((size_t)b * NVR + vbase + ai * HALF + wr * 64 + m * 16 + fr) * SP + pos0 + wc * 32 + 8 * fq;
#pragma unroll
                    for (int bj = 0; bj < 2; ++bj) { const f32x4 v0 = acc[ai][bj][m][0] * wsc, v1 = acc[ai][bj][m][1] * wsc;
                        u32x4 w; w.x = cvt_pk_bf16(v0[0], v0[1]); w.y = cvt_pk_bf16(v0[2], v0[3]); w.z = cvt_pk_bf16(v1[0], v1[1]); w.w = cvt_pk_bf16(v1[2], v1[3]);
                        *(u32x4*)(rowp + bj * HALF) = w; }
                }
        }
    }
};
}
__device__ __forceinline__ void phase_qkv(const Params& p, int L, int bid, int nb, unsigned char* smem) {
    pg8::Gemm g{(const bf16_t*)(p.ws + WS_H), (const bf16_t*)(p.ws + WS_H), 0, 0, D / 2};
    pg8::QkvSched So; So.init(L, nb, bid);
    pg8::EpiQkv E{L, (bf16_t*)(p.ws + WS_Q), (bf16_t*)(p.ws + WS_K), (bf16_t*)(p.ws + WS_VT), (const float2*)(p.ws + WS_ROPE), 1.0f / WQKV8_SCALE};
    pg8::gemm_phase<pg8::EpiQkv, pg8::QkvSched, true, true, true>((PG8_LAS unsigned char*)smem, g, So, E);
}

__device__ __forceinline__ void phase_knorm(const Params& p, int bid, int nb) {
    bf16_t* Kb = (bf16_t*)(p.ws + WS_K);
    const float2* ROPE = (const float2*)(p.ws + WS_ROPE);
    const int lane = threadIdx.x & 63, wv = threadIdx.x >> 6, nw = blockDim.x / 64;
    const float nwt = p.k_norm[lane];
    for (int it = bid * nw + wv; it < 2 * 2 * (SP / 8); it += nb * nw) {
        const int tile8 = it % (SP / 8), hb = it / (SP / 8), hd = hb & 1, b = hb >> 1;
        bf16_t* base = Kb + ((size_t)(b * 4 + hd) * SP + tile8 * 8) * 64 + lane;
#pragma unroll
        for (int i = 0; i < 8; ++i) {
            float v = bf2f(base[i * 64]);
            const float ss = wave_sum(v * v); v = v * rsqrtf(ss * (1.f / 64.f) + RMS_EPS) * nwt;
            if (tile8 >= 32) {
                const float2 cs = ROPE[(tile8 * 8 + i - 256) * 32 + (lane >> 1)];
                const float o = __shfl_xor(v, 1);
                v = (lane & 1) ? (o * cs.y + v * cs.x) : (v * cs.x - o * cs.y);
            }
            base[i * 64] = (bf16_t)f2bf(v);
        }
    }
}

__device__ __forceinline__ void phase_oproj(const Params& p, int L, int bid, int nb, unsigned char* smem) {
    const int M = L == 0 ? NTOK : NLAT;
    pg8::Gemm g{(const bf16_t*)(p.ws + WS_Y), (const bf16_t*)(p.ws + (L == 0 ? WS_WT_ABOUT : WS_WT_CDOUT)), M, D, D};
    pg8::StaticOrder So; So.init(M, D, nb, bid);
    pg8::EpiStoreBf16 E{(bf16_t*)(p.ws + WS_YO), D};
    pg8::gemm_phase<pg8::EpiStoreBf16, pg8::StaticOrder, true, true, false>((PG8_LAS unsigned char*)smem, g, So, E);
}

__device__ __forceinline__ void phase_ln1(const Params& p, int L, int bid, int nb, unsigned char* smem) {
    typedef float f32x4v __attribute__((ext_vector_type(4)));
    const float* MOD = (const float*)(p.ws + WS_MOD);
    const bf16_t* YO = (const bf16_t*)(p.ws + WS_YO);
    const float* X2 = (const float*)(p.ws + WS_X2);
    float* X1 = (float*)(p.ws + WS_X1);
    unsigned char* TOK8 = p.ws + WS_TOK;
    int* cnt = (int*)(p.ws + WS_CTL) + L * 32 * CNT_STRIDE;
    int* pair_e = (int*)(p.ws + WS_PAIR); int* pair_pos = pair_e + NTOK * 4; float* pair_gate = (float*)(pair_e + 3 * NTOK * 4);
    const int tidf = tid_fresh(); const int lane = tidf & 63, wv = tidf >> 6;
    constexpr int TKS = 1025;
    float* tokA = (float*)smem;
    float* part = (float*)(smem + 16 * TKS * 4 + 64);
    const LAS float* pl = (const LAS float*)(smem + LDS_PAR);
    int* lcnt = (int*)(smem + LDS_MISC);
    if (threadIdx.x < 2 * NE) lcnt[threadIdx.x] = 0;
    const int nrows = L == 0 ? NTOK : NLAT, ngrp = nrows / 16;
    const float* lg = p.ln1_g + L * D; const float* lb = p.ln1_b + L * D;
    const float* rw = p.router_w + (size_t)L * D * NE; const float* rb = p.router_b + L * NE;
    float4 xa[2][4]; uint2 ya[2][4];
    auto load_rows = [&](int g) {
        const int row0 = g * 16 + 2 * wv; const bool lt = row0 < NLAT;
        const float* xin0 = L == 0 ? (lt ? p.x + (size_t)row0 * D : p.ctx + (size_t)(row0 - NLAT) * D) : X2 + (size_t)row0 * D;
#pragma unroll
        for (int q = 0; q < 2; ++q)
#pragma unroll
            for (int j = 0; j < 4; ++j) { const int k = 4 * lane + 256 * j; xa[q][j] = *(const float4*)(xin0 + (size_t)q * D + k); ya[q][j] = *(const uint2*)(YO + (size_t)(row0 + q) * D + k); }
    };
    if (bid < ngrp) load_rows(bid);
    for (int grp = bid; grp < ngrp; grp += nb) {
        const int rowb = grp * 16; const bool lat = rowb < NLAT; const int rbat = lat ? (rowb >> 13) : 2;
        {
            const float* modb = MOD + (L * 3 + rbat) * 6144;
            __syncthreads();
            for (int i = threadIdx.x; i < 1280; i += blockDim.x) { const int vsel = i >> 8, idx = (i & 255) * 4;
                const float* src = vsel == 0 ? modb + 2048 : vsel == 1 ? modb + 3072 : vsel == 2 ? modb + 4096 : vsel == 3 ? lg : lb;
                const float4 t = *(const float4*)(src + idx);
                *(LAS float4v*)(smem + LDS_PAR + (vsel * 1024 + idx) * 4) = (float4v){t.x, t.y, t.z, t.w}; }
            __syncthreads();
        }
        {
            const int row0 = rowb + 2 * wv;
            float4 vq[2][4]; float sq[2];
#pragma unroll
            for (int q = 0; q < 2; ++q) {
                sq[q] = 0.f;
#pragma unroll
                for (int j = 0; j < 4; ++j) {
                    const int k = 4 * lane + 256 * j;
                    const float4 a = xa[q][j]; const uint2 yw = ya[q][j]; const float4 y = make_float4(bf2f(yw.x & 0xffffu), bf2f(yw.x >> 16), bf2f(yw.y & 0xffffu), bf2f(yw.y >> 16)); const float4v g = *(const LAS float4v*)(pl + k);
                    vq[q][j] = make_float4(ALPHA * a.x + g.x * y.x, ALPHA * a.y + g.y * y.y, ALPHA * a.z + g.z * y.z, ALPHA * a.w + g.w * y.w);
                    sq[q] += (vq[q][j].x + vq[q][j].y) + (vq[q][j].z + vq[q][j].w);
                }
            }
            if (grp + nb < ngrp) load_rows(grp + nb);
#pragma unroll
            for (int q = 0; q < 2; ++q) {
                const int row = row0 + q;
                float4 v[4]; float s = sq[q];
#pragma unroll
                for (int j = 0; j < 4; ++j) v[j] = vq[q][j];
                const float mean = wave_sum(s) * (1.f / D); float s2 = 0.f;
#pragma unroll
                for (int j = 0; j < 4; ++j) { v[j].x -= mean; v[j].y -= mean; v[j].z -= mean; v[j].w -= mean; s2 += (v[j].x * v[j].x + v[j].y * v[j].y) + (v[j].z * v[j].z + v[j].w * v[j].w); }
                const float rstd = rsqrtf(wave_sum(s2) * (1.f / D) + LN_EPS);
#pragma unroll
                for (int j = 0; j < 4; ++j) {
                    const int k = 4 * lane + 256 * j;
                    const float4v g = *(const LAS float4v*)(pl + 3072 + k), bb = *(const LAS float4v*)(pl + 4096 + k), a = *(const LAS float4v*)(pl + 2048 + k), b2 = *(const LAS float4v*)(pl + 1024 + k);
                    float4 x1 = make_float4(v[j].x * rstd * g.x + bb.x, v[j].y * rstd * g.y + bb.y, v[j].z * rstd * g.z + bb.z, v[j].w * rstd * g.w + bb.w);
                    *(float4*)(X1 + (size_t)row * D + k) = x1;
                    float4 tk = make_float4(x1.x * (1.f + a.x) + b2.x, x1.y * (1.f + a.y) + b2.y, x1.z * (1.f + a.z) + b2.z, x1.w * (1.f + a.w) + b2.w);
                    float* td = tokA + (2 * wv + q) * TKS + k; td[0] = tk.x; td[1] = tk.y; td[2] = tk.z; td[3] = tk.w;
                    *(unsigned*)(TOK8 + (size_t)row * D + k) = pk4_fp8(tk.x, tk.y, tk.z, tk.w);
                }
            }
        }
        __syncthreads();
        {
            f32x4v c0 = {0.f, 0.f, 0.f, 0.f}, c1 = {0.f, 0.f, 0.f, 0.f};
            const float* ta = tokA + (lane & 15) * TKS + 128 * wv + (lane >> 4);
            const float* wb = rw + (size_t)(128 * wv + (lane >> 4)) * NE + (lane & 15);
#pragma unroll 8
            for (int ks = 0; ks < 32; ++ks) {
                const float a = ta[4 * ks], b0 = wb[(size_t)(4 * ks) * NE], b1 = wb[(size_t)(4 * ks) * NE + 16];
                c0 = __builtin_amdgcn_mfma_f32_16x16x4f32(a, b0, c0, 0, 0, 0);
                c1 = __builtin_amdgcn_mfma_f32_16x16x4f32(a, b1, c1, 0, 0, 0);
            }
#pragma unroll
            for (int r = 0; r < 4; ++r) { float* pd = part + (wv * 16 + 4 * (lane >> 4) + r) * 32 + (lane & 15); pd[0] = c0[r]; pd[16] = c1[r]; }
        }
        __syncthreads();
        {
            const int e = lane & 31; const float rbe = rb[e];
#pragma unroll 1
            for (int q = 0; q < 2; ++q) {
                const int rl = 2 * wv + q, row = rowb + rl;
                float val = rbe;
#pragma unroll
                for (int w8 = 0; w8 < 8; ++w8) val += part[(w8 * 16 + rl) * 32 + e];
                int rank = 0;
#pragma unroll
                for (int j = 0; j < 32; ++j) { const float vj = __builtin_bit_cast(float, __builtin_amdgcn_readlane(__builtin_bit_cast(int, val), j)); rank += (vj > val || (vj == val && j < e)) ? 1 : 0; }
                float tv[4]; int ti[4];
#pragma unroll
                for (int rr = 0; rr < 4; ++rr) {
                    const unsigned msk = (unsigned)__ballot(rank == rr);
                    const int idx = __builtin_amdgcn_readfirstlane(__builtin_ctz(msk));
                    ti[rr] = idx; tv[rr] = __builtin_bit_cast(float, __builtin_amdgcn_readlane(__builtin_bit_cast(int, val), idx));
                }
                const float e0 = 1.f, e1 = __expf(tv[1] - tv[0]), e2 = __expf(tv[2] - tv[0]), e3 = __expf(tv[3] - tv[0]);
                const float inv = 1.f / (e0 + e1 + e2 + e3);
                const float gs4[4] = {e0 * inv, e1 * inv, e2 * inv, e3 * inv};
                if (lane == 0) {
#pragma unroll
                    for (int rr = 0; rr < 4; ++rr) {
                        const int pos = atomicAdd(&lcnt[ti[rr]], 1);
                        pair_e[row * 4 + rr] = ti[rr]; pair_pos[row * 4 + rr] = pos; pair_gate[row * 4 + rr] = gs4[rr];
                    }
                }
            }
        }
    }
    __syncthreads();
    if (threadIdx.x < NE) lcnt[NE + threadIdx.x] = atomicAdd(&cnt[threadIdx.x * CNT_STRIDE], lcnt[threadIdx.x]);
    __syncthreads();
    int* etok = (int*)(p.ws + WS_XB); float* egate = (float*)(p.ws + WS_XB + 4 * MiB);
    for (int grp = bid; grp < ngrp; grp += nb)
        if (threadIdx.x < 64) { const int pr = grp * 64 + threadIdx.x, e = pair_e[pr], pos = pair_pos[pr] + lcnt[NE + e];
            pair_pos[pr] = pos; etok[e * ECAP + pos] = pr >> 2; egate[e * ECAP + pos] = pair_gate[pr]; }
    __syncthreads();
}

__device__ __forceinline__ int moe_tile_table(const Params& p, int L, unsigned char* smem) {
    const int* cnt = (const int*)(p.ws + WS_CTL) + L * 32 * CNT_STRIDE;
    LAS int* tab = (LAS int*)(smem + LDS_MISC);
    __syncthreads();
    if (threadIdx.x == 0) { int t = 0;
        for (int e = 0; e < NE; ++e) { const int n = (cnt[e * CNT_STRIDE] + 255) / 256; tab[PSTART_AT + e] = t * 256; for (int q = 0; q < n; ++q) { tab[TOFF_AT + t] = e * ECAP - (t - q) * 256; tab[t++] = e; } }
        tab[320] = t; }
    __syncthreads();
    return tab[320];
}
__device__ __forceinline__ void phase_moe1(const Params& p, int L, int bid, int nb, unsigned char* smem) {
    const int T = moe_tile_table(p, L, smem);
    {
        const PG8_LAS int* tab = (const PG8_LAS int*)(smem + LDS_MISC);
        const int* pair_e = (const int*)(p.ws + WS_PAIR); const int* pair_pos = pair_e + NTOK * 4; int* pair_slot = (int*)pair_e + 2 * NTOK * 4;
        const int npairs = (L == 0 ? NTOK : NLAT) * 4;
        for (int pr = bid * blockDim.x + threadIdx.x; pr < npairs; pr += nb * blockDim.x) pair_slot[pr] = tab[PSTART_AT + pair_e[pr]] + pair_pos[pr];
    }
    pg8::Gemm g{(const bf16_t*)(p.ws + WS_TOK), (const bf16_t*)(p.ws + WS_WT_MIN + (size_t)L * 32 * 2048 * 1024), MAXSLOT, 32 * 2048, D / 2, (const int*)(p.ws + WS_XB)};
    pg8::MoeSched So; So.init(T, 8, nb, bid, (const PG8_LAS int*)(smem + LDS_MISC));
    pg8::EpiMoe1 E{(bf16_t*)(p.ws + WS_ACT), p.moe_b_in + (size_t)L * 32 * 2048, 1.0f / W8_SCALE};
    pg8::gemm_phase<pg8::EpiMoe1, pg8::MoeSched, true, true, true, true>((PG8_LAS unsigned char*)smem, g, So, E);
}
__device__ __forceinline__ void phase_moe2(const Params& p, int L, int bid, int nb, unsigned char* smem) {
    const int T = moe_tile_table(p, L, smem);
    pg8::Gemm g{(const bf16_t*)(p.ws + WS_ACT), (const bf16_t*)(p.ws + WS_WT_MOUT + (size_t)L * 32 * 1024 * 1024), MAXSLOT, 32 * 1024, D / 2};
    pg8::MoeSched So; So.init(T, 4, nb, bid, (const PG8_LAS int*)(smem + LDS_MISC));
    pg8::EpiMoe2 E{(bf16_t*)(p.ws + WS_YP), p.moe_b_out + (size_t)L * 32 * 1024, (const float*)(p.ws + WS_XB + 4 * MiB), 1.0f / (ACT8_SCALE * W8O_SCALE), (const PG8_LAS int*)(smem + LDS_MISC) + TOFF_AT};
    pg8::gemm_phase<pg8::EpiMoe2, pg8::MoeSched, true, true, true>((PG8_LAS unsigned char*)smem, g, So, E);
}

__device__ __forceinline__ void phase_ln2(const Params& p, int L, int bid, int nb) {
    const float* MOD = (const float*)(p.ws + WS_MOD);
    const float* X1 = (const float*)(p.ws + WS_X1);
    const unsigned char* YP8 = p.ws + WS_YP;
    const int* pair_slot = (const int*)(p.ws + WS_PAIR) + 2 * NTOK * 4;
    float* X2 = (float*)(p.ws + WS_X2); unsigned char* H8 = p.ws + WS_H;
    const int lane = threadIdx.x & 63, wv = threadIdx.x >> 6, nw = blockDim.x / 64;
    const int nrows = L == 0 ? NTOK : NLAT;
    const float* lg = p.ln2_g + L * D; const float* lb = p.ln2_b + L * D;
    for (int rp = bid * nw + wv; rp < nrows / 2; rp += nb * nw) {
        const int row0 = rp * 2;
        const bool lat = row0 < NLAT; const int r = lat ? (row0 >> 13) : 2;
        const float* mod = MOD + (L * 3 + r) * 6144; const float* g2 = mod + 5120;
        const float* modn = MOD + ((L == 0 ? 1 : 0) * 3 + r) * 6144;
        int sl[2][4];
#pragma unroll
        for (int q = 0; q < 2; ++q)
#pragma unroll
            for (int t = 0; t < 4; ++t) sl[q][t] = pair_slot[(row0 + q) * 4 + t];
        float4 xa[2][4]; unsigned yw[2][4][4];
#pragma unroll
        for (int q = 0; q < 2; ++q)
#pragma unroll
            for (int j = 0; j < 4; ++j) { const int k = 4 * lane + 256 * j; xa[q][j] = *(const float4*)(X1 + (size_t)(row0 + q) * D + k);
#pragma unroll
                for (int t = 0; t < 4; ++t) yw[q][j][t] = *(const unsigned*)(YP8 + (size_t)sl[q][t] * D + k); }
        float4 fs[2][4];
#pragma unroll
        for (int q = 0; q < 2; ++q)
#pragma unroll
            for (int j = 0; j < 4; ++j) { float4 f = make_float4(0.f, 0.f, 0.f, 0.f);
#pragma unroll
                for (int t = 0; t < 4; ++t) { const unsigned w = yw[q][j][t]; const f2v lo = __builtin_amdgcn_cvt_pk_f32_fp8(w, false), hi = __builtin_amdgcn_cvt_pk_f32_fp8(w, true); f.x += lo.x; f.y += lo.y; f.z += hi.x; f.w += hi.y; }
                fs[q][j] = make_float4(f.x * (1.f / YP8_SCALE), f.y * (1.f / YP8_SCALE), f.z * (1.f / YP8_SCALE), f.w * (1.f / YP8_SCALE)); }
#pragma unroll 1
        for (int q = 0; q < 2; ++q) {
            const int row = row0 + q;
            float4 v[4]; float s = 0.f;
#pragma unroll
            for (int j = 0; j < 4; ++j) {
                const int k = 4 * lane + 256 * j;
                float4 f = q == 0 ? fs[0][j] : fs[1][j];
                const float4 a = q == 0 ? xa[0][j] : xa[1][j], g = *(const float4*)(g2 + k);
                v[j] = make_float4(ALPHA * a.x + g.x * f.x, ALPHA * a.y + g.y * f.y, ALPHA * a.z + g.z * f.z, ALPHA * a.w + g.w * f.w);
                s += (v[j].x + v[j].y) + (v[j].z + v[j].w);
            }
            const float mean = wave_sum(s) * (1.f / D); float s2 = 0.f;
#pragma unroll
            for (int j = 0; j < 4; ++j) { v[j].x -= mean; v[j].y -= mean; v[j].z -= mean; v[j].w -= mean; s2 += (v[j].x * v[j].x + v[j].y * v[j].y) + (v[j].z * v[j].z + v[j].w * v[j].w); }
            const float rstd = rsqrtf(wave_sum(s2) * (1.f / D) + LN_EPS);
#pragma unroll
            for (int j = 0; j < 4; ++j) {
                const int k = 4 * lane + 256 * j;
                const float4 g = *(const float4*)(lg + k), bb = *(const float4*)(lb + k);
                const float4 x2 = make_float4(v[j].x * rstd * g.x + bb.x, v[j].y * rstd * g.y + bb.y, v[j].z * rstd * g.z + bb.z, v[j].w * rstd * g.w + bb.w);
                if (L == 0) {
                    *(float4*)(X2 + (size_t)row * D + k) = x2;
                    const float4 b = *(const float4*)(modn + k), a = *(const float4*)(modn + 1024 + k);
                    *(unsigned*)(H8 + (size_t)row * D + k) = pk4_fp8(x2.x * (1.f + a.x) + b.x, x2.y * (1.f + a.y) + b.y, x2.z * (1.f + a.z) + b.z, x2.w * (1.f + a.w) + b.w);
                } else {
                    *(float4*)(p.out + (size_t)row * D + k) = x2;
                }
            }
        }
    }
}

namespace att {
typedef short bf16x8 __attribute__((ext_vector_type(8)));
typedef float f32x16 __attribute__((ext_vector_type(16)));
typedef unsigned u4v __attribute__((ext_vector_type(4)));
typedef unsigned u2v __attribute__((ext_vector_type(2)));
constexpr int KROWB = 144, VROWB = 136, KBUF = 64 * KROWB, VBUF = 128 * VROWB;
constexpr int L_K = 0, L_V = 4 * KBUF, L_BIAS = 4 * KBUF + 4 * VBUF, L_X = L_BIAS + 2048, L_END = L_X + 2048;
constexpr float LOG2E = 1.4426950408889634f, C2 = 0.125f * LOG2E, NEGBIG = -1e30f;
constexpr float THR_L2 = 8.0f;
__device__ __forceinline__ int crow(int r, int hi) { return (r & 3) + 8 * (r >> 2) + 4 * hi; }
__device__ __forceinline__ unsigned cvtpk(float lo, float hi) { unsigned r; asm volatile("v_cvt_pk_bf16_f32 %0, %1, %2" : "=v"(r) : "v"(lo), "v"(hi)); return r; }
__device__ __forceinline__ float xhalf_max(float v) { auto rr = __builtin_amdgcn_permlane32_swap(__float_as_uint(v), __float_as_uint(v), false, false); return fmaxf(__uint_as_float(rr[0]), __uint_as_float(rr[1])); }
__device__ __forceinline__ float xhalf_sum(float v) { auto rr = __builtin_amdgcn_permlane32_swap(__float_as_uint(v), __float_as_uint(v), false, false); return __uint_as_float(rr[0]) + __uint_as_float(rr[1]); }

template <int VR> struct TileRegs { u4v k; u4v v[VR / 64]; };
template <int VR>
__device__ __forceinline__ void tile_load(TileRegs<VR>& t, const bf16_t* Kh, const bf16_t* VTh, int pos0, int tid) {
    const int row = tid >> 3, ch = tid & 7;
    t.k = *(const u4v*)(Kh + (size_t)(pos0 + row) * 64 + ch * 8);
#pragma unroll
    for (int i = 0; i < VR / 64; ++i) t.v[i] = *(const u4v*)(VTh + (size_t)(row + 64 * i) * SP + pos0 + ch * 8);
}
template <int VR>
__device__ __forceinline__ void tile_store(const TileRegs<VR>& t, LAS unsigned char* lds, int buf, int tid) {
    const int row = tid >> 3, ch = tid & 7;
    *(LAS u4v*)(lds + L_K + buf * KBUF + row * KROWB + ch * 16) = t.k;
#pragma unroll
    for (int i = 0; i < VR / 64; ++i) {
        LAS u2v* d = (LAS u2v*)(lds + L_V + buf * VBUF + (row + 64 * i) * VROWB + ch * 16);
        d[0] = (u2v){t.v[i].x, t.v[i].y}; d[1] = (u2v){t.v[i].z, t.v[i].w};
    }
}

struct MaskArgs { int rq, cq; const LAS float* biasL; };

template <int MODE>
__device__ __forceinline__ void softmax_half(f32x16& p, bf16x8 (&pb)[2], f32x16 (&o)[2], float& m, float& l, bf16x8& qx, int kpos0  , bool lat, int qp, int rq, int cq, const LAS float* biasL, int hi) {
    float mx = NEGBIG;
#pragma unroll
    for (int r = 0; r < 16; ++r) {
        float t = p[r];
        if (MODE == 1) { if (lat) { const int dd = qp - (kpos0 + crow(r, hi)); if (dd > 128 || dd < -128) t = NEGBIG; } }
        if (MODE == 2) {
            if (lat) {
                const int krow = (kpos0 - 256) >> 6, kc = ((kpos0 - 256) & 63) + crow(r, hi);
                const int ws = min(max(cq - 8, 0), 48);
                const bool valid = (unsigned)(kc - ws) < 16u;
                const int dc = min(max(kc - cq + 15, 0), 30);
                const float bv = biasL[(krow - rq + 7) * 31 + dc];
                t = valid ? t + bv : NEGBIG; } }
        if (MODE != 0) p[r] = t;
        mx = fmaxf(mx, t);
    }
    mx = xhalf_max(mx);
    if (__any(mx > THR_L2)) {
        const float mn = bf2f(f2bf(m + fmaxf(mx, 0.f))), dl = mn - m, alpha = __builtin_amdgcn_exp2f(-dl);
        m = mn; l *= alpha;
#pragma unroll
        for (int dt = 0; dt < 2; ++dt)
#pragma unroll
            for (int r = 0; r < 16; ++r) o[dt][r] *= alpha;
#pragma unroll
        for (int r = 0; r < 16; ++r) p[r] -= dl;
        qx[0] = (short)(hi == 0 ? f2bf(-mn) : 0u);
    }
    float sum = 0.f;
#pragma unroll
    for (int r = 0; r < 16; ++r) { const float e = __builtin_amdgcn_exp2f(p[r]); p[r] = e; sum += e; }
    l += sum;
#pragma unroll
    for (int s = 0; s < 2; ++s) {
        const int s8 = s * 8;
        u4v w; w.x = cvtpk(p[s8 + 0], p[s8 + 1]); w.y = cvtpk(p[s8 + 2], p[s8 + 3]); w.z = cvtpk(p[s8 + 4], p[s8 + 5]); w.w = cvtpk(p[s8 + 6], p[s8 + 7]);
        pb[s] = __builtin_bit_cast(bf16x8, w);
    }
}

template <int VR, int MODE, bool QPROC = false>
__device__ __forceinline__ void attn_pass(LAS unsigned char* lds, const bf16_t* Qh, const bf16_t* Kh, const bf16_t* VTh, int qpw, int vrow, bool wave_on, int ta0, int na, int tb0, int nbt,
                                          f32x16 (&o)[2][2], float (&m)[2], float (&l)[2], int rq, const LAS float* biasL, const float* qw = nullptr, const float2* ROPE = nullptr) {
    int tid = threadIdx.x; asm volatile("" : "+v"(tid));
    const int lane = tid & 63, r32 = lane & 31, hi = lane >> 5;
    bf16x8 qf[2][4];
#pragma unroll
    for (int j = 0; j < 2; ++j)
#pragma unroll
        for (int ks = 0; ks < 4; ++ks) qf[j][ks] = *(const bf16x8*)(Qh + (size_t)(qpw + 32 * j + r32) * 64 + ks * 16 + hi * 8);
    if (QPROC) {
#pragma unroll
        for (int j = 0; j < 2; ++j) {
            float v[4][8]; float ss = 0.f;
#pragma unroll
            for (int ks = 0; ks < 4; ++ks)
#pragma unroll
                for (int e = 0; e < 8; ++e) { v[ks][e] = bf2f((unsigned short)qf[j][ks][e]); ss += v[ks][e] * v[ks][e]; }
            const float sc = rsqrtf(xhalf_sum(ss) * (1.f / 64.f) + RMS_EPS) * C2;
            const int t = qpw + 32 * j + r32 - 256;
#pragma unroll
            for (int ks = 0; ks < 4; ++ks) {
                const int d0 = 16 * ks + 8 * hi;
                const float4 w0 = *(const float4*)(qw + d0), w1 = *(const float4*)(qw + d0 + 4);
                const float4 c01 = *(const float4*)(ROPE + t * 32 + (d0 >> 1)), c23 = *(const float4*)(ROPE + t * 32 + (d0 >> 1) + 2);
                const float x0 = v[ks][0] * sc * w0.x, x1 = v[ks][1] * sc * w0.y, x2 = v[ks][2] * sc * w0.z, x3 = v[ks][3] * sc * w0.w;
                const float x4 = v[ks][4] * sc * w1.x, x5 = v[ks][5] * sc * w1.y, x6 = v[ks][6] * sc * w1.z, x7 = v[ks][7] * sc * w1.w;
                u4v w; w.x = cvtpk(x0 * c01.x - x1 * c01.y, x0 * c01.y + x1 * c01.x); w.y = cvtpk(x2 * c01.z - x3 * c01.w, x2 * c01.w + x3 * c01.z);
                w.z = cvtpk(x4 * c23.x - x5 * c23.y, x4 * c23.y + x5 * c23.x); w.w = cvtpk(x6 * c23.z - x7 * c23.w, x6 * c23.w + x7 * c23.z);
                qf[j][ks] = __builtin_bit_cast(bf16x8, w);
            }
        }
    }
    if (!QPROC) {
#pragma unroll
        for (int j = 0; j < 2; ++j)
#pragma unroll
            for (int ks = 0; ks < 4; ++ks) { u4v w;
#pragma unroll
                for (int e2 = 0; e2 < 4; ++e2) w[e2] = cvtpk(bf2f((unsigned short)qf[j][ks][2 * e2]) * C2, bf2f((unsigned short)qf[j][ks][2 * e2 + 1]) * C2);
                qf[j][ks] = __builtin_bit_cast(bf16x8, w); }
    }
    bf16x8 qx[2]; bf16x8 kone;
#pragma unroll
    for (int e = 0; e < 8; ++e) { qx[0][e] = 0; qx[1][e] = 0; kone[e] = 0; }
    kone[0] = (short)(hi == 0 ? 0x3f80 : 0);
#pragma unroll
    for (int j = 0; j < 2; ++j) {
        m[j] = 0.f; l[j] = 0.f;
#pragma unroll
        for (int dt = 0; dt < 2; ++dt)
#pragma unroll
            for (int r = 0; r < 16; ++r) o[j][dt][r] = 0.f;
    }
    const int n = na + nbt;
    TileRegs<VR> tr;
#define ATT_TPOS(i_) (((i_) < na ? ta0 + (i_) : tb0 + ((i_) - na)) * 64)
    tile_load<VR>(tr, Kh, VTh, ATT_TPOS(0), tid); tile_store<VR>(tr, lds, 0, tid);
    if (n > 1) { tile_load<VR>(tr, Kh, VTh, ATT_TPOS(1), tid); tile_store<VR>(tr, lds, 1, tid); }
    __syncthreads();
    for (int ip = 0; 2 * ip < n; ++ip) {
        const int cb = ip & 1;
#pragma unroll
        for (int h2 = 0; h2 < 2; ++h2) {
            const int i = 2 * ip + h2, inx = i + 2;
            if (inx < n) tile_load<VR>(tr, Kh, VTh, ATT_TPOS(inx), tid);
            if (i < n) {
                const int pos0 = ATT_TPOS(i), slot = 2 * cb + h2;
                bool active = wave_on;
                if (MODE == 1 && pos0 >= 256) active = active && (pos0 <= qpw + 63 + 128) && (pos0 + 63 >= qpw - 128);
                if (MODE == 2 && pos0 >= 256) { const int krow = (pos0 - 256) >> 6, rs = min(max(rq - 4, 0), 120); active = active && (krow >= rs) && (krow < rs + 8); }
        if (active) {
                    const LAS unsigned char* kb = lds + L_K + slot * KBUF;
                    const LAS unsigned char* vb = lds + L_V + slot * VBUF + vrow * VROWB;
        #pragma unroll
                    for (int kt = 0; kt < 2; ++kt) {
                        f32x16 p[2];
        #pragma unroll
                        for (int r = 0; r < 16; ++r) { p[0][r] = 0.f; p[1][r] = 0.f; }
        #pragma unroll
                        for (int ks = 0; ks < 4; ++ks) {
                            const bf16x8 a = *(const LAS bf16x8*)(kb + (32 * kt + r32) * KROWB + ks * 32 + hi * 16);
                            p[0] = __builtin_amdgcn_mfma_f32_32x32x16_bf16(a, qf[0][ks], p[0], 0, 0, 0);
                            p[1] = __builtin_amdgcn_mfma_f32_32x32x16_bf16(a, qf[1][ks], p[1], 0, 0, 0);
                        }
                        p[0] = __builtin_amdgcn_mfma_f32_32x32x16_bf16(kone, qx[0], p[0], 0, 0, 0);
                        p[1] = __builtin_amdgcn_mfma_f32_32x32x16_bf16(kone, qx[1], p[1], 0, 0, 0);
                        bf16x8 pb[2][2];
                        softmax_half<MODE>(p[0], pb[0], o[0], m[0], l[0], qx[0], pos0 + 32 * kt, pos0 >= 256, qpw + r32, rq, r32, biasL, hi);
                        softmax_half<MODE>(p[1], pb[1], o[1], m[1], l[1], qx[1], pos0 + 32 * kt, pos0 >= 256, qpw + 32 + r32, rq, 32 + r32, biasL, hi);
        #pragma unroll
                        for (int dt = 0; dt < 2; ++dt)
        #pragma unroll
                            for (int s = 0; s < 2; ++s) {
                                const int sp = 2 * kt + s;
                                const LAS unsigned char* vp = vb + (32 * dt + r32) * VROWB + (16 * sp + 4 * hi) * 2;
                                const u2v lo = *(const LAS u2v*)vp, hi2 = *(const LAS u2v*)(vp + 16);
                                const bf16x8 a = __builtin_bit_cast(bf16x8, (u4v){lo.x, lo.y, hi2.x, hi2.y});
                                o[0][dt] = __builtin_amdgcn_mfma_f32_32x32x16_bf16(a, pb[0][s], o[0][dt], 0, 0, 0);
                                o[1][dt] = __builtin_amdgcn_mfma_f32_32x32x16_bf16(a, pb[1][s], o[1][dt], 0, 0, 0);
                            }
                    }
                }
            }
            if (inx < n) tile_store<VR>(tr, lds, 2 * (cb ^ 1) + h2, tid);
        }
        __syncthreads();
    }
#undef ATT_TPOS
}

__device__ __forceinline__ void store_out(bf16_t* yrow  , const f32x16 (&o)[2], float sc, int hi) {
#pragma unroll
    for (int dt = 0; dt < 2; ++dt)
#pragma unroll
        for (int g = 0; g < 4; ++g) {
            uint2 w; w.x = cvtpk(o[dt][4 * g + 0] * sc, o[dt][4 * g + 1] * sc); w.y = cvtpk(o[dt][4 * g + 2] * sc, o[dt][4 * g + 3] * sc);
            *(uint2*)(yrow + 32 * dt + 8 * g + 4 * hi) = w;
        }
}
}


constexpr int BG_OFF = 110592;
__device__ __forceinline__ int bg_region(int w) { return w < 5 ? BG_OFF + w * 4096 : LDS_PAR + (w - 5) * 4096; }
constexpr int BG_SLOTS = 96, BG_VB = 256;
struct BgConv { int s, end; bool fly; const float* src; unsigned char* dst; };
__device__ __forceinline__ void bg_seek(const Params& p, BgConv& bg, int vb) {
    if (bg.s < 64) {
        const int n0 = (vb & 31) * 64, k0 = (vb >> 5) * 128, nn = n0 & 1023, drow = 256 * (nn >> 7) + (nn & 127) + (n0 >= 1024 ? 128 : 0);
        bg.src = p.moe_w_in + (size_t)bg.s * 1024 * 2048 + (size_t)k0 * 2048 + n0;
        bg.dst = p.ws + WS_WT_MIN + (size_t)bg.s * 2048 * 1024 + (size_t)drow * 1024 + k0;
    } else {
        const int le = 2 * (bg.s - 64) + (vb >> 7), q2 = vb & 127, n0 = (q2 & 15) * 64, k0 = (q2 >> 4) * 128;
        bg.src = p.moe_w_out + (size_t)le * 1024 * 1024 + (size_t)k0 * 1024 + n0;
        bg.dst = p.ws + WS_WT_MOUT + (size_t)le * 1024 * 1024 + (size_t)n0 * 1024 + k0;
    }
}
__device__ __forceinline__ void bg_start(LAS unsigned char* lds, BgConv& bg) {
    if (bg.s < bg.end) {
        int tid = threadIdx.x; asm volatile("" : "+v"(tid));
        const int lane = tid & 63, w = __builtin_amdgcn_readfirstlane(tid >> 6);
        const int sh = bg.s < 64 ? 11 : 10;
        bg.fly = true;
        const float* src = bg.src + (((size_t)(16 * w + (lane >> 4))) << sh) + 4 * (lane & 15);
        const unsigned l0 = __builtin_amdgcn_readfirstlane((unsigned)(size_t)(lds + bg_region(w)));
        const size_t st = (size_t)4 << sh;
        const float* s1 = src + st; const float* s2 = src + 2 * st; const float* s3 = src + 3 * st;
        asm volatile("s_mov_b32 m0, %4\n\ts_nop 0\n\tglobal_load_lds_dwordx4 %0, off\n\t"
                     "s_mov_b32 m0, %5\n\ts_nop 0\n\tglobal_load_lds_dwordx4 %1, off\n\t"
                     "s_mov_b32 m0, %6\n\ts_nop 0\n\tglobal_load_lds_dwordx4 %2, off\n\t"
                     "s_mov_b32 m0, %7\n\ts_nop 0\n\tglobal_load_lds_dwordx4 %3, off"
                     :: "v"(src), "v"(s1), "v"(s2), "v"(s3), "s"(l0), "s"(l0 + 1024u), "s"(l0 + 2048u), "s"(l0 + 3072u) : "m0", "memory");
    }
}
__device__ __forceinline__ void bg_finish(const Params& p, LAS unsigned char* lds, BgConv& bg, int vb) {
    if (bg.fly) {
        asm volatile("s_waitcnt vmcnt(0)" ::: "memory");
        int tid = threadIdx.x; asm volatile("" : "+v"(tid));
        const int lane = tid & 63, w = __builtin_amdgcn_readfirstlane(tid >> 6);
        const LAS float* sp = (const LAS float*)(lds + bg_region(w)) + lane;
        const float sc = bg.s < 64 ? W8_SCALE : W8O_SCALE;
        float v[16];
#pragma unroll
        for (int i = 0; i < 16; ++i) v[i] = sp[i * 64] * sc;
        uint4 o; o.x = pk4_fp8(v[0], v[1], v[2], v[3]); o.y = pk4_fp8(v[4], v[5], v[6], v[7]); o.z = pk4_fp8(v[8], v[9], v[10], v[11]); o.w = pk4_fp8(v[12], v[13], v[14], v[15]);
        *(uint4*)(bg.dst + (size_t)lane * 1024 + 16 * w) = o;
        asm volatile("s_waitcnt lgkmcnt(0)" ::: "memory");
        bg.fly = false; ++bg.s;
        if (bg.s == 64) bg_seek(p, bg, vb); else { bg.src += 2 * 1024 * 1024; bg.dst += 2 * 1024 * 1024; }
    }
}
namespace attd {
typedef short bf16x8 __attribute__((ext_vector_type(8)));
typedef float f32x16 __attribute__((ext_vector_type(16)));
typedef unsigned u4v __attribute__((ext_vector_type(4)));
typedef unsigned u2v __attribute__((ext_vector_type(2)));
constexpr int KROWB = 144, VROWB = 136, KBUF = 64 * KROWB, VBUF = 128 * VROWB;
constexpr int L_K = 0, L_V = 4 * KBUF, L_BIAS = 4 * KBUF + 4 * VBUF, L_END = L_BIAS + 2048;
constexpr float LOG2E = 1.4426950408889634f, C2 = 0.125f * LOG2E, NEGBIG = -1e30f;
__device__ __forceinline__ int crow(int r, int hi) { return (r & 3) + 8 * (r >> 2) + 4 * hi; }
__device__ __forceinline__ unsigned cvtpk(float lo, float hi) { unsigned r; asm volatile("v_cvt_pk_bf16_f32 %0, %1, %2" : "=v"(r) : "v"(lo), "v"(hi)); return r; }

template <int DV> struct TileRegs { u4v k; u4v v[DV / 64]; };
template <int DV>
__device__ __forceinline__ void tile_load(TileRegs<DV>& t, const bf16_t* Kh, const bf16_t* VTh, int pos0, int tid) {
    const int row = tid >> 3, ch = tid & 7;
    t.k = *(const u4v*)(Kh + (size_t)(pos0 + row) * 64 + ch * 8);
#pragma unroll
    for (int i = 0; i < DV / 64; ++i) t.v[i] = *(const u4v*)(VTh + (size_t)(row + 64 * i) * SP + pos0 + ch * 8);
}
template <int DV>
__device__ __forceinline__ void tile_store(const TileRegs<DV>& t, LAS unsigned char* lds, int kbuf, int vbuf, int tid) {
    const int row = tid >> 3, ch = tid & 7;
    *(LAS u4v*)(lds + L_K + kbuf * KBUF + row * KROWB + ch * 16) = t.k;
#pragma unroll
    for (int i = 0; i < DV / 64; ++i) {
        LAS u2v* d = (LAS u2v*)(lds + L_V + vbuf * VBUF + (row + 64 * i) * VROWB + ch * 16);
        d[0] = (u2v){t.v[i].x, t.v[i].y}; d[1] = (u2v){t.v[i].z, t.v[i].w};
    }
}

struct MaskArgs { int rq, cq; const LAS float* biasL; };
constexpr float THR_L2 = 8.0f;

__device__ __forceinline__ void qk_step(f32x16 (&p)[2], const LAS unsigned char* kb, const bf16x8 (&qf)[4], int r32, int hi) {
#pragma unroll
    for (int kt = 0; kt < 2; ++kt) {
#pragma unroll
        for (int r = 0; r < 16; ++r) p[kt][r] = 0.f;
#pragma unroll
        for (int ks = 0; ks < 4; ++ks) {
            const bf16x8 a = *(const LAS bf16x8*)(kb + (32 * kt + r32) * KROWB + ks * 32 + hi * 16);
            p[kt] = __builtin_amdgcn_mfma_f32_32x32x16_bf16(a, qf[ks], p[kt], 0, 0, 0);
        }
    }
}
template <int DV, int MODE>
__device__ __forceinline__ void softmax_step(f32x16 (&p)[2], bf16x8 (&pb)[4], f32x16 (&o)[DV / 32], float& m, float& l, int pos0, int qp, const MaskArgs& ma, int hi) {
    constexpr float XS = (MODE == 2) ? 1.0f : C2;
    constexpr float THR = THR_L2 / XS;
    float mx; float mxp[4] = {NEGBIG, NEGBIG, NEGBIG, NEGBIG};
#pragma unroll
    for (int kt = 0; kt < 2; ++kt)
#pragma unroll
        for (int r = 0; r < 16; ++r) {
            float t = p[kt][r];
            if (MODE == 1) { if (pos0 >= 256) { const int dd = qp - (pos0 + 32 * kt + crow(r, hi)); if (dd > 128 || dd < -128) t = NEGBIG; } }
            if (MODE == 2) {
                t *= C2;
                if (pos0 >= 256) {
                    const int krow = (pos0 - 256) >> 6, kc = 32 * kt + crow(r, hi);
                    const int ws = min(max(ma.cq - 8, 0), 48);
                    const bool valid = (unsigned)(kc - ws) < 16u;
                    const int dc = min(max(kc - ma.cq + 15, 0), 30);
                    const float bv = ma.biasL[(krow - ma.rq + 7) * 31 + dc];
                    t = valid ? t + bv : NEGBIG; } }
            p[kt][r] = t; mxp[r & 3] = fmaxf(mxp[r & 3], t);
        }
    mx = fmaxf(fmaxf(mxp[0], mxp[1]), fmaxf(mxp[2], mxp[3]));
    { auto rr = __builtin_amdgcn_permlane32_swap(__float_as_uint(mx), __float_as_uint(mx), false, false);
      mx = fmaxf(__uint_as_float(rr[0]), __uint_as_float(rr[1])); }
    if (__any(mx > m + THR)) {
        const float mn = fmaxf(m, mx), alpha = __builtin_amdgcn_exp2f((m - mn) * XS);
        m = mn; l *= alpha;
#pragma unroll
        for (int dt = 0; dt < DV / 32; ++dt)
#pragma unroll
            for (int r = 0; r < 16; ++r) o[dt][r] *= alpha;
    }
    const float nm = -m * XS;
    float sm[4] = {0.f, 0.f, 0.f, 0.f};
#pragma unroll
    for (int kt = 0; kt < 2; ++kt)
#pragma unroll
        for (int r = 0; r < 16; ++r) { const float e = __builtin_amdgcn_exp2f(MODE == 2 ? p[kt][r] + nm : fmaf(p[kt][r], C2, nm)); p[kt][r] = e; sm[r & 3] += e; }
    l += (sm[0] + sm[1]) + (sm[2] + sm[3]);
#pragma unroll
    for (int sp = 0; sp < 4; ++sp) {
        const int kt = sp >> 1, s8 = (sp & 1) * 8;
        u4v w; w.x = cvtpk(p[kt][s8 + 0], p[kt][s8 + 1]); w.y = cvtpk(p[kt][s8 + 2], p[kt][s8 + 3]); w.z = cvtpk(p[kt][s8 + 4], p[kt][s8 + 5]); w.w = cvtpk(p[kt][s8 + 6], p[kt][s8 + 7]);
        pb[sp] = __builtin_bit_cast(bf16x8, w);
    }
}
template <int DV>
__device__ __forceinline__ void pv_step(f32x16 (&o)[DV / 32], const LAS unsigned char* vb, const bf16x8 (&pb)[4], int r32, int hi) {
#pragma unroll
    for (int dt = 0; dt < DV / 32; ++dt)
#pragma unroll
        for (int sp = 0; sp < 4; ++sp) {
            const LAS unsigned char* vp = vb + (32 * dt + r32) * VROWB + (16 * sp + 4 * hi) * 2;
            const u2v lo = *(const LAS u2v*)vp, hi2 = *(const LAS u2v*)(vp + 16);
            const u4v w = (u4v){lo.x, lo.y, hi2.x, hi2.y};
            o[dt] = __builtin_amdgcn_mfma_f32_32x32x16_bf16(__builtin_bit_cast(bf16x8, w), pb[sp], o[dt], 0, 0, 0);
        }
}

template <int DV, int MODE, int PINGPONG = 1>
__device__ __forceinline__ void attn_pass(LAS unsigned char* lds, const bf16_t* Qh, const bf16_t* Kh, const bf16_t* VTh, int qpos0, int ta0, int na, int tb0, int nbt,
                                          f32x16 (&o)[DV / 32], float& m, float& l, const MaskArgs& ma, const float* qnorm_w, const Params& prm, BgConv& bg, int bid, int nb) {
    int tid = threadIdx.x; asm volatile("" : "+v"(tid));
    const int lane = tid & 63, w = __builtin_amdgcn_readfirstlane(tid >> 6), r32 = lane & 31, hi = lane >> 5;
    const int qp = qpos0 + 32 * w + r32;
    bf16x8 qf[4];
#pragma unroll
    for (int ks = 0; ks < 4; ++ks) qf[ks] = *(const bf16x8*)(Qh + (size_t)qp * 64 + ks * 16 + hi * 8);
#pragma unroll
    for (int dt = 0; dt < DV / 32; ++dt)
#pragma unroll
        for (int r = 0; r < 16; ++r) o[dt][r] = 0.f;
    m = NEGBIG; l = 0.f;
    const int n = na + nbt;
    TileRegs<DV> tr, tr1;
#define ATT_TPOS(i_) (((i_) < na ? ta0 + (i_) : tb0 + ((i_) - na)) * 64)
    static_assert(PINGPONG == 0, "the pair loop is the in-step form");
    tile_load<DV>(tr, Kh, VTh, ATT_TPOS(0), tid); tile_store<DV>(tr, lds, 0, 0, tid);
    if (n > 1) { tile_load<DV>(tr, Kh, VTh, ATT_TPOS(1), tid); tile_store<DV>(tr, lds, 1, 1, tid); }
    __syncthreads();
    const int qlo = qpos0 + 32 * w;
    f32x16 p[2]; bf16x8 pb[4];
    for (int ip = 0; 2 * ip < n; ++ip) {
        const int cb = ip & 1, i0 = 2 * ip + 2;
        if (i0 < n) tile_load<DV>(tr, Kh, VTh, ATT_TPOS(i0), tid);
        if (i0 + 1 < n) tile_load<DV>(tr1, Kh, VTh, ATT_TPOS(i0 + 1), tid);
        bg_start(lds, bg);
#pragma unroll
        for (int h2 = 0; h2 < 2; ++h2) {
            const int i = 2 * ip + h2;
            if (i < n) {
                const int pos0 = ATT_TPOS(i), slot = 2 * cb + h2;
                bool active = true;
                if (MODE == 1 && pos0 >= 256) active = (pos0 <= qlo + 31 + 128) && (pos0 + 63 >= qlo - 128);
                if (MODE == 2 && pos0 >= 256) { const int krow = (pos0 - 256) >> 6, rs = min(max(ma.rq - 4, 0), 120); active = (krow >= rs) && (krow < rs + 8); }
                if (active) {
                    qk_step(p, lds + L_K + slot * KBUF, qf, r32, hi);
                    softmax_step<DV, MODE>(p, pb, o, m, l, pos0, qp, ma, hi);
                    pv_step<DV>(o, lds + L_V + slot * VBUF, pb, r32, hi);
                }
            }
        }
        if (i0 < n) tile_store<DV>(tr, lds, 2 * (cb ^ 1), 2 * (cb ^ 1), tid);
        if (i0 + 1 < n) tile_store<DV>(tr1, lds, 2 * (cb ^ 1) + 1, 2 * (cb ^ 1) + 1, tid);
        __syncthreads();
        bg_finish(prm, lds, bg, bid);
    }
#undef ATT_TPOS
}

template <int DV>
__device__ __forceinline__ void store_out(bf16_t* yrow  , const f32x16 (&o)[DV / 32], float sc, int hi) {
#pragma unroll
    for (int dt = 0; dt < DV / 32; ++dt)
#pragma unroll
        for (int g = 0; g < 4; ++g) {
            uint2 w; w.x = cvtpk(o[dt][4 * g + 0] * sc, o[dt][4 * g + 1] * sc); w.y = cvtpk(o[dt][4 * g + 2] * sc, o[dt][4 * g + 3] * sc);
            *(uint2*)(yrow + 32 * dt + 8 * g + 4 * hi) = w;
        }
}
}
__device__ __forceinline__ void diff_unit(const Params& p, LAS unsigned char* lds, int b, int hd, int qpos0, int ntile_a, size_t yrow0, int scr_unit, BgConv& bg, int bid, int nb) {
    const bf16_t* Q = (const bf16_t*)(p.ws + WS_Q); const bf16_t* Kb = (const bf16_t*)(p.ws + WS_K); const bf16_t* VT = (const bf16_t*)(p.ws + WS_VT);
    const bf16_t* VTh = VT + ((size_t)b * 1024 + 512 + hd * 128) * SP;
    attd::MaskArgs ma{0, 0, nullptr};
    attd::f32x16 o[4]; float m, l;
    attd::attn_pass<128, 0, 0>(lds, Q + (size_t)(b * NQH + 8 + 2 * hd) * SP * 64, Kb + (size_t)(b * 16 + 8 + 2 * hd) * SP * 64, VTh, qpos0, 0, ntile_a, 0, 0, o, m, l, ma, nullptr, p, bg, bid, nb);
    { int t1 = threadIdx.x; asm volatile("" : "+v"(t1));
      float4* SCR = (float4*)(p.ws + WS_SCR) + ((size_t)(scr_unit * 8 + (t1 >> 6)) * 16) * 64 + (t1 & 63);
      float lt = l; { auto rr = __builtin_amdgcn_permlane32_swap(__float_as_uint(lt), __float_as_uint(lt), false, false); lt = __uint_as_float(rr[0]) + __uint_as_float(rr[1]); }
      const float il = 1.f / lt;
#pragma unroll
      for (int dt = 0; dt < 4; ++dt)
#pragma unroll
          for (int g = 0; g < 4; ++g) SCR[(dt * 4 + g) * 64] = make_float4(o[dt][4 * g] * il, o[dt][4 * g + 1] * il, o[dt][4 * g + 2] * il, o[dt][4 * g + 3] * il); }
    attd::attn_pass<128, 0, 0>(lds, Q + (size_t)(b * NQH + 8 + 2 * hd + 1) * SP * 64, Kb + (size_t)(b * 16 + 8 + 2 * hd + 1) * SP * 64, VTh, qpos0, 0, ntile_a, 0, 0, o, m, l, ma, nullptr, p, bg, bid, nb);
    int t2 = threadIdx.x; asm volatile("" : "+v"(t2));
    const int lane = t2 & 63, w = t2 >> 6, r32 = lane & 31, hi = lane >> 5;
    const float4* SCR = (const float4*)(p.ws + WS_SCR) + ((size_t)(scr_unit * 8 + w) * 16) * 64 + lane;
    const float lam = ((const float*)(p.ws + WS_SCAL))[0];
    float lt = l; { auto rr = __builtin_amdgcn_permlane32_swap(__float_as_uint(lt), __float_as_uint(lt), false, false); lt = __uint_as_float(rr[0]) + __uint_as_float(rr[1]); }
    const float il2 = lam / lt;
    float ss = 0.f;
#pragma unroll
    for (int dt = 0; dt < 4; ++dt)
#pragma unroll
        for (int g = 0; g < 4; ++g) {
            const float4 a = SCR[(dt * 4 + g) * 64];
            o[dt][4 * g] = a.x - o[dt][4 * g] * il2; o[dt][4 * g + 1] = a.y - o[dt][4 * g + 1] * il2; o[dt][4 * g + 2] = a.z - o[dt][4 * g + 2] * il2; o[dt][4 * g + 3] = a.w - o[dt][4 * g + 3] * il2;
            ss += o[dt][4 * g] * o[dt][4 * g] + o[dt][4 * g + 1] * o[dt][4 * g + 1] + o[dt][4 * g + 2] * o[dt][4 * g + 2] + o[dt][4 * g + 3] * o[dt][4 * g + 3];
        }
    { auto rr = __builtin_amdgcn_permlane32_swap(__float_as_uint(ss), __float_as_uint(ss), false, false); ss = __uint_as_float(rr[0]) + __uint_as_float(rr[1]); }
    const float sc = rsqrtf(ss * (1.f / 128.f) + RMS_EPS) * 0.8f;
    bf16_t* yrow = (bf16_t*)(p.ws + WS_Y) + (yrow0 + 32 * w + r32) * D + 512 + hd * 128;
#pragma unroll
    for (int dt = 0; dt < 4; ++dt)
#pragma unroll
        for (int g = 0; g < 4; ++g) {
            const int d0 = 32 * dt + 8 * g + 4 * hi;
            const float4 sw = *(const float4*)(p.subln + d0);
            uint2 wv; wv.x = attd::cvtpk(o[dt][4 * g] * sc * sw.x, o[dt][4 * g + 1] * sc * sw.y); wv.y = attd::cvtpk(o[dt][4 * g + 2] * sc * sw.z, o[dt][4 * g + 3] * sc * sw.w);
            *(uint2*)(yrow + d0) = wv;
        }
}
__device__ __forceinline__ void phase_attn0(const Params& p, int bid, int nb, unsigned char* smem) {
    LAS unsigned char* lds = (LAS unsigned char*)smem;
    const bf16_t* Q = (const bf16_t*)(p.ws + WS_Q); const bf16_t* Kb = (const bf16_t*)(p.ws + WS_K); const bf16_t* VT = (const bf16_t*)(p.ws + WS_VT);
    bf16_t* Y = (bf16_t*)(p.ws + WS_Y);
    constexpr int U_B = 256, U_A = 256, U_C = 16, U_D = 8;
    BgConv bg; bg.s = 0; bg.end = bid < BG_VB ? BG_SLOTS : 0; bg.fly = false; bg_seek(p, bg, bid);
    for (int u = bid; u < U_B; u += nb) {
        const int qb = u >> 3, hd = u & 3, b = (u >> 2) & 1;
        diff_unit(p, lds, b, hd, 256 + 256 * qb, SP / 64, (size_t)b * S + 256 * qb, u, bg, bid, nb);
    }
    for (int u2 = bid; u2 < U_A; u2 += nb) {
        int tid = threadIdx.x; asm volatile("" : "+v"(tid));
        const int lane = tid & 63, r32 = lane & 31, hi = lane >> 5; const int w = __builtin_amdgcn_readfirstlane(tid >> 6);
        const int qb = u2 & 15, h = (u2 >> 4) & 7, b = u2 >> 7;
        LAS float* biasL = (LAS float*)(lds + att::L_BIAS);
        for (int i = tid; i < 15 * 31; i += blockDim.x) biasL[i] = p.na_rpb[h * 465 + i] * att::LOG2E;
        const int r0 = 8 * qb;
        const int tb0 = 4 + min(max(r0 - 4, 0), 120), tb1 = 4 + min(max(r0 + 3, 0), 120) + 8;
        att::f32x16 o[2][2]; float m[2], l[2];
        att::attn_pass<64, 2>(lds, Q + (size_t)(b * NQH + h) * SP * 64, Kb + (size_t)(b * 16 + h) * SP * 64, VT + ((size_t)b * 1024 + h * 64) * SP, 256 + 512 * qb + 64 * w, 0, true, 0, 4, tb0, tb1 - tb0, o, m, l, r0 + w, biasL);
#pragma unroll
        for (int j = 0; j < 2; ++j) att::store_out(Y + ((size_t)b * S + 512 * qb + 64 * w + 32 * j + r32) * D + h * 64, o[j], 1.f / att::xhalf_sum(l[j]), hi);
    }
    for (int u2 = bid; u2 < U_C; u2 += nb) {
        int tid = threadIdx.x; asm volatile("" : "+v"(tid));
        const int lane = tid & 63, r32 = lane & 31, hi = lane >> 5; const int w = __builtin_amdgcn_readfirstlane(tid >> 6);
        const int h = u2 & 7, b = u2 >> 3;
        att::f32x16 o[2][2]; float m[2], l[2];
        att::attn_pass<64, 0>(lds, Q + (size_t)(b * NQH + h) * SP * 64, Kb + (size_t)(b * 16 + h) * SP * 64, VT + ((size_t)b * 1024 + h * 64) * SP, 64 * (w & 3), 0, w < 4, 0, 4, 0, 0, o, m, l, 0, nullptr);
        if (w < 4) {
#pragma unroll
            for (int j = 0; j < 2; ++j) att::store_out(Y + ((size_t)NLAT + b * CTX + 64 * w + 32 * j + r32) * D + h * 64, o[j], 1.f / att::xhalf_sum(l[j]), hi);
        }
    }
    for (int u2 = bid; u2 < U_D; u2 += nb) {
        const int hd = u2 & 3, b = u2 >> 2;
        diff_unit(p, lds, b, hd, 0, 4, (size_t)NLAT + b * CTX, U_B + u2, bg, bid, nb);
    }
    while (bg.s < bg.end) { bg_start(lds, bg); bg_finish(p, lds, bg, bid); }
    for (int vb = bid + nb; vb < BG_VB; vb += nb) { bg.s = 0; bg.end = BG_SLOTS; bg_seek(p, bg, vb); while (bg.s < bg.end) { bg_start(lds, bg); bg_finish(p, lds, bg, vb); } }
}
__device__ __forceinline__ void phase_attn1(const Params& p, int bid, int nb, unsigned char* smem) {
    LAS unsigned char* lds = (LAS unsigned char*)smem;
    const bf16_t* Q = (const bf16_t*)(p.ws + WS_Q); const bf16_t* Kb = (const bf16_t*)(p.ws + WS_K); const bf16_t* VT = (const bf16_t*)(p.ws + WS_VT);
    bf16_t* Y = (bf16_t*)(p.ws + WS_Y);
    for (int u = bid; u < 256; u += nb) {
        int tid = threadIdx.x; asm volatile("" : "+v"(tid));
        const int lane = tid & 63, r32 = lane & 31, hi = lane >> 5; const int w = __builtin_amdgcn_readfirstlane(tid >> 6);
        att::f32x16 o[2][2]; float m[2], l[2];
        const int xc = (u & 7) >> 1, idx = (u & 1) * 32 + (u >> 3);
        const int b = xc >> 1, qh = (xc & 1) * 4 + (idx >> 4), qb = idx & 15;
        att::attn_pass<64, 0, true>(lds, Q + (size_t)(b * NQH + qh) * SP * 64, Kb + (size_t)(b * 4 + (qh >> 2)) * SP * 64, VT + ((size_t)b * 256 + (qh >> 2) * 64) * SP, 256 + 512 * qb + 64 * w, 0, true, 0, SP / 64, 0, 0, o, m, l, 0, nullptr, p.q_norm, (const float2*)(p.ws + WS_ROPE));
#pragma unroll
        for (int j = 0; j < 2; ++j) att::store_out(Y + ((size_t)b * S + 512 * qb + 64 * w + 32 * j + r32) * D + qh * 64, o[j], 1.f / att::xhalf_sum(l[j]), hi);
    }
    for (int u2 = bid; u2 < 256; u2 += nb) {
        int tid = threadIdx.x; asm volatile("" : "+v"(tid));
        const int lane = tid & 63, r32 = lane & 31, hi = lane >> 5; const int w = __builtin_amdgcn_readfirstlane(tid >> 6);
        att::f32x16 o[2][2]; float m[2], l[2];
        const int qb = u2 & 15, qh = (u2 >> 4) & 7, b = u2 >> 7;
        const int t0 = 512 * qb;
        const int tb0 = 4 + max(t0 - 128, 0) / 64, tb1 = 4 + min(t0 + 511 + 128, S - 1) / 64 + 1;
        att::attn_pass<64, 1>(lds, Q + (size_t)(b * NQH + 8 + qh) * SP * 64, Kb + (size_t)(b * 4 + 2 + (qh >> 2)) * SP * 64, VT + ((size_t)b * 256 + 128 + (qh >> 2) * 64) * SP, 256 + t0 + 64 * w, 0, true, 0, 4, tb0, tb1 - tb0, o, m, l, 0, nullptr);
        const float sk = p.sink[qh] * att::LOG2E;
#pragma unroll
        for (int j = 0; j < 2; ++j) {
            const float lt = att::xhalf_sum(l[j]), ml2 = m[j];
            const float mn = fmaxf(ml2, sk), corr = __builtin_amdgcn_exp2f(ml2 - mn);
            const float den = lt * corr + __builtin_amdgcn_exp2f(sk - mn);
            att::store_out(Y + ((size_t)b * S + t0 + 64 * w + 32 * j + r32) * D + 512 + qh * 64, o[j], corr / den, hi);
        }
    }
}
#define XB_TMO      128
#define XB_XCNT(j)  (256  + 64 * (j))
#define XB_XSUB(j)  (1280 + 64 * (j))
#define XB_XGEN(j)  (2304 + 64 * (j))
#define XB_TOP      3328
#define XB_TOPGEN   3392
#define XCD_BAR_WORDS 3456
#define XB_SPIN_CAP (1u << 18)

__device__ __forceinline__ unsigned xb_ld(unsigned* p)              { return __hip_atomic_load(p, __ATOMIC_RELAXED, __HIP_MEMORY_SCOPE_AGENT); }
__device__ __forceinline__ unsigned xb_add(unsigned* p, unsigned v) { return __hip_atomic_fetch_add(p, v, __ATOMIC_RELAXED, __HIP_MEMORY_SCOPE_AGENT); }
__device__ __forceinline__ unsigned xb_xcc_id() { return (unsigned)__builtin_amdgcn_s_getreg((3 << 11) | 20) & 0xFu; }
#define XB_SPIN(cond, bar) do { unsigned _sp = 0; while (cond) { __builtin_amdgcn_s_sleep(1); \
    if ((++_sp & 255u) == 0u) { if (xb_ld(&(bar)[XB_TMO])) break; if (_sp > XB_SPIN_CAP) { atomicAdd(&(bar)[XB_TMO], 1u); break; } } } } while (0)

struct XcdBarrier {
    unsigned* bar; unsigned x;
    volatile LAS unsigned* st;
};

__device__ __forceinline__ XcdBarrier xcd_barrier_post(unsigned* bar, volatile LAS unsigned* st) {
    XcdBarrier b; b.bar = bar; b.x = xb_xcc_id(); b.st = st;
    if (threadIdx.x == 0) (void)xb_add(&bar[XB_XCNT(b.x)], 1u);
    return b;
}
__device__ __forceinline__ void xcd_barrier_complete(unsigned* bar, unsigned x, unsigned& nloc, unsigned& nx) {
    const unsigned G = gridDim.x * gridDim.y * gridDim.z;
    unsigned sum, cnt, mine, sp = 0u;
    for (;;) {
        sum = 0u; cnt = 0u; mine = 0u;
#pragma unroll
        for (unsigned j = 0; j < 16; ++j) { const unsigned c = xb_ld(&bar[XB_XCNT(j)]); sum += c; cnt += (c > 0u) ? 1u : 0u; mine = (j == x) ? c : mine; }
        if (sum == G) break;
        __builtin_amdgcn_s_sleep(1);
        if ((++sp & 255u) == 0u) { if (xb_ld(&bar[XB_TMO])) break; if (sp > XB_SPIN_CAP) { atomicAdd(&bar[XB_TMO], 1u); break; } }
    }
    nloc = mine > 0u ? mine : 1u; nx = cnt > 0u ? cnt : 1u;
}

__device__ __forceinline__ void xcd_barrier(const XcdBarrier& b) {
    asm volatile("s_waitcnt vmcnt(0)" ::: "memory");
    __syncthreads();
    if (threadIdx.x == 0) {
        unsigned* bar = b.bar;
        __builtin_amdgcn_s_waitcnt(0);
        unsigned nloc = b.st[0], nx = b.st[1];
        if (nloc == 0u) { xcd_barrier_complete(bar, b.x, nloc, nx); b.st[0] = nloc; b.st[1] = nx; }
        const unsigned old = xb_add(&bar[XB_XSUB(b.x)], 1u);
        const unsigned gen = old / nloc;
        if (old + 1u == (gen + 1u) * nloc) {
            __builtin_amdgcn_fence(__ATOMIC_RELEASE, "agent");
            asm volatile("s_waitcnt vmcnt(0)" ::: "memory");
            const unsigned og = xb_add(&bar[XB_TOP], 1u);
            const unsigned tg = og / nx;
            if (og + 1u == (tg + 1u) * nx) xb_add(&bar[XB_TOPGEN], 1u);
            else XB_SPIN(xb_ld(&bar[XB_TOPGEN]) == tg, bar);
            __builtin_amdgcn_fence(__ATOMIC_ACQUIRE, "agent");
            xb_add(&bar[XB_XGEN(b.x)], 1u);
            asm volatile("s_waitcnt vmcnt(0)" ::: "memory");
        } else {
            XB_SPIN(xb_ld(&bar[XB_XGEN(b.x)]) == gen, bar);
            __builtin_amdgcn_fence(__ATOMIC_ACQUIRE, "agent");
            asm volatile("s_waitcnt vmcnt(0)" ::: "memory");
        }
    }
    __syncthreads();
}

constexpr int NPHASE = 2 + 9 * 2;
constexpr int NTH = 512;
constexpr int PROBE_DUP = -1;
constexpr int CTL_BAR_WORD = 4096;
constexpr int CTL_BYTES = 65536;
template <bool COOP>
__global__ void __launch_bounds__(NTH, 2) fwd_kernel(Params p, int lo, int hi) {
    extern __shared__ __attribute__((aligned(16))) unsigned char smem[];
    const int bid = blockIdx.x, nb = gridDim.x;
    XcdBarrier bar; bar.bar = nullptr; bar.x = 0; bar.st = nullptr;
    if (COOP) {
        volatile LAS unsigned* st = (volatile LAS unsigned*)((LAS unsigned char*)smem + LDS_MISC + 2048);
        if (threadIdx.x < 2) st[threadIdx.x] = 0u;
        __syncthreads();
        if (bid == 0) { uint4* z = (uint4*)(p.ws + WS_CTL); for (int i = threadIdx.x; i < CTL_BYTES / 16; i += NTH) z[i] = make_uint4(0u, 0u, 0u, 0u); }
    }
#define SEAM(k) do { if (COOP) { if ((k) == 0) { cg::this_grid().sync(); bar = xcd_barrier_post((unsigned*)(p.ws + WS_CTL) + CTL_BAR_WORD, (volatile LAS unsigned*)((LAS unsigned char*)smem + LDS_MISC + 2048)); } else xcd_barrier(bar); } } while (0)
#define RUN(k, stmt) if (lo <= (k) && (k) < hi) { stmt; if (PROBE_DUP == (k)) { SEAM(1); stmt; } if ((k) + 1 < hi) SEAM(k); }
    RUN(0, phase_pre(p, bid, nb, smem))
    RUN(1, phase_h0(p, bid, nb))
    RUN(2, phase_qkv(p, 0, bid, nb, smem))
    RUN(4, phase_attn0(p, bid, nb, smem))
    RUN(5, phase_oproj(p, 0, bid, nb, smem))
    RUN(6, phase_ln1(p, 0, bid, nb, smem))
    RUN(8, phase_moe1(p, 0, bid, nb, smem))
    RUN(9, phase_moe2(p, 0, bid, nb, smem))
    RUN(10, phase_ln2(p, 0, bid, nb))
    RUN(11, phase_qkv(p, 1, bid, nb, smem))
    RUN(12, phase_knorm(p, bid, nb))
    RUN(13, phase_attn1(p, bid, nb, smem))
    RUN(14, phase_oproj(p, 1, bid, nb, smem))
    RUN(15, phase_ln1(p, 1, bid, nb, smem))
    RUN(17, phase_moe1(p, 1, bid, nb, smem))
    RUN(18, phase_moe2(p, 1, bid, nb, smem))
    RUN(19, phase_ln2(p, 1, bid, nb))
#undef RUN
#undef SEAM
}

extern "C" void kernel_launch(void* const* d_in, const int* in_sizes, int n_in, void* d_out, int out_size, void* d_ws, size_t ws_size, hipStream_t stream) {
    static int grid = 0;
    if (grid == 0) {
        if (n_in != 29 || ws_size < WS_END) { fprintf(stderr, "kernel_launch: unexpected n_in %d / ws %zu (need %zu)\n", n_in, ws_size, (size_t)WS_END); grid = -1; return; }
        int dev = 0, cus = 0, per_cu = 0;
        (void)hipGetDevice(&dev); (void)hipDeviceGetAttribute(&cus, hipDeviceAttributeMultiprocessorCount, dev);
        if (hipFuncSetAttribute((const void*)fwd_kernel<true>, hipFuncAttributeMaxDynamicSharedMemorySize, LDS_TOTAL) != hipSuccess) { fprintf(stderr, "kernel_launch: hipFuncSetAttribute failed\n"); grid = -1; return; }
        if (hipOccupancyMaxActiveBlocksPerMultiprocessor(&per_cu, (const void*)fwd_kernel<true>, NTH, LDS_TOTAL) != hipSuccess || per_cu < 1) { fprintf(stderr, "kernel_launch: occupancy query says %d\n", per_cu); per_cu = 1; }
        grid = cus;
        (void)hipGetLastError();
    }
    if (grid < 0) return;
    Params p{};
    const float* const* in = (const float* const*)d_in;
    p.x = in[0]; p.c = in[1]; p.ctx = in[2]; p.c_ctx = in[3]; p.mod_w = in[4]; p.mod_b = in[5]; p.ln1_g = in[6]; p.ln1_b = in[7]; p.ln2_g = in[8]; p.ln2_b = in[9];
    p.router_w = in[10]; p.router_b = in[11]; p.moe_w_in = in[12]; p.moe_b_in = in[13]; p.moe_w_out = in[14]; p.moe_b_out = in[15]; p.ab_w_in = in[16]; p.ab_w_out = in[17];
    p.na_rpb = in[18]; p.lq1 = in[19]; p.lk1 = in[20]; p.lq2 = in[21]; p.lk2 = in[22]; p.subln = in[23]; p.cd_w_in = in[24]; p.cd_w_out = in[25]; p.q_norm = in[26]; p.k_norm = in[27]; p.sink = in[28];
    p.out = (float*)d_out; p.ws = (unsigned char*)d_ws;
    int lo = 0, hi = NPHASE;
    void* args[] = {(void*)&p, (void*)&lo, (void*)&hi};
    hipError_t e = hipLaunchCooperativeKernel((const void*)fwd_kernel<true>, dim3(grid), dim3(NTH), args, LDS_TOTAL, stream);
    if (e != hipSuccess) fprintf(stderr, "kernel_launch: cooperative launch failed: %s (grid %d)\n", hipGetErrorString(e), grid);
}
```

```cpp
#include <hip/hip_runtime.h>
#include <hip/hip_cooperative_groups.h>
#include <cstdio>
#include <cstdint>
namespace cg = cooperative_groups;

typedef unsigned short bf16_t;

constexpr int D = 1024, NB = 2, S = 8192, NLAT = NB * S, CTX = 256, NCTX = NB * CTX, NTOK = NLAT + NCTX;
constexpr int SP = S + CTX;
constexpr int NE = 32, TOPK = 4;
constexpr int CNT_STRIDE = 32;
constexpr int MAXSLOT = (NTOK * TOPK / 256 + NE) * 256;
constexpr int NQH = 16;
constexpr float ALPHA = 1.41421356237309515f;
constexpr float LN_EPS = 1e-5f, RMS_EPS = 1e-6f, SCALE = 0.125f;
constexpr float SW_LIMIT = 7.0f, SW_ALPHA = 1.702f;
constexpr float W8O_SCALE = 128.0f, ACT8_SCALE = 4.0f;
constexpr float WQKV8_SCALE = 64.0f, WO8_SCALE = 128.0f, Y8_SCALE = 64.0f;
constexpr float YP8_SCALE = 16.0f;
constexpr float W8_SCALE = 64.0f;

constexpr size_t MiB = 1ull << 20;
constexpr size_t WS_CTL = 0;
constexpr size_t WS_MOD = 1 * MiB;
constexpr size_t WS_SCAL = 2 * MiB;
constexpr size_t WS_ROPE = 3 * MiB;
constexpr size_t WS_PAIR = 6 * MiB;
constexpr size_t WS_SLOTG = 8 * MiB;
constexpr size_t WS_H = 10 * MiB;
constexpr size_t WS_Q = 150 * MiB;
constexpr size_t WS_K = 186 * MiB;
constexpr size_t WS_VT = 222 * MiB;
constexpr size_t WS_Y = 258 * MiB;
constexpr size_t WS_YO = 294 * MiB;
constexpr size_t WS_X1 = 364 * MiB;
constexpr size_t WS_X2 = 434 * MiB;
constexpr size_t WS_TOK = 504 * MiB;
constexpr size_t WS_XB = 540 * MiB;
constexpr size_t WS_ACT = 696 * MiB;
constexpr size_t WS_YP = 852 * MiB;
constexpr size_t WS_SCR = 1008 * MiB;
constexpr size_t WS_WT_ABIN = WS_H + 66 * 262144;
constexpr size_t WS_WT_ABOUT = 1054 * MiB;
constexpr size_t WS_WT_CDIN = WS_H + 78 * 262144;
constexpr size_t WS_WT_CDOUT = 1059 * MiB;
constexpr size_t WS_WT_MIN = 1062 * MiB;
constexpr size_t WS_WT_MOUT = 1318 * MiB;
constexpr size_t WS_END = 1446 * MiB;

struct Params {
    const float *x, *c, *ctx, *c_ctx, *mod_w, *mod_b, *ln1_g, *ln1_b, *ln2_g, *ln2_b, *router_w, *router_b;
    const float *moe_w_in, *moe_b_in, *moe_w_out, *moe_b_out, *ab_w_in, *ab_w_out, *na_rpb;
    const float *lq1, *lk1, *lq2, *lk2, *subln, *cd_w_in, *cd_w_out, *q_norm, *k_norm, *sink;
    float* out;
    unsigned char* ws;
};

__device__ __forceinline__ float bf2f(unsigned v) { return __uint_as_float(v << 16); }
__device__ __forceinline__ unsigned f2bf(float f) { unsigned u = __float_as_uint(f); return (u + 0x7fffu + ((u >> 16) & 1u)) >> 16; }
__device__ __forceinline__ unsigned pk2(float lo, float hi) { return f2bf(lo) | (f2bf(hi) << 16); }
template <int CTRL> __device__ __forceinline__ float dpp_xadd(float v) { const int t = __builtin_amdgcn_update_dpp(0, __float_as_int(v), CTRL, 0xf, 0xf, true); return v + __int_as_float(t); }
__device__ __forceinline__ float wave_sum(float v) {
    v = dpp_xadd<0xB1>(v); v = dpp_xadd<0x4E>(v); v = dpp_xadd<0x141>(v); v = dpp_xadd<0x140>(v);
    v += __int_as_float(__builtin_amdgcn_ds_swizzle(__float_as_int(v), 0x401f));
    auto rr = __builtin_amdgcn_permlane32_swap(__float_as_uint(v), __float_as_uint(v), false, false);
    return __uint_as_float(rr[0]) + __uint_as_float(rr[1]);
}
typedef float f2v __attribute__((ext_vector_type(2)));
__device__ __forceinline__ float silu_f(float v) { return v / (1.f + __expf(-v)); }
#define LAS __attribute__((address_space(3)))
typedef float float4v __attribute__((ext_vector_type(4)));

namespace pg8 {
#define PG8_LAS __attribute__((address_space(3)))
typedef unsigned short bf16_t;
typedef short bf16x8 __attribute__((ext_vector_type(8)));
typedef float f32x4 __attribute__((ext_vector_type(4)));
typedef unsigned u32x4 __attribute__((ext_vector_type(4)));
constexpr int BM = 256, BK = 64, HALF = 128, HTB = HALF * BK * 2  , STAGE_BYTES = 8 * HTB, NXCD = 8, WGM = 8;

__host__ __device__ __forceinline__ int lds_byte(int r, int c) { const int st = (r >> 4) * 2 + (c >> 5), rr = r & 15, cc = c & 31, ob = rr * 64 + cc * 2; return st * 1024 + (ob ^ (((ob >> 9) & 1) << 5)); }
__host__ __device__ __forceinline__ void stage_rc(int b, int& R, int& C) { const int st = b / 1024, sb = b % 1024, swz = sb ^ (((sb >> 9) & 1) << 5); R = (st >> 1) * 16 + swz / 64; C = (st & 1) * 32 + (swz % 64) / 2; }
__host__ __device__ __forceinline__ int perm32(int rho) { const int n = rho >> 4, i = rho & 15; return 8 * (i >> 2) + 4 * n + (i & 3); }

struct Unit { int pm, pn; };
struct Gemm { const bf16_t* A; const bf16_t* Bt; int M, N, K; const int* arow; };

struct StaticOrder {
    int nM, nN, nwg, G, c;
    __host__ __device__ void init(int M, int N, int G_, int c_) { nM = M / BM; nN = N / BM; nwg = nM * nN; G = G_; c = c_; }
    __host__ __device__ bool next(int i, Unit& u) const {
        const long L = (long)i * G + c; if (L >= nwg) return false;
        int wgid = (int)L; { const int q = nwg / NXCD, r = nwg % NXCD, xcd = wgid % NXCD, off = wgid / NXCD; wgid = (xcd < r ? xcd * (q + 1) : r * (q + 1) + (xcd - r) * q) + off; }
        const int nig = WGM * nN, gid = wgid / nig, fm = gid * WGM, gsz = (nM - fm) < WGM ? (nM - fm) : WGM;
        u.pm = fm + ((wgid % nig) % gsz); u.pn = (wgid % nig) / gsz; return true;
    }
    __device__ __forceinline__ void a_ready(const Unit&) const {}
    __device__ __forceinline__ void done(const Unit&) const {}
};

typedef int v8i_t __attribute__((ext_vector_type(8)));
typedef int v4i_t __attribute__((ext_vector_type(4)));
__device__ __forceinline__ v8i_t cat8(bf16x8 a, bf16x8 b) { const v4i_t x = __builtin_bit_cast(v4i_t, a), y = __builtin_bit_cast(v4i_t, b); return __builtin_shufflevector(x, y, 0, 1, 2, 3, 4, 5, 6, 7); }
template <bool FP8>
__device__ __forceinline__ void mma_block(f32x4 (&c)[4][2], const bf16x8 (&At)[4][2], const bf16x8 (&Bt)[2][2], const v8i_t (&a8)[4], const v8i_t (&b8)[2]) {
    if constexpr (FP8) {
#pragma unroll
        for (int m = 0; m < 4; ++m)
#pragma unroll
            for (int n = 0; n < 2; ++n)
                asm volatile("s_nop 1\n\tv_mfma_f32_16x16x128_f8f6f4 %0, %1, %2, %0" : "+v"(c[m][n]) : "v"(b8[n]), "v"(a8[m]));
    } else {
#pragma unroll
        for (int m = 0; m < 4; ++m)
#pragma unroll
            for (int n = 0; n < 2; ++n)
#pragma unroll
                for (int k = 0; k < 2; ++k) c[m][n] = __builtin_amdgcn_mfma_f32_16x16x32_bf16(Bt[n][k], At[m][k], c[m][n], 0, 0, 0);
    }
}
template <class Epi, class Sched, bool ALIGN_EPI = false, bool SP2 = false, bool FP8 = false, bool GATHER = false>
__device__ __forceinline__ void gemm_phase(PG8_LAS unsigned char* lds, const Gemm g, const Sched& S, const Epi& E) {
    int tid_ = threadIdx.x; asm volatile("" : "+v"(tid_));
    const int tid = tid_, wid = __builtin_amdgcn_readfirstlane(tid >> 6), lane = tid & 63, wr = wid >> 2, wc = wid & 3, fr = lane & 15, fq = lane >> 4;
    const int K = g.K, nt = K / BK;
    unsigned voffA[2], voffB[2];
#pragma unroll
    for (int i = 0; i < 2; ++i) { int R, C; stage_rc(tid * 16 + i * 8192, R, C); const int Rb = Epi::PERM ? ((R & ~31) + perm32(R & 31)) : R;
        voffA[i] = (unsigned)(R * K + C) * 2u; voffB[i] = (unsigned)(Rb * K + C) * 2u; }
    const size_t kstep = (size_t)(BK * 2);
    const size_t hstep = (size_t)HALF * K * 2;
    const size_t tstep = 2 * hstep;
    const unsigned ldsw = (unsigned)wid * 1024u;
    const int aoff = lds_byte(wr * 64 + fr, fq * 8), boff = lds_byte(wc * 32 + fr, fq * 8);
#define PG8_SA(b, h) (((b) * 2 + (h)) * HTB)
#define PG8_SB(b, h) ((4 + (b) * 2 + (h)) * HTB)
#define PG8_STAGE(bufoff, gbase, voff) do { _Pragma("unroll") for (int _i = 0; _i < 2; ++_i) \
        __builtin_amdgcn_global_load_lds((const unsigned*)((const char*)(gbase) + (voff)[_i]), (PG8_LAS unsigned*)(lds + (bufoff) + ldsw + _i * 8192), 16, 0, 0); } while (0)
#define PG8_STAGE_A(bufoff, gbase, HALF_, NEXT_) do { if constexpr (GATHER) { _Pragma("unroll") for (int _i = 0; _i < 2; ++_i) \
        __builtin_amdgcn_global_load_lds((const unsigned*)((const char*)(gbase) + ((NEXT_) ? gN[HALF_][_i] : gC[HALF_][_i])), (PG8_LAS unsigned*)(lds + (bufoff) + ldsw + _i * 8192), 16, 0, 0); } \
    else { PG8_STAGE(bufoff, (gbase) + ((HALF_) ? hstep : 0), voffA); } } while (0)
#define PG8_LDA(dst, b, h) do { if constexpr (FP8) { _Pragma("unroll") for (int m = 0; m < 4; ++m) dst##8[m] = cat8(*(const PG8_LAS bf16x8*)(lds + PG8_SA(b, h) + aoff + m * 2048), *(const PG8_LAS bf16x8*)(lds + PG8_SA(b, h) + aoff + m * 2048 + 1024)); } \
        else { _Pragma("unroll") for (int m = 0; m < 4; ++m) _Pragma("unroll") for (int k = 0; k < 2; ++k) dst[m][k] = *(const PG8_LAS bf16x8*)(lds + PG8_SA(b, h) + aoff + m * 2048 + k * 1024); } } while (0)
#define PG8_LDB(dst, b, h) do { if constexpr (FP8) { _Pragma("unroll") for (int n = 0; n < 2; ++n) dst##8[n] = cat8(*(const PG8_LAS bf16x8*)(lds + PG8_SB(b, h) + boff + n * 2048), *(const PG8_LAS bf16x8*)(lds + PG8_SB(b, h) + boff + n * 2048 + 1024)); } \
        else { _Pragma("unroll") for (int n = 0; n < 2; ++n) _Pragma("unroll") for (int k = 0; k < 2; ++k) dst[n][k] = *(const PG8_LAS bf16x8*)(lds + PG8_SB(b, h) + boff + n * 2048 + k * 1024); } } while (0)
#define PG8_MMA(ai, bj, At, Bt) do { __builtin_amdgcn_s_setprio(1); mma_block<FP8>(acc[ai][bj], At, Bt, At##8, Bt##8); __builtin_amdgcn_s_setprio(0); } while (0)
#define PG8_WAIT_V(n) asm volatile("s_waitcnt vmcnt(" #n ")" ::: "memory")
#define PG8_WAIT_L(n) asm volatile("s_waitcnt lgkmcnt(" #n ")" ::: "memory")
#define PG8_BAR __builtin_amdgcn_s_barrier()
#define PG8_SCHED __builtin_amdgcn_sched_barrier(0)
    Unit cur, nxt; int ui = 0;
    if (!S.next(0, cur)) return;
    static_assert(!GATHER || SP2, "GATHER is wired into the SP2 loop only");
    unsigned gC[2][2] = {{0u, 0u}, {0u, 0u}}, gN[2][2] = {{0u, 0u}, {0u, 0u}}; int gR[2] = {0, 0}; unsigned gCc[2] = {0u, 0u};
    if constexpr (GATHER) {
#pragma unroll
        for (int i = 0; i < 2; ++i) { int R, C; stage_rc(tid * 16 + i * 8192, R, C); gR[i] = R; gCc[i] = (unsigned)C * 2u; }
#pragma unroll
        for (int h = 0; h < 2; ++h)
#pragma unroll
            for (int i = 0; i < 2; ++i) gC[h][i] = (unsigned)g.arow[S.aoff(cur.pm) + cur.pm * BM + h * HALF + gR[i]] * (unsigned)(K * 2) + gCc[i];
        asm volatile("s_waitcnt vmcnt(0)" ::: "memory"); asm volatile("" : "+v"(gC[0][0]), "+v"(gC[0][1]), "+v"(gC[1][0]), "+v"(gC[1][1]));
    }
    f32x4 acc[2][2][4][2];
#pragma unroll
    for (int a = 0; a < 2; ++a)
#pragma unroll
        for (int b = 0; b < 2; ++b)
#pragma unroll
            for (int m = 0; m < 4; ++m)
#pragma unroll
                for (int n = 0; n < 2; ++n) acc[a][b][m][n] = (f32x4){0.f, 0.f, 0.f, 0.f};
    bf16x8 At[4][2], B0[2][2], B1[2][2]; v8i_t At8[4], B08[2], B18[2];
    const char* cA = (const char*)g.A + (GATHER ? (size_t)0 : (size_t)cur.pm * tstep); const char* cB = (const char*)g.Bt + (size_t)cur.pn * tstep;
    S.a_ready(cur);
    if constexpr (SP2) {
        PG8_STAGE(PG8_SB(0, 0), cB, voffB); PG8_STAGE(PG8_SB(0, 1), cB + hstep, voffB); PG8_STAGE_A(PG8_SA(0, 0), cA, 0, false); PG8_STAGE_A(PG8_SA(0, 1), cA, 1, false);
        if (wr == 1) PG8_BAR;
        PG8_WAIT_V(2); PG8_BAR;
        PG8_STAGE(PG8_SB(1, 0), cB + kstep, voffB); PG8_STAGE_A(PG8_SA(1, 0), cA + kstep, 0, false); PG8_STAGE(PG8_SB(1, 1), cB + hstep + kstep, voffB);
        PG8_WAIT_V(6); PG8_BAR;
    } else {
        PG8_STAGE(PG8_SB(0, 0), cB, voffB); PG8_STAGE(PG8_SA(0, 0), cA, voffA); PG8_STAGE(PG8_SB(0, 1), cB + hstep, voffB); PG8_STAGE(PG8_SA(0, 1), cA + hstep, voffA);
        if (wr == 1) PG8_BAR;
        PG8_WAIT_V(4); PG8_BAR;
        PG8_STAGE(PG8_SB(1, 0), cB + kstep, voffB); PG8_STAGE(PG8_SA(1, 0), cA + kstep, voffA); PG8_STAGE(PG8_SB(1, 1), cB + hstep + kstep, voffB);
        PG8_WAIT_V(6); PG8_BAR;
    }
    for (;;) {
        const bool has_next = S.next(ui + 1, nxt);
        const char* nA = (has_next && !GATHER) ? (const char*)g.A + (size_t)nxt.pm * tstep : cA; const char* nB = has_next ? (const char*)g.Bt + (size_t)nxt.pn * tstep : cB;
        if constexpr (GATHER) {
            const int npm = has_next ? nxt.pm : cur.pm;
#pragma unroll
            for (int h = 0; h < 2; ++h)
#pragma unroll
                for (int i = 0; i < 2; ++i) gN[h][i] = (unsigned)g.arow[S.aoff(npm) + npm * BM + h * HALF + gR[i]] * (unsigned)(K * 2) + gCc[i];
            asm volatile("s_waitcnt vmcnt(0)" ::: "memory"); asm volatile("" : "+v"(gN[0][0]), "+v"(gN[0][1]), "+v"(gN[1][0]), "+v"(gN[1][1]));
        }
        for (int t = 0; t < nt; t += 2) {
            const bool last = (t == nt - 2);
            const char* a1 = cA + (size_t)(t + 1) * kstep;
            const char* a2 = last ? nA : cA + (size_t)(t + 2) * kstep; const char* b2 = last ? nB : cB + (size_t)(t + 2) * kstep;
            const char* a3 = a2 + kstep; const char* b3 = b2 + kstep;
            if (last && has_next) S.a_ready(nxt);
            if constexpr (SP2) {
            PG8_LDB(B0, 0, 0); PG8_LDB(B1, 0, 1); PG8_SCHED; PG8_LDA(At, 0, 0); PG8_STAGE_A(PG8_SA(1, 1), a1, 1, false);
            PG8_WAIT_V(8); PG8_WAIT_L(0); PG8_BAR; PG8_MMA(0, 0, At, B0); PG8_MMA(0, 1, At, B1); PG8_BAR; PG8_SCHED;
            PG8_LDA(At, 0, 1); PG8_STAGE(PG8_SB(0, 0), b2, voffB); PG8_STAGE(PG8_SB(0, 1), b2 + hstep, voffB); PG8_STAGE_A(PG8_SA(0, 0), a2, 0, last);
            PG8_WAIT_V(8); PG8_WAIT_L(0); PG8_BAR; PG8_MMA(1, 0, At, B0); PG8_MMA(1, 1, At, B1); PG8_BAR; PG8_SCHED;
            PG8_LDB(B0, 1, 0); PG8_LDB(B1, 1, 1); PG8_SCHED; PG8_LDA(At, 1, 0); PG8_STAGE_A(PG8_SA(0, 1), a2, 1, last);
            PG8_WAIT_V(8); PG8_WAIT_L(0); PG8_BAR; PG8_MMA(0, 0, At, B0); PG8_MMA(0, 1, At, B1); PG8_BAR; PG8_SCHED;
            PG8_LDA(At, 1, 1); PG8_STAGE(PG8_SB(1, 0), b3, voffB); PG8_STAGE(PG8_SB(1, 1), b3 + hstep, voffB); PG8_STAGE_A(PG8_SA(1, 0), a3, 0, last);
            PG8_WAIT_V(8); PG8_WAIT_L(0); PG8_BAR; PG8_MMA(1, 0, At, B0); PG8_MMA(1, 1, At, B1); PG8_BAR; PG8_SCHED;
            } else {
            PG8_LDB(B0, 0, 0); PG8_SCHED; PG8_LDA(At, 0, 0); PG8_STAGE(PG8_SA(1, 1), a1 + hstep, voffA);
            PG8_WAIT_L(8); PG8_BAR; PG8_WAIT_L(0); PG8_MMA(0, 0, At, B0); PG8_BAR; PG8_SCHED;
            PG8_LDB(B1, 0, 1); PG8_STAGE(PG8_SB(0, 0), b2, voffB);
            PG8_BAR; PG8_WAIT_L(0); PG8_MMA(0, 1, At, B1); PG8_BAR;
            PG8_LDA(At, 0, 1); PG8_STAGE(PG8_SA(0, 0), a2, voffA);
            PG8_BAR; PG8_WAIT_L(0); PG8_MMA(1, 0, At, B0); PG8_BAR; PG8_SCHED;
            PG8_STAGE(PG8_SB(0, 1), b2 + hstep, voffB);
            PG8_WAIT_V(6); PG8_BAR; PG8_MMA(1, 1, At, B1); PG8_BAR;
            PG8_LDB(B0, 1, 0); PG8_SCHED; PG8_LDA(At, 1, 0); PG8_STAGE(PG8_SA(0, 1), a2 + hstep, voffA);
            PG8_WAIT_L(8); PG8_BAR; PG8_WAIT_L(0); PG8_MMA(0, 0, At, B0); PG8_BAR; PG8_SCHED;
            PG8_LDB(B1, 1, 1); PG8_STAGE(PG8_SB(1, 0), b3, voffB);
            PG8_BAR; PG8_WAIT_L(0); PG8_MMA(0, 1, At, B1); PG8_BAR;
            PG8_LDA(At, 1, 1); PG8_STAGE(PG8_SA(1, 0), a3, voffA);
            PG8_BAR; PG8_WAIT_L(0); PG8_MMA(1, 0, At, B0); PG8_BAR; PG8_SCHED;
            PG8_STAGE(PG8_SB(1, 1), b3 + hstep, voffB);
            PG8_WAIT_V(6); PG8_BAR; PG8_MMA(1, 1, At, B1); PG8_BAR;
            }
        }
        if constexpr (ALIGN_EPI) { if (wr == 0) PG8_BAR; }
        if constexpr (!Epi::AFTER_DRAIN) { E(acc, cur, wr, wc, fr, fq); S.done(cur); }
        if (!has_next) break;
#pragma unroll
        for (int a = 0; a < 2; ++a)
#pragma unroll
            for (int b = 0; b < 2; ++b)
#pragma unroll
                for (int m = 0; m < 4; ++m)
#pragma unroll
                    for (int n = 0; n < 2; ++n) acc[a][b][m][n] = (f32x4){0.f, 0.f, 0.f, 0.f};
        cur = nxt; cA = nA; cB = nB; ++ui;
        if constexpr (GATHER) { gC[0][0] = gN[0][0]; gC[0][1] = gN[0][1]; gC[1][0] = gN[1][0]; gC[1][1] = gN[1][1]; }
        if constexpr (ALIGN_EPI) { if (wr == 1) PG8_BAR; }
    }
    PG8_WAIT_V(0);
    if constexpr (!ALIGN_EPI) { if (wr == 0) PG8_BAR; }
    PG8_BAR;
    if constexpr (Epi::AFTER_DRAIN) { E.fused(acc, cur, wr, wc, fr, fq, lds, wid, lane); S.done(cur); }
#undef PG8_SA
#undef PG8_SB
#undef PG8_STAGE
#undef PG8_STAGE_A
#undef PG8_LDA
#undef PG8_LDB
#undef PG8_MMA
#undef PG8_WAIT_V
#undef PG8_WAIT_L
#undef PG8_BAR
#undef PG8_SCHED
}
}
__device__ __forceinline__ unsigned pk4_fp8(float a, float b, float c, float d) { int r = __builtin_amdgcn_cvt_pk_fp8_f32(a, b, 0, false); r = __builtin_amdgcn_cvt_pk_fp8_f32(c, d, r, true); return (unsigned)r; }

constexpr int ECAP = NTOK;
constexpr int TOFF_AT = 700, PSTART_AT = 330;
namespace pg8 {
__device__ __forceinline__ unsigned cvt_pk_bf16(float lo, float hi) { unsigned r; asm volatile("v_cvt_pk_bf16_f32 %0, %1, %2" : "=v"(r) : "v"(lo), "v"(hi)); return r; }

struct EpiStoreBf16 {
    static constexpr bool PERM = true, AFTER_DRAIN = false;
    bf16_t* O; int ldc;
    __device__ __forceinline__ void operator()(const f32x4 (&acc)[2][2][4][2], const Unit& u, int wr, int wc, int fr, int fq) const {
        const int row0 = u.pm * BM + wr * 64 + fr, col0 = u.pn * BM + wc * 32 + 8 * fq;
#pragma unroll
        for (int ai = 0; ai < 2; ++ai)
#pragma unroll
            for (int m = 0; m < 4; ++m) { bf16_t* rowp = O + (size_t)(row0 + ai * HALF + m * 16) * ldc + col0;
#pragma unroll
                for (int bj = 0; bj < 2; ++bj) { const f32x4 v0 = acc[ai][bj][m][0], v1 = acc[ai][bj][m][1];
                    u32x4 w; w.x = cvt_pk_bf16(v0[0], v0[1]); w.y = cvt_pk_bf16(v0[2], v0[3]); w.z = cvt_pk_bf16(v1[0], v1[1]); w.w = cvt_pk_bf16(v1[2], v1[3]);
                    *(u32x4*)(rowp + bj * HALF) = w; } }
    }
};
struct EpiStoreF32 {
    static constexpr bool PERM = false, AFTER_DRAIN = false;
    float* O; int ldc; float wsc;
    __device__ __forceinline__ void operator()(const f32x4 (&acc)[2][2][4][2], const Unit& u, int wr, int wc, int fr_in, int fq_in) const {
        int fr = fr_in, fq = fq_in; asm volatile("s_nop 15\n\ts_nop 15" : "+v"(fr), "+v"(fq)); __builtin_amdgcn_sched_barrier(0);
        const int row0 = u.pm * BM + wr * 64 + fr, col0 = u.pn * BM + wc * 32 + 4 * fq;
#pragma unroll
        for (int ai = 0; ai < 2; ++ai)
#pragma unroll
            for (int m = 0; m < 4; ++m) { float* rowp = O + (size_t)(row0 + ai * HALF + m * 16) * ldc + col0;
#pragma unroll
                for (int bj = 0; bj < 2; ++bj)
#pragma unroll
                    for (int n = 0; n < 2; ++n) *(f32x4*)(rowp + bj * HALF + n * 16) = acc[ai][bj][m][n] * wsc; }
    }
};
__device__ __forceinline__ float swiglu1(float g, float u) {
    g = fminf(g, SW_LIMIT); u = fminf(fmaxf(u, -SW_LIMIT), SW_LIMIT);
    return g * __builtin_amdgcn_rcpf(1.f + __builtin_amdgcn_exp2f(-SW_ALPHA * 1.4426950408889634f * g)) * (u + 1.f);
}
struct EpiMoe1 {
    static constexpr bool PERM = true, AFTER_DRAIN = false;
    bf16_t* ACT; const float* b_in; float wsc;
    __device__ __forceinline__ void operator()(const f32x4 (&acc)[2][2][4][2], const Unit& u, int wr, int wc, int fr, int fq) const {
        int fr_ = fr, fq_ = fq; asm volatile("s_nop 15\n\ts_nop 15" : "+v"(fr_), "+v"(fq_)); __builtin_amdgcn_sched_barrier(0);
        const int e = u.pn >> 3, pnl = u.pn & 7;
        const int row0 = u.pm * BM + wr * 64 + fr_, c0 = pnl * 128 + wc * 32 + 8 * fq_;
        f32x4 bg[2], bu[2];
#pragma unroll
        for (int n = 0; n < 2; ++n) { bg[n] = *(const f32x4*)(b_in + e * 2048 + c0 + 4 * n); bu[n] = *(const f32x4*)(b_in + e * 2048 + 1024 + c0 + 4 * n); }
#pragma unroll
        for (int ai = 0; ai < 2; ++ai)
#pragma unroll
            for (int m = 0; m < 4; ++m) {
                float a[8];
#pragma unroll
                for (int n = 0; n < 2; ++n) { const f32x4 g = acc[ai][0][m][n] * wsc + bg[n], uu = acc[ai][1][m][n] * wsc + bu[n];
#pragma unroll
                    for (int i = 0; i < 4; ++i) a[4 * n + i] = swiglu1(g[i], uu[i]); }
                uint2 w; w.x = pk4_fp8(a[0] * ACT8_SCALE, a[1] * ACT8_SCALE, a[2] * ACT8_SCALE, a[3] * ACT8_SCALE); w.y = pk4_fp8(a[4] * ACT8_SCALE, a[5] * ACT8_SCALE, a[6] * ACT8_SCALE, a[7] * ACT8_SCALE);
                *(uint2*)((unsigned char*)ACT + (size_t)(row0 + ai * HALF + m * 16) * D + c0) = w;
            }
    }
};
struct EpiMoe2 {
    static constexpr bool PERM = true, AFTER_DRAIN = false;
    bf16_t* YP; const float* b_out; const float* slot_gate; float wsc; const PG8_LAS int* tile_off;
    __device__ __forceinline__ void operator()(const f32x4 (&acc)[2][2][4][2], const Unit& u, int wr, int wc, int fr, int fq) const {
        int fr_ = fr, fq_ = fq; asm volatile("s_nop 15\n\ts_nop 15" : "+v"(fr_), "+v"(fq_)); __builtin_amdgcn_sched_barrier(0);
        const int e = u.pn >> 2, pnl = u.pn & 3;
        const int row0 = u.pm * BM + wr * 64 + fr_, c0 = pnl * 256 + wc * 32 + 8 * fq_;
        f32x4 bv[2][2];
#pragma unroll
        for (int bj = 0; bj < 2; ++bj)
#pragma unroll
            for (int n = 0; n < 2; ++n) bv[bj][n] = *(const f32x4*)(b_out + e * 1024 + c0 + bj * HALF + 4 * n);
#pragma unroll
        for (int ai = 0; ai < 2; ++ai)
#pragma unroll
            for (int m = 0; m < 4; ++m) { const int row = row0 + ai * HALF + m * 16; const float gt = slot_gate[tile_off[u.pm] + row] * YP8_SCALE;
#pragma unroll
                for (int bj = 0; bj < 2; ++bj) { const f32x4 v0 = (acc[ai][bj][m][0] * wsc + bv[bj][0]) * gt, v1 = (acc[ai][bj][m][1] * wsc + bv[bj][1]) * gt;
                    uint2 w; w.x = pk4_fp8(v0[0], v0[1], v0[2], v0[3]); w.y = pk4_fp8(v1[0], v1[1], v1[2], v1[3]);
                    *(uint2*)((unsigned char*)YP + (size_t)row * D + c0 + bj * HALF) = w; } }
    }
};
struct MoeSched {
    int T, NTN, tb, te, j, MR, G, c;
    const PG8_LAS int* tile_e;
    __device__ __forceinline__ int aoff(int pm) const { return tile_e[TOFF_AT + pm]; }
    __device__ void init(int T_, int NTN_, int G_, int bx, const PG8_LAS int* te_) {
        T = T_; NTN = NTN_; G = G_; c = bx; tile_e = te_;
        const int ngrp = (G % 8 == 0) ? 8 : 1, per = G / ngrp;
        const int x = bx % ngrp; j = bx / ngrp;
        tb = (int)((long)x * T / ngrp); te = (int)((long)(x + 1) * T / ngrp); MR = per / NTN;
    }
    __device__ bool next(int i, Unit& u) const {
        if (MR == 0) { const long Lx = (long)i * G + c; if (Lx >= (long)T * NTN) return false; u.pm = (int)(Lx / NTN); u.pn = tile_e[u.pm] * NTN + (int)(Lx % NTN); return true; }
        if (j >= MR * NTN) return false;
        const int pm = tb + i * MR + j / NTN; if (pm >= te) return false;
        u.pm = pm; u.pn = tile_e[pm] * NTN + j % NTN; return true;
    }
    __device__ __forceinline__ void a_ready(const Unit&) const {}
    __device__ __forceinline__ void done(const Unit&) const {}
};
}

__device__ __forceinline__ int tid_fresh() { int t = threadIdx.x; asm volatile("" : "+v"(t)); return t; }
constexpr int LDS_GEMM = 131072, LDS_MISC = 131072, LDS_PAR = 131072 + 4096, LDS_TOTAL = 131072 + 4096 + 20480;

__device__ __forceinline__ void conv_item(const float* W, int ldw, int k0, int n0, bf16_t* WT, int dst_row, LAS float* scr, int lane) {
    float4 v[16];
    const float* src = W + (size_t)(k0 + (lane >> 4)) * ldw + n0 + 4 * (lane & 15);
#pragma unroll
    for (int j = 0; j < 16; ++j) v[j] = *(const float4*)(src + (size_t)(4 * j) * ldw);
    LAS float* d = scr + (lane >> 4) * 65 + 4 * (lane & 15);
#pragma unroll
    for (int j = 0; j < 16; ++j) { d[(4 * j) * 65 + 0] = v[j].x; d[(4 * j) * 65 + 1] = v[j].y; d[(4 * j) * 65 + 2] = v[j].z; d[(4 * j) * 65 + 3] = v[j].w; }
    asm volatile("s_waitcnt lgkmcnt(0)" ::: "memory");
    const int kc = lane & 7;
#pragma unroll
    for (int j = 0; j < 8; ++j) { const int n = 8 * j + (lane >> 3); const LAS float* sp = scr + (8 * kc) * 65 + n;
        uint4 o; o.x = pk2(sp[0 * 65], sp[1 * 65]); o.y = pk2(sp[2 * 65], sp[3 * 65]); o.z = pk2(sp[4 * 65], sp[5 * 65]); o.w = pk2(sp[6 * 65], sp[7 * 65]);
        *(uint4*)(WT + (size_t)(dst_row + n) * 1024 + k0 + 8 * kc) = o; }
    asm volatile("s_waitcnt lgkmcnt(0)" ::: "memory");
}
__device__ __forceinline__ void conv_item8(const float* W, int ldw, int k0, int n0, unsigned char* WT8, int dst_row, LAS float* scr, int lane, float wscale) {
    float4 v[16];
    const float* src = W + (size_t)(k0 + (lane >> 4)) * ldw + n0 + 4 * (lane & 15);
#pragma unroll
    for (int j = 0; j < 16; ++j) v[j] = *(const float4*)(src + (size_t)(4 * j) * ldw);
    LAS float* d = scr + (lane >> 4) * 65 + 4 * (lane & 15);
#pragma unroll
    for (int j = 0; j < 16; ++j) { d[(4 * j) * 65 + 0] = v[j].x * wscale; d[(4 * j) * 65 + 1] = v[j].y * wscale; d[(4 * j) * 65 + 2] = v[j].z * wscale; d[(4 * j) * 65 + 3] = v[j].w * wscale; }
    asm volatile("s_waitcnt lgkmcnt(0)" ::: "memory");
    const int kc = lane & 3;
#pragma unroll
    for (int j = 0; j < 4; ++j) { const int n = 16 * j + (lane >> 2); const LAS float* sp = scr + (16 * kc) * 65 + n;
        uint4 o; o.x = pk4_fp8(sp[0 * 65], sp[1 * 65], sp[2 * 65], sp[3 * 65]); o.y = pk4_fp8(sp[4 * 65], sp[5 * 65], sp[6 * 65], sp[7 * 65]);
        o.z = pk4_fp8(sp[8 * 65], sp[9 * 65], sp[10 * 65], sp[11 * 65]); o.w = pk4_fp8(sp[12 * 65], sp[13 * 65], sp[14 * 65], sp[15 * 65]);
        *(uint4*)(WT8 + (size_t)(dst_row + n) * 1024 + k0 + 16 * kc) = o; }
    asm volatile("s_waitcnt lgkmcnt(0)" ::: "memory");
}
__device__ __forceinline__ void conv8_load(float4 (&v)[16], const float* W, int ldw, int k0, int n0, int lane) {
    const float* src = W + (size_t)(k0 + (lane >> 4)) * ldw + n0 + 4 * (lane & 15);
#pragma unroll
    for (int j = 0; j < 16; ++j) v[j] = *(const float4*)(src + (size_t)(4 * j) * ldw);
}
__device__ __forceinline__ void conv8_store(const float4 (&v)[16], unsigned char* WT8, int dst_row, int k0, LAS float* scr, int lane, float wscale) {
    LAS float* d = scr + (lane >> 4) * 65 + 4 * (lane & 15);
#pragma unroll
    for (int j = 0; j < 16; ++j) { d[(4 * j) * 65 + 0] = v[j].x * wscale; d[(4 * j) * 65 + 1] = v[j].y * wscale; d[(4 * j) * 65 + 2] = v[j].z * wscale; d[(4 * j) * 65 + 3] = v[j].w * wscale; }
    asm volatile("s_waitcnt lgkmcnt(0)" ::: "memory");
    const int kc = lane & 3;
#pragma unroll
    for (int j = 0; j < 4; ++j) { const int n = 16 * j + (lane >> 2); const LAS float* sp = scr + (16 * kc) * 65 + n;
        uint4 o; o.x = pk4_fp8(sp[0 * 65], sp[1 * 65], sp[2 * 65], sp[3 * 65]); o.y = pk4_fp8(sp[4 * 65], sp[5 * 65], sp[6 * 65], sp[7 * 65]);
        o.z = pk4_fp8(sp[8 * 65], sp[9 * 65], sp[10 * 65], sp[11 * 65]); o.w = pk4_fp8(sp[12 * 65], sp[13 * 65], sp[14 * 65], sp[15 * 65]);
        *(uint4*)(WT8 + (size_t)(dst_row + n) * 1024 + k0 + 16 * kc) = o; }
    asm volatile("s_waitcnt lgkmcnt(0)" ::: "memory");
}
__device__ __forceinline__ void conv8h_load(float4 (&v)[16], const float* W, int ldw, int k0, int n0, int lane) {
    const float* src = W + (size_t)(k0 + 4 * (lane >> 4)) * ldw + n0 + 4 * (lane & 15);
#pragma unroll
    for (int j = 0; j < 4; ++j)
#pragma unroll
        for (int i = 0; i < 4; ++i) v[4 * j + i] = *(const float4*)(src + (size_t)(16 * j + i) * ldw);
}
__device__ __forceinline__ void conv8h_stage(const float4 (&v)[16], LAS unsigned* img, int half, int lane, float s) {
    const int kq = lane >> 4, nq = lane & 15;
#pragma unroll
    for (int j = 0; j < 4; ++j) {
        LAS unsigned* d = img + (4 * nq) * 33 + 16 * half + 4 * j + kq;
        d[0 * 33] = pk4_fp8(v[4 * j].x * s, v[4 * j + 1].x * s, v[4 * j + 2].x * s, v[4 * j + 3].x * s);
        d[1 * 33] = pk4_fp8(v[4 * j].y * s, v[4 * j + 1].y * s, v[4 * j + 2].y * s, v[4 * j + 3].y * s);
        d[2 * 33] = pk4_fp8(v[4 * j].z * s, v[4 * j + 1].z * s, v[4 * j + 2].z * s, v[4 * j + 3].z * s);
        d[3 * 33] = pk4_fp8(v[4 * j].w * s, v[4 * j + 1].w * s, v[4 * j + 2].w * s, v[4 * j + 3].w * s);
    }
}
__device__ __forceinline__ void conv8h_flush(const LAS unsigned* img, unsigned char* WT8, int dst_row, int k0, int lane) {
    asm volatile("s_waitcnt lgkmcnt(0)" ::: "memory");
    const int ch = lane & 7;
#pragma unroll
    for (int j = 0; j < 8; ++j) { const int n = 8 * j + (lane >> 3); const LAS unsigned* sp = img + n * 33 + 4 * ch;
        uint4 o; o.x = sp[0]; o.y = sp[1]; o.z = sp[2]; o.w = sp[3];
        *(uint4*)(WT8 + (size_t)(dst_row + n) * 1024 + k0 + 16 * ch) = o; }
    asm volatile("s_waitcnt lgkmcnt(0)" ::: "memory");
}
struct MoeConvItem { const float* W; unsigned char* WT8; int ldw, k0, n0, drow; float scale; };
__device__ __forceinline__ MoeConvItem moe_conv_item(const Params& p, int r) {
    MoeConvItem it; const int le = r / 384, q = r % 384;
    if (q < 256) { it.n0 = (q % 32) * 64; it.k0 = (q / 32) * 128; it.ldw = 2048; it.W = p.moe_w_in + (size_t)le * 1024 * 2048; it.WT8 = p.ws + WS_WT_MIN + (size_t)le * 2048 * 1024;
        const int nn = it.n0 & 1023; it.drow = 256 * (nn >> 7) + (nn & 127) + (it.n0 >= 1024 ? 128 : 0); it.scale = W8_SCALE; }
    else { const int q2 = q - 256; it.n0 = (q2 % 16) * 64; it.k0 = (q2 / 16) * 128; it.ldw = 1024; it.W = p.moe_w_out + (size_t)le * 1024 * 1024; it.WT8 = p.ws + WS_WT_MOUT + (size_t)le * 1024 * 1024;
        it.drow = it.n0; it.scale = W8O_SCALE; }
    return it;
}
__device__ __forceinline__ void phase_pre(const Params& p, int bid, int nb, unsigned char* smem) {
    const int nth = blockDim.x, tid = threadIdx.x;
    const int lane = tid & 63, wv = tid >> 6, nw = nth / 64;
    float* MOD = (float*)(p.ws + WS_MOD);
    {
        LAS float* sl = (LAS float*)smem;
        LAS float* part = (LAS float*)(smem + 12288);
        for (int it = bid; it < 192; it += nb) {
            for (int i = tid; i < 3072; i += nth) { const float cv = i < 2048 ? p.c[i] : p.c_ctx[i - 2048]; sl[i] = silu_f(cv); }
            __syncthreads();
            const int L = it / 96, n = (it % 96) * 64 + lane;
            const float* W = p.mod_w + (size_t)L * 1024 * 6144 + n;
            float a0 = 0.f, a1 = 0.f, a2 = 0.f;
#pragma unroll 8
            for (int k = 128 * wv; k < 128 * wv + 128; ++k) { const float w = W[(size_t)k * 6144]; a0 += sl[k] * w; a1 += sl[1024 + k] * w; a2 += sl[2048 + k] * w; }
            part[(wv * 3 + 0) * 64 + lane] = a0; part[(wv * 3 + 1) * 64 + lane] = a1; part[(wv * 3 + 2) * 64 + lane] = a2;
            __syncthreads();
            if (tid < 192) { const int r = tid >> 6, nn = (it % 96) * 64 + (tid & 63); float sum = p.mod_b[L * 6144 + nn];
                for (int q = 0; q < nw; ++q) sum += part[(q * 3 + r) * 64 + (tid & 63)];
                MOD[(L * 3 + r) * 6144 + nn] = sum; }
            __syncthreads();
        }
    }
    const int gt = bid * nth + tid, gs = nb * nth;
    float2* ROPE = (float2*)(p.ws + WS_ROPE);
    for (int idx = gt; idx < 8192 * 32; idx += gs) {
        const int t = idx >> 5, i = idx & 31;
        const float pos = (i < 16) ? (float)(t >> 6) : (float)(t & 63);
        const float fr = powf(10000.0f, -(float)(i & 15) / 16.0f);
        const float ang = pos * fr;
        ROPE[idx] = make_float2(cosf(ang), sinf(ang));
    }
    if (gt == 0) {
        float s1 = 0.f, s2 = 0.f;
        for (int k = 0; k < 64; ++k) { s1 += p.lq1[k] * p.lk1[k]; s2 += p.lq2[k] * p.lk2[k]; }
        ((float*)(p.ws + WS_SCAL))[0] = expf(s1) - expf(s2) + 0.2f;
    }
    LAS float* scr = (LAS float*)(smem + wv * 16640);
    constexpr int I_ABIN = 16 * 48, I_ABOUT = 16 * 16, I_CDIN = 16 * 24, I_CDOUT = 16 * 16, I_MIN = 16 * 32, I_MOUT = 16 * 16;
    constexpr int I_SMALL = I_ABIN + I_ABOUT + I_CDIN + I_CDOUT;
    for (int it = bid * nw + wv; it < I_SMALL; it += nb * nw) {
        int r = it;
        if (r < I_ABIN) { conv_item8(p.ab_w_in, 3072, (r / 48) * 64, (r % 48) * 64, p.ws + WS_WT_ABIN, (r % 48) * 64, scr, lane, WQKV8_SCALE); continue; } r -= I_ABIN;
        if (r < I_ABOUT) { conv_item(p.ab_w_out, 1024, (r / 16) * 64, (r % 16) * 64, (bf16_t*)(p.ws + WS_WT_ABOUT), (r % 16) * 64, scr, lane); continue; } r -= I_ABOUT;
        if (r < I_CDIN) { const int n0 = (r % 24) * 64; const int np = n0 < 512 ? n0 : n0 < 640 ? 1024 + (n0 - 512) : n0 < 768 ? 1280 + (n0 - 640) : n0 < 1280 ? 512 + (n0 - 768) : n0 < 1408 ? 1152 + (n0 - 1280) : n0;
            conv_item8(p.cd_w_in, 1536, (r / 24) * 64, n0, p.ws + WS_WT_CDIN, np, scr, lane, WQKV8_SCALE); continue; } r -= I_CDIN;
        conv_item(p.cd_w_out, 1024, (r / 16) * 64, (r % 16) * 64, (bf16_t*)(p.ws + WS_WT_CDOUT), (r % 16) * 64, scr, lane);
    }
    {
        uint4* z0 = (uint4*)(p.ws + WS_XB); uint4* z1 = (uint4*)(p.ws + WS_XB + 4 * MiB);
        for (int i = gt; i < NE * ECAP / 4; i += gs) { z0[i] = make_uint4(0u, 0u, 0u, 0u); z1[i] = make_uint4(0u, 0u, 0u, 0u); }
    }
}

__device__ __forceinline__ void phase_h0(const Params& p, int bid, int nb) {
    const float* MOD = (const float*)(p.ws + WS_MOD);
    unsigned char* H8 = p.ws + WS_H;
    const int lane = threadIdx.x & 63, wv = threadIdx.x >> 6, nw = blockDim.x / 64;
    for (int rq = bid * nw + wv; rq < NTOK / 4; rq += nb * nw) {
        const int row0 = rq * 4;
        const bool lat = row0 < NLAT; const int r = lat ? (row0 >> 13) : 2;
        const float* xin = lat ? p.x + (size_t)row0 * D : p.ctx + (size_t)(row0 - NLAT) * D;
        const float* sh = MOD + (0 * 3 + r) * 6144; const float* sc = sh + 1024;
        float4 v[4][4];
#pragma unroll
        for (int q = 0; q < 4; ++q)
#pragma unroll
            for (int j = 0; j < 4; ++j) v[q][j] = *(const float4*)(xin + (size_t)q * D + 4 * lane + 256 * j);
#pragma unroll
        for (int j = 0; j < 4; ++j) {
            const int k = 4 * lane + 256 * j;
            const float4 a = *(const float4*)(sc + k), b = *(const float4*)(sh + k);
#pragma unroll
            for (int q = 0; q < 4; ++q)
                *(unsigned*)(H8 + (size_t)(row0 + q) * D + k) = pk4_fp8(v[q][j].x * (1.f + a.x) + b.x, v[q][j].y * (1.f + a.y) + b.y, v[q][j].z * (1.f + a.z) + b.z, v[q][j].w * (1.f + a.w) + b.w);
        }
    }
}

__device__ __forceinline__ void chunk_desc(int L, int ch, int& kind, int& idx, int& flags) {
    if (L == 0) {
        const int g = ch >> 3, u = ch & 7;
        kind = g % 3; idx = (g >= 3 ? 8 : 0) + u; flags = (g == 3 || g == 4) ? 1 : 0;
    } else {
        if (ch < 8) { kind = 0; idx = ch; flags = 0; }
        else if (ch < 16) { kind = 0; idx = ch; flags = 1; }
        else if (ch < 18) { kind = 1; idx = ch - 16; flags = 0; }
        else if (ch < 20) { kind = 1; idx = ch - 16; flags = 1; }
        else { kind = 2; idx = ch - 20; flags = 0; }
    }
}
namespace pg8 {
struct QkvSched {
    int L, nwg, G, c;
    __device__ __forceinline__ void init(int L_, int G_, int c_) { L = L_; G = G_; c = c_; nwg = 66 * (L_ == 0 ? 12 : 6); }
    __device__ __forceinline__ bool next(int i, Unit& u) const {
        const long Lx = (long)i * G + c; if (Lx >= nwg) return false;
        int wgid = (int)Lx; { const int q = nwg / NXCD, r = nwg % NXCD, xcd = wgid % NXCD, off = wgid / NXCD; wgid = (xcd < r ? xcd * (q + 1) : r * (q + 1) + (xcd - r) * q) + off; }
        if (L == 0) { const int t = wgid / 12, j = wgid % 12;
            if (j < 8) { u.pm = t; u.pn = 66 + (j < 4 ? j : j + 2); } else { u.pm = 66 + (j < 10 ? j - 4 : j); u.pn = t; } }
        else { const int t = wgid / 6, j = wgid % 6;
            if (j < 5) { u.pm = t; u.pn = 78 + j; } else { u.pm = 78 + 5; u.pn = t; } }
        return true;
    }
    __device__ __forceinline__ void a_ready(const Unit&) const {}
    __device__ __forceinline__ void done(const Unit&) const {}
};
struct EpiQkv {
    static constexpr bool PERM = true, AFTER_DRAIN = false;
    int L; bf16_t* Q; bf16_t* Kb; bf16_t* VT; const float2* ROPE; float wsc;
    __device__ __forceinline__ void operator()(const f32x4 (&acc)[2][2][4][2], const Unit& u, int wr, int wc, int fr_in, int fq_in) const {
        int fr = fr_in, fq = fq_in; asm volatile("s_nop 15\n\ts_nop 15" : "+v"(fr), "+v"(fq)); __builtin_amdgcn_sched_barrier(0);
        const int WT0 = L == 0 ? 66 : 78, NKH = L == 0 ? 16 : 4, NVR = L == 0 ? 1024 : 256;
        if (u.pm < 66) {
            const int wt = u.pn - WT0, cic = (wc & 1) * 32 + 8 * fq;
#pragma unroll
            for (int bj = 0; bj < 2; ++bj) {
                int kind, idx, flags; chunk_desc(L, wt * 4 + bj * 2 + (wc >> 1), kind, idx, flags);
                bf16_t* base = kind == 0 ? Q + (size_t)idx * SP * 64 : Kb + (size_t)idx * SP * 64;
                const size_t bstride = (size_t)(kind == 0 ? NQH : NKH) * SP * 64;
#pragma unroll
                for (int ai = 0; ai < 2; ++ai)
#pragma unroll
                    for (int m = 0; m < 4; ++m) {
                        const int row = u.pm * BM + ai * HALF + wr * 64 + m * 16 + fr;
                        const bool lat = row < NLAT;
                        const int b = lat ? (row >> 13) : ((row - NLAT) >> 8), t = row & 8191, pos = lat ? 256 + t : ((row - NLAT) & 255);
                        f32x4 v0 = acc[ai][bj][m][0] * wsc, v1 = acc[ai][bj][m][1] * wsc;
                        if ((flags & 1) && lat) {
                            const f32x4 c01 = *(const f32x4*)(ROPE + t * 32 + (cic >> 1)), c23 = *(const f32x4*)(ROPE + t * 32 + (cic >> 1) + 2);
                            const f32x4 a = v0, bq = v1;
                            v0[0] = a[0] * c01[0] - a[1] * c01[1]; v0[1] = a[0] * c01[1] + a[1] * c01[0];
                            v0[2] = a[2] * c01[2] - a[3] * c01[3]; v0[3] = a[2] * c01[3] + a[3] * c01[2];
                            v1[0] = bq[0] * c23[0] - bq[1] * c23[1]; v1[1] = bq[0] * c23[1] + bq[1] * c23[0];
                            v1[2] = bq[2] * c23[2] - bq[3] * c23[3]; v1[3] = bq[2] * c23[3] + bq[3] * c23[2];
                        }
                        u32x4 w; w.x = cvt_pk_bf16(v0[0], v0[1]); w.y = cvt_pk_bf16(v0[2], v0[3]); w.z = cvt_pk_bf16(v1[0], v1[1]); w.w = cvt_pk_bf16(v1[2], v1[3]);
                        *(u32x4*)(base + (size_t)b * bstride + (size_t)pos * 64 + cic) = w;
                    }
            }
        } else {
            const int wt = u.pm - WT0;
            const int vbase = L == 0 ? (wt == 4 ? 0 : wt == 5 ? 256 : wt == 10 ? 512 : 768) : 0;
            const int t = u.pn, b = t < 64 ? (t >> 5) : (t - 64), pos0 = t < 64 ? 256 + (t & 31) * 256 : 0;
#pragma unroll
            for (int ai = 0; ai < 2; ++ai)
#pragma unroll
                for (int m = 0; m < 4; ++m) {
                    bf16_t* rowp = VT + ((size_t)b * NVR + vbase + ai * HALF + wr * 64 + m * 16 + fr) * SP + pos0 + wc * 32 + 8 * fq;
#pragma unroll
                    for (int bj = 0; bj < 2; ++bj) { const f32x4 v0 = acc[ai][bj][m][0] * wsc, v1 = acc[ai][bj][m][1] * wsc;
                        u32x4 w; w.x = cvt_pk_bf16(v0[0], v0[1]); w.y = cvt_pk_bf16(v0[2], v0[3]); w.z = cvt_pk_bf16(v1[0], v1[1]); w.w = cvt_pk_bf16(v1[2], v1[3]);
                        *(u32x4*)(rowp + bj * HALF) = w; }
                }
        }
    }
};
}
__device__ __forceinline__ void phase_qkv(const Params& p, int L, int bid, int nb, unsigned char* smem) {
    pg8::Gemm g{(const bf16_t*)(p.ws + WS_H), (const bf16_t*)(p.ws + WS_H), 0, 0, D / 2};
    pg8::QkvSched So; So.init(L, nb, bid);
    pg8::EpiQkv E{L, (bf16_t*)(p.ws + WS_Q), (bf16_t*)(p.ws + WS_K), (bf16_t*)(p.ws + WS_VT), (const float2*)(p.ws + WS_ROPE), 1.0f / WQKV8_SCALE};
    pg8::gemm_phase<pg8::EpiQkv, pg8::QkvSched, true, true, true>((PG8_LAS unsigned char*)smem, g, So, E);
}

__device__ __forceinline__ void phase_knorm(const Params& p, int bid, int nb) {
    bf16_t* Kb = (bf16_t*)(p.ws + WS_K);
    const float2* ROPE = (const float2*)(p.ws + WS_ROPE);
    const int lane = threadIdx.x & 63, wv = threadIdx.x >> 6, nw = blockDim.x / 64;
    const float nwt = p.k_norm[lane];
    for (int it = bid * nw + wv; it < 2 * 2 * (SP / 8); it += nb * nw) {
        const int tile8 = it % (SP / 8), hb = it / (SP / 8), hd = hb & 1, b = hb >> 1;
        bf16_t* base = Kb + ((size_t)(b * 4 + hd) * SP + tile8 * 8) * 64 + lane;
#pragma unroll
        for (int i = 0; i < 8; ++i) {
            float v = bf2f(base[i * 64]);
            const float ss = wave_sum(v * v); v = v * rsqrtf(ss * (1.f / 64.f) + RMS_EPS) * nwt;
            if (tile8 >= 32) {
                const float2 cs = ROPE[(tile8 * 8 + i - 256) * 32 + (lane >> 1)];
                const float o = __shfl_xor(v, 1);
                v = (lane & 1) ? (o * cs.y + v * cs.x) : (v * cs.x - o * cs.y);
            }
            base[i * 64] = (bf16_t)f2bf(v);
        }
    }
}

__device__ __forceinline__ void phase_oproj(const Params& p, int L, int bid, int nb, unsigned char* smem) {
    const int M = L == 0 ? NTOK : NLAT;
    pg8::Gemm g{(const bf16_t*)(p.ws + WS_Y), (const bf16_t*)(p.ws + (L == 0 ? WS_WT_ABOUT : WS_WT_CDOUT)), M, D, D};
    pg8::StaticOrder So; So.init(M, D, nb, bid);
    pg8::EpiStoreBf16 E{(bf16_t*)(p.ws + WS_YO), D};
    pg8::gemm_phase<pg8::EpiStoreBf16, pg8::StaticOrder, true, true, false>((PG8_LAS unsigned char*)smem, g, So, E);
}

__device__ __forceinline__ void phase_ln1(const Params& p, int L, int bid, int nb, unsigned char* smem) {
    typedef float f32x4v __attribute__((ext_vector_type(4)));
    const float* MOD = (const float*)(p.ws + WS_MOD);
    const bf16_t* YO = (const bf16_t*)(p.ws + WS_YO);
    const bf16_t* X2 = (const bf16_t*)(p.ws + WS_X2);
    bf16_t* X1 = (bf16_t*)(p.ws + WS_X1);
    unsigned char* TOK8 = p.ws + WS_TOK;
    int* cnt = (int*)(p.ws + WS_CTL) + L * 32 * CNT_STRIDE;
    int* pair_e = (int*)(p.ws + WS_PAIR); int* pair_pos = pair_e + NTOK * 4; float* pair_gate = (float*)(pair_e + 3 * NTOK * 4);
    const int tidf = tid_fresh(); const int lane = tidf & 63, wv = tidf >> 6;
    constexpr int TKS = 1025;
    float* tokA = (float*)smem;
    float* part = (float*)(smem + 16 * TKS * 4 + 64);
    const LAS float* pl = (const LAS float*)(smem + LDS_PAR);
    int* lcnt = (int*)(smem + LDS_MISC);
    if (threadIdx.x < 2 * NE) lcnt[threadIdx.x] = 0;
    const int nrows = L == 0 ? NTOK : NLAT, ngrp = nrows / 16;
    const float* lg = p.ln1_g + L * D; const float* lb = p.ln1_b + L * D;
    const float* rw = p.router_w + (size_t)L * D * NE; const float* rb = p.router_b + L * NE;
    float4 xa[2][4]; uint2 ya[2][4];
    auto load_rows = [&](int g) {
        const int row0 = g * 16 + 2 * wv; const bool lt = row0 < NLAT;
        const float* xin0 = lt ? p.x + (size_t)row0 * D : p.ctx + (size_t)(row0 - NLAT) * D;
#pragma unroll
        for (int q = 0; q < 2; ++q)
#pragma unroll
            for (int j = 0; j < 4; ++j) { const int k = 4 * lane + 256 * j;
                if (L == 0) xa[q][j] = *(const float4*)(xin0 + (size_t)q * D + k);
                else { const uint2 xw = *(const uint2*)(X2 + (size_t)(row0 + q) * D + k); xa[q][j] = make_float4(bf2f(xw.x & 0xffffu), bf2f(xw.x >> 16), bf2f(xw.y & 0xffffu), bf2f(xw.y >> 16)); }
                ya[q][j] = *(const uint2*)(YO + (size_t)(row0 + q) * D + k); }
    };
    if (bid < ngrp) load_rows(bid);
    for (int grp = bid; grp < ngrp; grp += nb) {
        const int rowb = grp * 16; const bool lat = rowb < NLAT; const int rbat = lat ? (rowb >> 13) : 2;
        {
            const float* modb = MOD + (L * 3 + rbat) * 6144;
            __syncthreads();
            for (int i = threadIdx.x; i < 1280; i += blockDim.x) { const int vsel = i >> 8, idx = (i & 255) * 4;
                const float* src = vsel == 0 ? modb + 2048 : vsel == 1 ? modb + 3072 : vsel == 2 ? modb + 4096 : vsel == 3 ? lg : lb;
                const float4 t = *(const float4*)(src + idx);
                *(LAS float4v*)(smem + LDS_PAR + (vsel * 1024 + idx) * 4) = (float4v){t.x, t.y, t.z, t.w}; }
            __syncthreads();
        }
        {
            const int row0 = rowb + 2 * wv;
            float4 vq[2][4]; float sq[2];
#pragma unroll
            for (int q = 0; q < 2; ++q) {
                sq[q] = 0.f;
#pragma unroll
                for (int j = 0; j < 4; ++j) {
                    const int k = 4 * lane + 256 * j;
                    const float4 a = xa[q][j]; const uint2 yw = ya[q][j]; const float4 y = make_float4(bf2f(yw.x & 0xffffu), bf2f(yw.x >> 16), bf2f(yw.y & 0xffffu), bf2f(yw.y >> 16)); const float4v g = *(const LAS float4v*)(pl + k);
                    vq[q][j] = make_float4(ALPHA * a.x + g.x * y.x, ALPHA * a.y + g.y * y.y, ALPHA * a.z + g.z * y.z, ALPHA * a.w + g.w * y.w);
                    sq[q] += (vq[q][j].x + vq[q][j].y) + (vq[q][j].z + vq[q][j].w);
                }
            }
            if (grp + nb < ngrp) load_rows(grp + nb);
#pragma unroll
            for (int q = 0; q < 2; ++q) {
                const int row = row0 + q;
                float4 v[4]; float s = sq[q];
#pragma unroll
                for (int j = 0; j < 4; ++j) v[j] = vq[q][j];
                const float mean = wave_sum(s) * (1.f / D); float s2 = 0.f;
#pragma unroll
                for (int j = 0; j < 4; ++j) { v[j].x -= mean; v[j].y -= mean; v[j].z -= mean; v[j].w -= mean; s2 += (v[j].x * v[j].x + v[j].y * v[j].y) + (v[j].z * v[j].z + v[j].w * v[j].w); }
                const float rstd = rsqrtf(wave_sum(s2) * (1.f / D) + LN_EPS);
#pragma unroll
                for (int j = 0; j < 4; ++j) {
                    const int k = 4 * lane + 256 * j;
                    const float4v g = *(const LAS float4v*)(pl + 3072 + k), bb = *(const LAS float4v*)(pl + 4096 + k), a = *(const LAS float4v*)(pl + 2048 + k), b2 = *(const LAS float4v*)(pl + 1024 + k);
                    float4 x1 = make_float4(v[j].x * rstd * g.x + bb.x, v[j].y * rstd * g.y + bb.y, v[j].z * rstd * g.z + bb.z, v[j].w * rstd * g.w + bb.w);
                    { uint2 xo; xo.x = pk2(x1.x, x1.y); xo.y = pk2(x1.z, x1.w); *(uint2*)(X1 + (size_t)row * D + k) = xo; }
                    float4 tk = make_float4(x1.x * (1.f + a.x) + b2.x, x1.y * (1.f + a.y) + b2.y, x1.z * (1.f + a.z) + b2.z, x1.w * (1.f + a.w) + b2.w);
                    float* td = tokA + (2 * wv + q) * TKS + k; td[0] = tk.x; td[1] = tk.y; td[2] = tk.z; td[3] = tk.w;
                    *(unsigned*)(TOK8 + (size_t)row * D + k) = pk4_fp8(tk.x, tk.y, tk.z, tk.w);
                }
            }
        }
        __syncthreads();
        {
            f32x4v c0 = {0.f, 0.f, 0.f, 0.f}, c1 = {0.f, 0.f, 0.f, 0.f};
            const float* ta = tokA + (lane & 15) * TKS + 128 * wv + (lane >> 4);
            const float* wb = rw + (size_t)(128 * wv + (lane >> 4)) * NE + (lane & 15);
#pragma unroll 8
            for (int ks = 0; ks < 32; ++ks) {
                const float a = ta[4 * ks], b0 = wb[(size_t)(4 * ks) * NE], b1 = wb[(size_t)(4 * ks) * NE + 16];
                c0 = __builtin_amdgcn_mfma_f32_16x16x4f32(a, b0, c0, 0, 0, 0);
                c1 = __builtin_amdgcn_mfma_f32_16x16x4f32(a, b1, c1, 0, 0, 0);
            }
#pragma unroll
            for (int r = 0; r < 4; ++r) { float* pd = part + (wv * 16 + 4 * (lane >> 4) + r) * 32 + (lane & 15); pd[0] = c0[r]; pd[16] = c1[r]; }
        }
        __syncthreads();
        {
            const int e = lane & 31; const float rbe = rb[e];
#pragma unroll 1
            for (int q = 0; q < 2; ++q) {
                const int rl = 2 * wv + q, row = rowb + rl;
                float val = rbe;
#pragma unroll
                for (int w8 = 0; w8 < 8; ++w8) val += part[(w8 * 16 + rl) * 32 + e];
                int rank = 0;
#pragma unroll
                for (int j = 0; j < 32; ++j) { const float vj = __builtin_bit_cast(float, __builtin_amdgcn_readlane(__builtin_bit_cast(int, val), j)); rank += (vj > val || (vj == val && j < e)) ? 1 : 0; }
                float tv[4]; int ti[4];
#pragma unroll
                for (int rr = 0; rr < 4; ++rr) {
                    const unsigned msk = (unsigned)__ballot(rank == rr);
                    const int idx = __builtin_amdgcn_readfirstlane(__builtin_ctz(msk));
                    ti[rr] = idx; tv[rr] = __builtin_bit_cast(float, __builtin_amdgcn_readlane(__builtin_bit_cast(int, val), idx));
                }
                const float e0 = 1.f, e1 = __expf(tv[1] - tv[0]), e2 = __expf(tv[2] - tv[0]), e3 = __expf(tv[3] - tv[0]);
                const float inv = 1.f / (e0 + e1 + e2 + e3);
                const float gs4[4] = {e0 * inv, e1 * inv, e2 * inv, e3 * inv};
                if (lane == 0) {
#pragma unroll
                    for (int rr = 0; rr < 4; ++rr) {
                        const int pos = atomicAdd(&lcnt[ti[rr]], 1);
                        pair_e[row * 4 + rr] = ti[rr]; pair_pos[row * 4 + rr] = pos; pair_gate[row * 4 + rr] = gs4[rr];
                    }
                }
            }
        }
    }
    __syncthreads();
    if (threadIdx.x < NE) lcnt[NE + threadIdx.x] = atomicAdd(&cnt[threadIdx.x * CNT_STRIDE], lcnt[threadIdx.x]);
    __syncthreads();
    int* etok = (int*)(p.ws + WS_XB); float* egate = (float*)(p.ws + WS_XB + 4 * MiB);
    for (int grp = bid; grp < ngrp; grp += nb)
        if (threadIdx.x < 64) { const int pr = grp * 64 + threadIdx.x, e = pair_e[pr], pos = pair_pos[pr] + lcnt[NE + e];
            pair_pos[pr] = pos; etok[e * ECAP + pos] = pr >> 2; egate[e * ECAP + pos] = pair_gate[pr]; }
    __syncthreads();
}

__device__ __forceinline__ int moe_tile_table(const Params& p, int L, unsigned char* smem) {
    const int* cnt = (const int*)(p.ws + WS_CTL) + L * 32 * CNT_STRIDE;
    LAS int* tab = (LAS int*)(smem + LDS_MISC);
    __syncthreads();
    if (threadIdx.x == 0) { int t = 0;
        for (int e = 0; e < NE; ++e) { const int n = (cnt[e * CNT_STRIDE] + 255) / 256; tab[PSTART_AT + e] = t * 256; for (int q = 0; q < n; ++q) { tab[TOFF_AT + t] = e * ECAP - (t - q) * 256; tab[t++] = e; } }
        tab[320] = t; }
    __syncthreads();
    return tab[320];
}
__device__ __forceinline__ void phase_moe1(const Params& p, int L, int bid, int nb, unsigned char* smem) {
    const int T = moe_tile_table(p, L, smem);
    {
        const PG8_LAS int* tab = (const PG8_LAS int*)(smem + LDS_MISC);
        const int* pair_e = (const int*)(p.ws + WS_PAIR); const int* pair_pos = pair_e + NTOK * 4; int* pair_slot = (int*)pair_e + 2 * NTOK * 4;
        const int npairs = (L == 0 ? NTOK : NLAT) * 4;
        for (int pr = bid * blockDim.x + threadIdx.x; pr < npairs; pr += nb * blockDim.x) pair_slot[pr] = tab[PSTART_AT + pair_e[pr]] + pair_pos[pr];
    }
    pg8::Gemm g{(const bf16_t*)(p.ws + WS_TOK), (const bf16_t*)(p.ws + WS_WT_MIN + (size_t)L * 32 * 2048 * 1024), MAXSLOT, 32 * 2048, D / 2, (const int*)(p.ws + WS_XB)};
    pg8::MoeSched So; So.init(T, 8, nb, bid, (const PG8_LAS int*)(smem + LDS_MISC));
    pg8::EpiMoe1 E{(bf16_t*)(p.ws + WS_ACT), p.moe_b_in + (size_t)L * 32 * 2048, 1.0f / W8_SCALE};
    pg8::gemm_phase<pg8::EpiMoe1, pg8::MoeSched, true, true, true, true>((PG8_LAS unsigned char*)smem, g, So, E);
}
__device__ __forceinline__ void phase_moe2(const Params& p, int L, int bid, int nb, unsigned char* smem) {
    const int T = moe_tile_table(p, L, smem);
    pg8::Gemm g{(const bf16_t*)(p.ws + WS_ACT), (const bf16_t*)(p.ws + WS_WT_MOUT + (size_t)L * 32 * 1024 * 1024), MAXSLOT, 32 * 1024, D / 2};
    pg8::MoeSched So; So.init(T, 4, nb, bid, (const PG8_LAS int*)(smem + LDS_MISC));
    pg8::EpiMoe2 E{(bf16_t*)(p.ws + WS_YP), p.moe_b_out + (size_t)L * 32 * 1024, (const float*)(p.ws + WS_XB + 4 * MiB), 1.0f / (ACT8_SCALE * W8O_SCALE), (const PG8_LAS int*)(smem + LDS_MISC) + TOFF_AT};
    pg8::gemm_phase<pg8::EpiMoe2, pg8::MoeSched, true, true, true>((PG8_LAS unsigned char*)smem, g, So, E);
}

__device__ __forceinline__ void phase_ln2(const Params& p, int L, int bid, int nb) {
    const float* MOD = (const float*)(p.ws + WS_MOD);
    const bf16_t* X1 = (const bf16_t*)(p.ws + WS_X1);
    const unsigned char* YP8 = p.ws + WS_YP;
    const int* pair_slot = (const int*)(p.ws + WS_PAIR) + 2 * NTOK * 4;
    bf16_t* X2 = (bf16_t*)(p.ws + WS_X2); unsigned char* H8 = p.ws + WS_H;
    const int lane = threadIdx.x & 63, wv = threadIdx.x >> 6, nw = blockDim.x / 64;
    const int nrows = L == 0 ? NTOK : NLAT;
    const float* lg = p.ln2_g + L * D; const float* lb = p.ln2_b + L * D;
    for (int rp = bid * nw + wv; rp < nrows / 2; rp += nb * nw) {
        const int row0 = rp * 2;
        const bool lat = row0 < NLAT; const int r = lat ? (row0 >> 13) : 2;
        const float* mod = MOD + (L * 3 + r) * 6144; const float* g2 = mod + 5120;
        const float* modn = MOD + ((L == 0 ? 1 : 0) * 3 + r) * 6144;
        int sl[2][4];
#pragma unroll
        for (int q = 0; q < 2; ++q)
#pragma unroll
            for (int t = 0; t < 4; ++t) sl[q][t] = pair_slot[(row0 + q) * 4 + t];
        float4 xa[2][4]; unsigned yw[2][4][4];
#pragma unroll
        for (int q = 0; q < 2; ++q)
#pragma unroll
            for (int j = 0; j < 4; ++j) { const int k = 4 * lane + 256 * j; { const uint2 xw = *(const uint2*)(X1 + (size_t)(row0 + q) * D + k); xa[q][j] = make_float4(bf2f(xw.x & 0xffffu), bf2f(xw.x >> 16), bf2f(xw.y & 0xffffu), bf2f(xw.y >> 16)); }
#pragma unroll
                for (int t = 0; t < 4; ++t) yw[q][j][t] = *(const unsigned*)(YP8 + (size_t)sl[q][t] * D + k); }
        float4 fs[2][4];
#pragma unroll
        for (int q = 0; q < 2; ++q)
#pragma unroll
            for (int j = 0; j < 4; ++j) { float4 f = make_float4(0.f, 0.f, 0.f, 0.f);
#pragma unroll
                for (int t = 0; t < 4; ++t) { const unsigned w = yw[q][j][t]; const f2v lo = __builtin_amdgcn_cvt_pk_f32_fp8(w, false), hi = __builtin_amdgcn_cvt_pk_f32_fp8(w, true); f.x += lo.x; f.y += lo.y; f.z += hi.x; f.w += hi.y; }
                fs[q][j] = make_float4(f.x * (1.f / YP8_SCALE), f.y * (1.f / YP8_SCALE), f.z * (1.f / YP8_SCALE), f.w * (1.f / YP8_SCALE)); }
#pragma unroll 1
        for (int q = 0; q < 2; ++q) {
            const int row = row0 + q;
            float4 v[4]; float s = 0.f;
#pragma unroll
            for (int j = 0; j < 4; ++j) {
                const int k = 4 * lane + 256 * j;
                float4 f = q == 0 ? fs[0][j] : fs[1][j];
                const float4 a = q == 0 ? xa[0][j] : xa[1][j], g = *(const float4*)(g2 + k);
                v[j] = make_float4(ALPHA * a.x + g.x * f.x, ALPHA * a.y + g.y * f.y, ALPHA * a.z + g.z * f.z, ALPHA * a.w + g.w * f.w);
                s += (v[j].x + v[j].y) + (v[j].z + v[j].w);
            }
            const float mean = wave_sum(s) * (1.f / D); float s2 = 0.f;
#pragma unroll
            for (int j = 0; j < 4; ++j) { v[j].x -= mean; v[j].y -= mean; v[j].z -= mean; v[j].w -= mean; s2 += (v[j].x * v[j].x + v[j].y * v[j].y) + (v[j].z * v[j].z + v[j].w * v[j].w); }
            const float rstd = rsqrtf(wave_sum(s2) * (1.f / D) + LN_EPS);
#pragma unroll
            for (int j = 0; j < 4; ++j) {
                const int k = 4 * lane + 256 * j;
                const float4 g = *(const float4*)(lg + k), bb = *(const float4*)(lb + k);
                const float4 x2 = make_float4(v[j].x * rstd * g.x + bb.x, v[j].y * rstd * g.y + bb.y, v[j].z * rstd * g.z + bb.z, v[j].w * rstd * g.w + bb.w);
                if (L == 0) {
                    { uint2 xo; xo.x = pk2(x2.x, x2.y); xo.y = pk2(x2.z, x2.w); *(uint2*)(X2 + (size_t)row * D + k) = xo; }
                    const float4 b = *(const float4*)(modn + k), a = *(const float4*)(modn + 1024 + k);
                    *(unsigned*)(H8 + (size_t)row * D + k) = pk4_fp8(x2.x * (1.f + a.x) + b.x, x2.y * (1.f + a.y) + b.y, x2.z * (1.f + a.z) + b.z, x2.w * (1.f + a.w) + b.w);
                } else {
                    *(float4*)(p.out + (size_t)row * D + k) = x2;
                }
            }
        }
    }
}

namespace att {
typedef short bf16x8 __attribute__((ext_vector_type(8)));
typedef float f32x16 __attribute__((ext_vector_type(16)));
typedef unsigned u4v __attribute__((ext_vector_type(4)));
typedef unsigned u2v __attribute__((ext_vector_type(2)));
constexpr int KROWB = 144, VROWB = 136, KBUF = 64 * KROWB, VBUF = 128 * VROWB;
constexpr int L_K = 0, L_V = 4 * KBUF, L_BIAS = 4 * KBUF + 4 * VBUF, L_X = L_BIAS + 2048, L_END = L_X + 2048;
constexpr float LOG2E = 1.4426950408889634f, C2 = 0.125f * LOG2E, NEGBIG = -1e30f;
constexpr float THR_L2 = 8.0f;
__device__ __forceinline__ int crow(int r, int hi) { return (r & 3) + 8 * (r >> 2) + 4 * hi; }
__device__ __forceinline__ unsigned cvtpk(float lo, float hi) { unsigned r; asm volatile("v_cvt_pk_bf16_f32 %0, %1, %2" : "=v"(r) : "v"(lo), "v"(hi)); return r; }
__device__ __forceinline__ float xhalf_max(float v) { auto rr = __builtin_amdgcn_permlane32_swap(__float_as_uint(v), __float_as_uint(v), false, false); return fmaxf(__uint_as_float(rr[0]), __uint_as_float(rr[1])); }
__device__ __forceinline__ float xhalf_sum(float v) { auto rr = __builtin_amdgcn_permlane32_swap(__float_as_uint(v), __float_as_uint(v), false, false); return __uint_as_float(rr[0]) + __uint_as_float(rr[1]); }

template <int VR> struct TileRegs { u4v k; u4v v[VR / 64]; };
template <int VR>
__device__ __forceinline__ void tile_load(TileRegs<VR>& t, const bf16_t* Kh, const bf16_t* VTh, int pos0, int tid) {
    const int row = tid >> 3, ch = tid & 7;
    t.k = *(const u4v*)(Kh + (size_t)(pos0 + row) * 64 + ch * 8);
#pragma unroll
    for (int i = 0; i < VR / 64; ++i) t.v[i] = *(const u4v*)(VTh + (size_t)(row + 64 * i) * SP + pos0 + ch * 8);
}
template <int VR>
__device__ __forceinline__ void tile_store(const TileRegs<VR>& t, LAS unsigned char* lds, int buf, int tid) {
    const int row = tid >> 3, ch = tid & 7;
    *(LAS u4v*)(lds + L_K + buf * KBUF + row * KROWB + ch * 16) = t.k;
#pragma unroll
    for (int i = 0; i < VR / 64; ++i) {
        LAS u2v* d = (LAS u2v*)(lds + L_V + buf * VBUF + (row + 64 * i) * VROWB + ch * 16);
        d[0] = (u2v){t.v[i].x, t.v[i].y}; d[1] = (u2v){t.v[i].z, t.v[i].w};
    }
}

struct MaskArgs { int rq, cq; const LAS float* biasL; };

template <int MODE>
__device__ __forceinline__ void softmax_half(f32x16& p, bf16x8 (&pb)[2], f32x16 (&o)[2], float& m, float& l, bf16x8& qx, int kpos0  , bool lat, int qp, int rq, int cq, const LAS float* biasL, int hi) {
    float mx = NEGBIG;
#pragma unroll
    for (int r = 0; r < 16; ++r) {
        float t = p[r];
        if (MODE == 1) { if (lat) { const int dd = qp - (kpos0 + crow(r, hi)); if (dd > 128 || dd < -128) t = NEGBIG; } }
        if (MODE == 2) {
            if (lat) {
                const int krow = (kpos0 - 256) >> 6, kc = ((kpos0 - 256) & 63) + crow(r, hi);
                const int ws = min(max(cq - 8, 0), 48);
                const bool valid = (unsigned)(kc - ws) < 16u;
                const int dc = min(max(kc - cq + 15, 0), 30);
                const float bv = biasL[(krow - rq + 7) * 31 + dc];
                t = valid ? t + bv : NEGBIG; } }
        if (MODE != 0) p[r] = t;
        mx = fmaxf(mx, t);
    }
    mx = xhalf_max(mx);
    if (__any(mx > THR_L2)) {
        const float mn = bf2f(f2bf(m + fmaxf(mx, 0.f))), dl = mn - m, alpha = __builtin_amdgcn_exp2f(-dl);
        m = mn; l *= alpha;
#pragma unroll
        for (int dt = 0; dt < 2; ++dt)
#pragma unroll
            for (int r = 0; r < 16; ++r) o[dt][r] *= alpha;
#pragma unroll
        for (int r = 0; r < 16; ++r) p[r] -= dl;
        qx[0] = (short)(hi == 0 ? f2bf(-mn) : 0u);
    }
    float sum = 0.f;
#pragma unroll
    for (int r = 0; r < 16; ++r) { const float e = __builtin_amdgcn_exp2f(p[r]); p[r] = e; sum += e; }
    l += sum;
#pragma unroll
    for (int s = 0; s < 2; ++s) {
        const int s8 = s * 8;
        u4v w; w.x = cvtpk(p[s8 + 0], p[s8 + 1]); w.y = cvtpk(p[s8 + 2], p[s8 + 3]); w.z = cvtpk(p[s8 + 4], p[s8 + 5]); w.w = cvtpk(p[s8 + 6], p[s8 + 7]);
        pb[s] = __builtin_bit_cast(bf16x8, w);
    }
}

template <int VR, int MODE, bool QPROC = false>
__device__ __forceinline__ void attn_pass(LAS unsigned char* lds, const bf16_t* Qh, const bf16_t* Kh, const bf16_t* VTh, int qpw, int vrow, bool wave_on, int ta0, int na, int tb0, int nbt,
                                          f32x16 (&o)[2][2], float (&m)[2], float (&l)[2], int rq, const LAS float* biasL, const float* qw = nullptr, const float2* ROPE = nullptr) {
    int tid = threadIdx.x; asm volatile("" : "+v"(tid));
    const int lane = tid & 63, r32 = lane & 31, hi = lane >> 5;
    bf16x8 qf[2][4];
#pragma unroll
    for (int j = 0; j < 2; ++j)
#pragma unroll
        for (int ks = 0; ks < 4; ++ks) qf[j][ks] = *(const bf16x8*)(Qh + (size_t)(qpw + 32 * j + r32) * 64 + ks * 16 + hi * 8);
    if (QPROC) {
#pragma unroll
        for (int j = 0; j < 2; ++j) {
            float v[4][8]; float ss = 0.f;
#pragma unroll
            for (int ks = 0; ks < 4; ++ks)
#pragma unroll
                for (int e = 0; e < 8; ++e) { v[ks][e] = bf2f((unsigned short)qf[j][ks][e]); ss += v[ks][e] * v[ks][e]; }
            const float sc = rsqrtf(xhalf_sum(ss) * (1.f / 64.f) + RMS_EPS) * C2;
            const int t = qpw + 32 * j + r32 - 256;
#pragma unroll
            for (int ks = 0; ks < 4; ++ks) {
                const int d0 = 16 * ks + 8 * hi;
                const float4 w0 = *(const float4*)(qw + d0), w1 = *(const float4*)(qw + d0 + 4);
                const float4 c01 = *(const float4*)(ROPE + t * 32 + (d0 >> 1)), c23 = *(const float4*)(ROPE + t * 32 + (d0 >> 1) + 2);
                const float x0 = v[ks][0] * sc * w0.x, x1 = v[ks][1] * sc * w0.y, x2 = v[ks][2] * sc * w0.z, x3 = v[ks][3] * sc * w0.w;
                const float x4 = v[ks][4] * sc * w1.x, x5 = v[ks][5] * sc * w1.y, x6 = v[ks][6] * sc * w1.z, x7 = v[ks][7] * sc * w1.w;
                u4v w; w.x = cvtpk(x0 * c01.x - x1 * c01.y, x0 * c01.y + x1 * c01.x); w.y = cvtpk(x2 * c01.z - x3 * c01.w, x2 * c01.w + x3 * c01.z);
                w.z = cvtpk(x4 * c23.x - x5 * c23.y, x4 * c23.y + x5 * c23.x); w.w = cvtpk(x6 * c23.z - x7 * c23.w, x6 * c23.w + x7 * c23.z);
                qf[j][ks] = __builtin_bit_cast(bf16x8, w);
            }
        }
    }
    if (!QPROC) {
#pragma unroll
        for (int j = 0; j < 2; ++j)
#pragma unroll
            for (int ks = 0; ks < 4; ++ks) { u4v w;
#pragma unroll
                for (int e2 = 0; e2 < 4; ++e2) w[e2] = cvtpk(bf2f((unsigned short)qf[j][ks][2 * e2]) * C2, bf2f((unsigned short)qf[j][ks][2 * e2 + 1]) * C2);
                qf[j][ks] = __builtin_bit_cast(bf16x8, w); }
    }
    bf16x8 qx[2]; bf16x8 kone;
#pragma unroll
    for (int e = 0; e < 8; ++e) { qx[0][e] = 0; qx[1][e] = 0; kone[e] = 0; }
    kone[0] = (short)(hi == 0 ? 0x3f80 : 0);
#pragma unroll
    for (int j = 0; j < 2; ++j) {
        m[j] = 0.f; l[j] = 0.f;
#pragma unroll
        for (int dt = 0; dt < 2; ++dt)
#pragma unroll
            for (int r = 0; r < 16; ++r) o[j][dt][r] = 0.f;
    }
    const int n = na + nbt;
    TileRegs<VR> tr;
#define ATT_TPOS(i_) (((i_) < na ? ta0 + (i_) : tb0 + ((i_) - na)) * 64)
    tile_load<VR>(tr, Kh, VTh, ATT_TPOS(0), tid); tile_store<VR>(tr, lds, 0, tid);
    if (n > 1) { tile_load<VR>(tr, Kh, VTh, ATT_TPOS(1), tid); tile_store<VR>(tr, lds, 1, tid); }
    __syncthreads();
    for (int ip = 0; 2 * ip < n; ++ip) {
        const int cb = ip & 1;
#pragma unroll
        for (int h2 = 0; h2 < 2; ++h2) {
            const int i = 2 * ip + h2, inx = i + 2;
            if (inx < n) tile_load<VR>(tr, Kh, VTh, ATT_TPOS(inx), tid);
            if (i < n) {
                const int pos0 = ATT_TPOS(i), slot = 2 * cb + h2;
                bool active = wave_on;
                if (MODE == 1 && pos0 >= 256) active = active && (pos0 <= qpw + 63 + 128) && (pos0 + 63 >= qpw - 128);
                if (MODE == 2 && pos0 >= 256) { const int krow = (pos0 - 256) >> 6, rs = min(max(rq - 4, 0), 120); active = active && (krow >= rs) && (krow < rs + 8); }
        if (active) {
                    const LAS unsigned char* kb = lds + L_K + slot * KBUF;
                    const LAS unsigned char* vb = lds + L_V + slot * VBUF + vrow * VROWB;
        #pragma unroll
                    for (int kt = 0; kt < 2; ++kt) {
                        f32x16 p[2];
        #pragma unroll
                        for (int r = 0; r < 16; ++r) { p[0][r] = 0.f; p[1][r] = 0.f; }
        #pragma unroll
                        for (int ks = 0; ks < 4; ++ks) {
                            const bf16x8 a = *(const LAS bf16x8*)(kb + (32 * kt + r32) * KROWB + ks * 32 + hi * 16);
                            p[0] = __builtin_amdgcn_mfma_f32_32x32x16_bf16(a, qf[0][ks], p[0], 0, 0, 0);
                            p[1] = __builtin_amdgcn_mfma_f32_32x32x16_bf16(a, qf[1][ks], p[1], 0, 0, 0);
                        }
                        p[0] = __builtin_amdgcn_mfma_f32_32x32x16_bf16(kone, qx[0], p[0], 0, 0, 0);
                        p[1] = __builtin_amdgcn_mfma_f32_32x32x16_bf16(kone, qx[1], p[1], 0, 0, 0);
                        bf16x8 pb[2][2];
                        softmax_half<MODE>(p[0], pb[0], o[0], m[0], l[0], qx[0], pos0 + 32 * kt, pos0 >= 256, qpw + r32, rq, r32, biasL, hi);
                        softmax_half<MODE>(p[1], pb[1], o[1], m[1], l[1], qx[1], pos0 + 32 * kt, pos0 >= 256, qpw + 32 + r32, rq, 32 + r32, biasL, hi);
        #pragma unroll
                        for (int dt = 0; dt < 2; ++dt)
        #pragma unroll
                            for (int s = 0; s < 2; ++s) {
                                const int sp = 2 * kt + s;
                                const LAS unsigned char* vp = vb + (32 * dt + r32) * VROWB + (16 * sp + 4 * hi) * 2;
                                const u2v lo = *(const LAS u2v*)vp, hi2 = *(const LAS u2v*)(vp + 16);
                                const bf16x8 a = __builtin_bit_cast(bf16x8, (u4v){lo.x, lo.y, hi2.x, hi2.y});
                                o[0][dt] = __builtin_amdgcn_mfma_f32_32x32x16_bf16(a, pb[0][s], o[0][dt], 0, 0, 0);
                                o[1][dt] = __builtin_amdgcn_mfma_f32_32x32x16_bf16(a, pb[1][s], o[1][dt], 0, 0, 0);
                            }
                    }
                }
            }
            if (inx < n) tile_store<VR>(tr, lds, 2 * (cb ^ 1) + h2, tid);
        }
        __syncthreads();
    }
#undef ATT_TPOS
}

__device__ __forceinline__ void store_out(bf16_t* yrow  , const f32x16 (&o)[2], float sc, int hi) {
#pragma unroll
    for (int dt = 0; dt < 2; ++dt)
#pragma unroll
        for (int g = 0; g < 4; ++g) {
            uint2 w; w.x = cvtpk(o[dt][4 * g + 0] * sc, o[dt][4 * g + 1] * sc); w.y = cvtpk(o[dt][4 * g + 2] * sc, o[dt][4 * g + 3] * sc);
            *(uint2*)(yrow + 32 * dt + 8 * g + 4 * hi) = w;
        }
}
}


constexpr int BG_OFF = 110592;
__device__ __forceinline__ int bg_region(int w) { return w < 5 ? BG_OFF + w * 4096 : LDS_PAR + (w - 5) * 4096; }
constexpr int BG_SLOTS = 96, BG_VB = 256;
struct BgConv { int s, end; bool fly; const float* src; unsigned char* dst; };
__device__ __forceinline__ void bg_seek(const Params& p, BgConv& bg, int vb) {
    if (bg.s < 64) {
        const int n0 = (vb & 31) * 64, k0 = (vb >> 5) * 128, nn = n0 & 1023, drow = 256 * (nn >> 7) + (nn & 127) + (n0 >= 1024 ? 128 : 0);
        bg.src = p.moe_w_in + (size_t)bg.s * 1024 * 2048 + (size_t)k0 * 2048 + n0;
        bg.dst = p.ws + WS_WT_MIN + (size_t)bg.s * 2048 * 1024 + (size_t)drow * 1024 + k0;
    } else {
        const int le = 2 * (bg.s - 64) + (vb >> 7), q2 = vb & 127, n0 = (q2 & 15) * 64, k0 = (q2 >> 4) * 128;
        bg.src = p.moe_w_out + (size_t)le * 1024 * 1024 + (size_t)k0 * 1024 + n0;
        bg.dst = p.ws + WS_WT_MOUT + (size_t)le * 1024 * 1024 + (size_t)n0 * 1024 + k0;
    }
}
__device__ __forceinline__ void bg_start(LAS unsigned char* lds, BgConv& bg) {
    if (bg.s < bg.end) {
        int tid = threadIdx.x; asm volatile("" : "+v"(tid));
        const int lane = tid & 63, w = __builtin_amdgcn_readfirstlane(tid >> 6);
        const int sh = bg.s < 64 ? 11 : 10;
        bg.fly = true;
        const float* src = bg.src + (((size_t)(16 * w + (lane >> 4))) << sh) + 4 * (lane & 15);
        const unsigned l0 = __builtin_amdgcn_readfirstlane((unsigned)(size_t)(lds + bg_region(w)));
        const size_t st = (size_t)4 << sh;
        const float* s1 = src + st; const float* s2 = src + 2 * st; const float* s3 = src + 3 * st;
        asm volatile("s_mov_b32 m0, %4\n\ts_nop 0\n\tglobal_load_lds_dwordx4 %0, off\n\t"
                     "s_mov_b32 m0, %5\n\ts_nop 0\n\tglobal_load_lds_dwordx4 %1, off\n\t"
                     "s_mov_b32 m0, %6\n\ts_nop 0\n\tglobal_load_lds_dwordx4 %2, off\n\t"
                     "s_mov_b32 m0, %7\n\ts_nop 0\n\tglobal_load_lds_dwordx4 %3, off"
                     :: "v"(src), "v"(s1), "v"(s2), "v"(s3), "s"(l0), "s"(l0 + 1024u), "s"(l0 + 2048u), "s"(l0 + 3072u) : "m0", "memory");
    }
}
__device__ __forceinline__ void bg_finish(const Params& p, LAS unsigned char* lds, BgConv& bg, int vb) {
    if (bg.fly) {
        asm volatile("s_waitcnt vmcnt(0)" ::: "memory");
        int tid = threadIdx.x; asm volatile("" : "+v"(tid));
        const int lane = tid & 63, w = __builtin_amdgcn_readfirstlane(tid >> 6);
        const LAS float* sp = (const LAS float*)(lds + bg_region(w)) + lane;
        const float sc = bg.s < 64 ? W8_SCALE : W8O_SCALE;
        float v[16];
#pragma unroll
        for (int i = 0; i < 16; ++i) v[i] = sp[i * 64] * sc;
        uint4 o; o.x = pk4_fp8(v[0], v[1], v[2], v[3]); o.y = pk4_fp8(v[4], v[5], v[6], v[7]); o.z = pk4_fp8(v[8], v[9], v[10], v[11]); o.w = pk4_fp8(v[12], v[13], v[14], v[15]);
        *(uint4*)(bg.dst + (size_t)lane * 1024 + 16 * w) = o;
        asm volatile("s_waitcnt lgkmcnt(0)" ::: "memory");
        bg.fly = false; ++bg.s;
        if (bg.s == 64) bg_seek(p, bg, vb); else { bg.src += 2 * 1024 * 1024; bg.dst += 2 * 1024 * 1024; }
    }
}
namespace attd {
typedef short bf16x8 __attribute__((ext_vector_type(8)));
typedef float f32x16 __attribute__((ext_vector_type(16)));
typedef unsigned u4v __attribute__((ext_vector_type(4)));
typedef unsigned u2v __attribute__((ext_vector_type(2)));
constexpr int KROWB = 144, VROWB = 136, KBUF = 64 * KROWB, VBUF = 128 * VROWB;
constexpr int L_K = 0, L_V = 4 * KBUF, L_BIAS = 4 * KBUF + 4 * VBUF, L_END = L_BIAS + 2048;
constexpr float LOG2E = 1.4426950408889634f, C2 = 0.125f * LOG2E, NEGBIG = -1e30f;
__device__ __forceinline__ int crow(int r, int hi) { return (r & 3) + 8 * (r >> 2) + 4 * hi; }
__device__ __forceinline__ unsigned cvtpk(float lo, float hi) { unsigned r; asm volatile("v_cvt_pk_bf16_f32 %0, %1, %2" : "=v"(r) : "v"(lo), "v"(hi)); return r; }

template <int DV> struct TileRegs { u4v k; u4v v[DV / 64]; };
template <int DV>
__device__ __forceinline__ void tile_load(TileRegs<DV>& t, const bf16_t* Kh, const bf16_t* VTh, int pos0, int tid) {
    const int row = tid >> 3, ch = tid & 7;
    t.k = *(const u4v*)(Kh + (size_t)(pos0 + row) * 64 + ch * 8);
#pragma unroll
    for (int i = 0; i < DV / 64; ++i) t.v[i] = *(const u4v*)(VTh + (size_t)(row + 64 * i) * SP + pos0 + ch * 8);
}
template <int DV>
__device__ __forceinline__ void tile_store(const TileRegs<DV>& t, LAS unsigned char* lds, int kbuf, int vbuf, int tid) {
    const int row = tid >> 3, ch = tid & 7;
    *(LAS u4v*)(lds + L_K + kbuf * KBUF + row * KROWB + ch * 16) = t.k;
#pragma unroll
    for (int i = 0; i < DV / 64; ++i) {
        LAS u2v* d = (LAS u2v*)(lds + L_V + vbuf * VBUF + (row + 64 * i) * VROWB + ch * 16);
        d[0] = (u2v){t.v[i].x, t.v[i].y}; d[1] = (u2v){t.v[i].z, t.v[i].w};
    }
}

struct MaskArgs { int rq, cq; const LAS float* biasL; };
constexpr float THR_L2 = 8.0f;

__device__ __forceinline__ void qk_step(f32x16 (&p)[2], const LAS unsigned char* kb, const bf16x8 (&qf)[4], int r32, int hi) {
#pragma unroll
    for (int kt = 0; kt < 2; ++kt) {
#pragma unroll
        for (int r = 0; r < 16; ++r) p[kt][r] = 0.f;
#pragma unroll
        for (int ks = 0; ks < 4; ++ks) {
            const bf16x8 a = *(const LAS bf16x8*)(kb + (32 * kt + r32) * KROWB + ks * 32 + hi * 16);
            p[kt] = __builtin_amdgcn_mfma_f32_32x32x16_bf16(a, qf[ks], p[kt], 0, 0, 0);
        }
    }
}
template <int DV, int MODE>
__device__ __forceinline__ void softmax_step(f32x16 (&p)[2], bf16x8 (&pb)[4], f32x16 (&o)[DV / 32], float& m, float& l, int pos0, int qp, const MaskArgs& ma, int hi) {
    constexpr float XS = (MODE == 2) ? 1.0f : C2;
    constexpr float THR = THR_L2 / XS;
    float mx; float mxp[4] = {NEGBIG, NEGBIG, NEGBIG, NEGBIG};
#pragma unroll
    for (int kt = 0; kt < 2; ++kt)
#pragma unroll
        for (int r = 0; r < 16; ++r) {
            float t = p[kt][r];
            if (MODE == 1) { if (pos0 >= 256) { const int dd = qp - (pos0 + 32 * kt + crow(r, hi)); if (dd > 128 || dd < -128) t = NEGBIG; } }
            if (MODE == 2) {
                t *= C2;
                if (pos0 >= 256) {
                    const int krow = (pos0 - 256) >> 6, kc = 32 * kt + crow(r, hi);
                    const int ws = min(max(ma.cq - 8, 0), 48);
                    const bool valid = (unsigned)(kc - ws) < 16u;
                    const int dc = min(max(kc - ma.cq + 15, 0), 30);
                    const float bv = ma.biasL[(krow - ma.rq + 7) * 31 + dc];
                    t = valid ? t + bv : NEGBIG; } }
            p[kt][r] = t; mxp[r & 3] = fmaxf(mxp[r & 3], t);
        }
    mx = fmaxf(fmaxf(mxp[0], mxp[1]), fmaxf(mxp[2], mxp[3]));
    { auto rr = __builtin_amdgcn_permlane32_swap(__float_as_uint(mx), __float_as_uint(mx), false, false);
      mx = fmaxf(__uint_as_float(rr[0]), __uint_as_float(rr[1])); }
    if (__any(mx > m + THR)) {
        const float mn = fmaxf(m, mx), alpha = __builtin_amdgcn_exp2f((m - mn) * XS);
        m = mn; l *= alpha;
#pragma unroll
        for (int dt = 0; dt < DV / 32; ++dt)
#pragma unroll
            for (int r = 0; r < 16; ++r) o[dt][r] *= alpha;
    }
    const float nm = -m * XS;
    float sm[4] = {0.f, 0.f, 0.f, 0.f};
#pragma unroll
    for (int kt = 0; kt < 2; ++kt)
#pragma unroll
        for (int r = 0; r < 16; ++r) { const float e = __builtin_amdgcn_exp2f(MODE == 2 ? p[kt][r] + nm : fmaf(p[kt][r], C2, nm)); p[kt][r] = e; sm[r & 3] += e; }
    l += (sm[0] + sm[1]) + (sm[2] + sm[3]);
#pragma unroll
    for (int sp = 0; sp < 4; ++sp) {
        const int kt = sp >> 1, s8 = (sp & 1) * 8;
        u4v w; w.x = cvtpk(p[kt][s8 + 0], p[kt][s8 + 1]); w.y = cvtpk(p[kt][s8 + 2], p[kt][s8 + 3]); w.z = cvtpk(p[kt][s8 + 4], p[kt][s8 + 5]); w.w = cvtpk(p[kt][s8 + 6], p[kt][s8 + 7]);
        pb[sp] = __builtin_bit_cast(bf16x8, w);
    }
}
template <int DV>
__device__ __forceinline__ void pv_step(f32x16 (&o)[DV / 32], const LAS unsigned char* vb, const bf16x8 (&pb)[4], int r32, int hi) {
#pragma unroll
    for (int dt = 0; dt < DV / 32; ++dt)
#pragma unroll
        for (int sp = 0; sp < 4; ++sp) {
            const LAS unsigned char* vp = vb + (32 * dt + r32) * VROWB + (16 * sp + 4 * hi) * 2;
            const u2v lo = *(const LAS u2v*)vp, hi2 = *(const LAS u2v*)(vp + 16);
            const u4v w = (u4v){lo.x, lo.y, hi2.x, hi2.y};
            o[dt] = __builtin_amdgcn_mfma_f32_32x32x16_bf16(__builtin_bit_cast(bf16x8, w), pb[sp], o[dt], 0, 0, 0);
        }
}

template <int DV, int MODE, int PINGPONG = 1>
__device__ __forceinline__ void attn_pass(LAS unsigned char* lds, const bf16_t* Qh, const bf16_t* Kh, const bf16_t* VTh, int qpos0, int ta0, int na, int tb0, int nbt,
                                          f32x16 (&o)[DV / 32], float& m, float& l, const MaskArgs& ma, const float* qnorm_w, const Params& prm, BgConv& bg, int bid, int nb) {
    int tid = threadIdx.x; asm volatile("" : "+v"(tid));
    const int lane = tid & 63, w = __builtin_amdgcn_readfirstlane(tid >> 6), r32 = lane & 31, hi = lane >> 5;
    const int qp = qpos0 + 32 * w + r32;
    bf16x8 qf[4];
#pragma unroll
    for (int ks = 0; ks < 4; ++ks) qf[ks] = *(const bf16x8*)(Qh + (size_t)qp * 64 + ks * 16 + hi * 8);
#pragma unroll
    for (int dt = 0; dt < DV / 32; ++dt)
#pragma unroll
        for (int r = 0; r < 16; ++r) o[dt][r] = 0.f;
    m = NEGBIG; l = 0.f;
    const int n = na + nbt;
    TileRegs<DV> tr, tr1;
#define ATT_TPOS(i_) (((i_) < na ? ta0 + (i_) : tb0 + ((i_) - na)) * 64)
    static_assert(PINGPONG == 0, "the pair loop is the in-step form");
    tile_load<DV>(tr, Kh, VTh, ATT_TPOS(0), tid); tile_store<DV>(tr, lds, 0, 0, tid);
    if (n > 1) { tile_load<DV>(tr, Kh, VTh, ATT_TPOS(1), tid); tile_store<DV>(tr, lds, 1, 1, tid); }
    __syncthreads();
    const int qlo = qpos0 + 32 * w;
    f32x16 p[2]; bf16x8 pb[4];
    for (int ip = 0; 2 * ip < n; ++ip) {
        const int cb = ip & 1, i0 = 2 * ip + 2;
        if (i0 < n) tile_load<DV>(tr, Kh, VTh, ATT_TPOS(i0), tid);
        if (i0 + 1 < n) tile_load<DV>(tr1, Kh, VTh, ATT_TPOS(i0 + 1), tid);
        bg_start(lds, bg);
#pragma unroll
        for (int h2 = 0; h2 < 2; ++h2) {
            const int i = 2 * ip + h2;
            if (i < n) {
                const int pos0 = ATT_TPOS(i), slot = 2 * cb + h2;
                bool active = true;
                if (MODE == 1 && pos0 >= 256) active = (pos0 <= qlo + 31 + 128) && (pos0 + 63 >= qlo - 128);
                if (MODE == 2 && pos0 >= 256) { const int krow = (pos0 - 256) >> 6, rs = min(max(ma.rq - 4, 0), 120); active = (krow >= rs) && (krow < rs + 8); }
                if (active) {
                    qk_step(p, lds + L_K + slot * KBUF, qf, r32, hi);
                    softmax_step<DV, MODE>(p, pb, o, m, l, pos0, qp, ma, hi);
                    pv_step<DV>(o, lds + L_V + slot * VBUF, pb, r32, hi);
                }
            }
        }
        if (i0 < n) tile_store<DV>(tr, lds, 2 * (cb ^ 1), 2 * (cb ^ 1), tid);
        if (i0 + 1 < n) tile_store<DV>(tr1, lds, 2 * (cb ^ 1) + 1, 2 * (cb ^ 1) + 1, tid);
        __syncthreads();
        bg_finish(prm, lds, bg, bid);
    }
#undef ATT_TPOS
}

template <int DV>
__device__ __forceinline__ void store_out(bf16_t* yrow  , const f32x16 (&o)[DV / 32], float sc, int hi) {
#pragma unroll
    for (int dt = 0; dt < DV / 32; ++dt)
#pragma unroll
        for (int g = 0; g < 4; ++g) {
            uint2 w; w.x = cvtpk(o[dt][4 * g + 0] * sc, o[dt][4 * g + 1] * sc); w.y = cvtpk(o[dt][4 * g + 2] * sc, o[dt][4 * g + 3] * sc);
            *(uint2*)(yrow + 32 * dt + 8 * g + 4 * hi) = w;
        }
}
}
__device__ __forceinline__ void diff_unit(const Params& p, LAS unsigned char* lds, int b, int hd, int qpos0, int ntile_a, size_t yrow0, int scr_unit, BgConv& bg, int bid, int nb) {
    const bf16_t* Q = (const bf16_t*)(p.ws + WS_Q); const bf16_t* Kb = (const bf16_t*)(p.ws + WS_K); const bf16_t* VT = (const bf16_t*)(p.ws + WS_VT);
    const bf16_t* VTh = VT + ((size_t)b * 1024 + 512 + hd * 128) * SP;
    attd::MaskArgs ma{0, 0, nullptr};
    attd::f32x16 o[4]; float m, l;
    attd::attn_pass<128, 0, 0>(lds, Q + (size_t)(b * NQH + 8 + 2 * hd) * SP * 64, Kb + (size_t)(b * 16 + 8 + 2 * hd) * SP * 64, VTh, qpos0, 0, ntile_a, 0, 0, o, m, l, ma, nullptr, p, bg, bid, nb);
    { int t1 = threadIdx.x; asm volatile("" : "+v"(t1));
      float4* SCR = (float4*)(p.ws + WS_SCR) + ((size_t)(scr_unit * 8 + (t1 >> 6)) * 16) * 64 + (t1 & 63);
      float lt = l; { auto rr = __builtin_amdgcn_permlane32_swap(__float_as_uint(lt), __float_as_uint(lt), false, false); lt = __uint_as_float(rr[0]) + __uint_as_float(rr[1]); }
      const float il = 1.f / lt;
#pragma unroll
      for (int dt = 0; dt < 4; ++dt)
#pragma unroll
          for (int g = 0; g < 4; ++g) SCR[(dt * 4 + g) * 64] = make_float4(o[dt][4 * g] * il, o[dt][4 * g + 1] * il, o[dt][4 * g + 2] * il, o[dt][4 * g + 3] * il); }
    attd::attn_pass<128, 0, 0>(lds, Q + (size_t)(b * NQH + 8 + 2 * hd + 1) * SP * 64, Kb + (size_t)(b * 16 + 8 + 2 * hd + 1) * SP * 64, VTh, qpos0, 0, ntile_a, 0, 0, o, m, l, ma, nullptr, p, bg, bid, nb);
    int t2 = threadIdx.x; asm volatile("" : "+v"(t2));
    const int lane = t2 & 63, w = t2 >> 6, r32 = lane & 31, hi = lane >> 5;
    const float4* SCR = (const float4*)(p.ws + WS_SCR) + ((size_t)(scr_unit * 8 + w) * 16) * 64 + lane;
    const float lam = ((const float*)(p.ws + WS_SCAL))[0];
    float lt = l; { auto rr = __builtin_amdgcn_permlane32_swap(__float_as_uint(lt), __float_as_uint(lt), false, false); lt = __uint_as_float(rr[0]) + __uint_as_float(rr[1]); }
    const float il2 = lam / lt;
    float ss = 0.f;
#pragma unroll
    for (int dt = 0; dt < 4; ++dt)
#pragma unroll
        for (int g = 0; g < 4; ++g) {
            const float4 a = SCR[(dt * 4 + g) * 64];
            o[dt][4 * g] = a.x - o[dt][4 * g] * il2; o[dt][4 * g + 1] = a.y - o[dt][4 * g + 1] * il2; o[dt][4 * g + 2] = a.z - o[dt][4 * g + 2] * il2; o[dt][4 * g + 3] = a.w - o[dt][4 * g + 3] * il2;
            ss += o[dt][4 * g] * o[dt][4 * g] + o[dt][4 * g + 1] * o[dt][4 * g + 1] + o[dt][4 * g + 2] * o[dt][4 * g + 2] + o[dt][4 * g + 3] * o[dt][4 * g + 3];
        }
    { auto rr = __builtin_amdgcn_permlane32_swap(__float_as_uint(ss), __float_as_uint(ss), false, false); ss = __uint_as_float(rr[0]) + __uint_as_float(rr[1]); }
    const float sc = rsqrtf(ss * (1.f / 128.f) + RMS_EPS) * 0.8f;
    bf16_t* yrow = (bf16_t*)(p.ws + WS_Y) + (yrow0 + 32 * w + r32) * D + 512 + hd * 128;
#pragma unroll
    for (int dt = 0; dt < 4; ++dt)
#pragma unroll
        for (int g = 0; g < 4; ++g) {
            const int d0 = 32 * dt + 8 * g + 4 * hi;
            const float4 sw = *(const float4*)(p.subln + d0);
            uint2 wv; wv.x = attd::cvtpk(o[dt][4 * g] * sc * sw.x, o[dt][4 * g + 1] * sc * sw.y); wv.y = attd::cvtpk(o[dt][4 * g + 2] * sc * sw.z, o[dt][4 * g + 3] * sc * sw.w);
            *(uint2*)(yrow + d0) = wv;
        }
}
__device__ __forceinline__ void phase_attn0(const Params& p, int bid, int nb, unsigned char* smem) {
    LAS unsigned char* lds = (LAS unsigned char*)smem;
    const bf16_t* Q = (const bf16_t*)(p.ws + WS_Q); const bf16_t* Kb = (const bf16_t*)(p.ws + WS_K); const bf16_t* VT = (const bf16_t*)(p.ws + WS_VT);
    bf16_t* Y = (bf16_t*)(p.ws + WS_Y);
    constexpr int U_B = 256, U_A = 256, U_C = 16, U_D = 8;
    BgConv bg; bg.s = 0; bg.end = bid < BG_VB ? BG_SLOTS : 0; bg.fly = false; bg_seek(p, bg, bid);
    for (int u = bid; u < U_B; u += nb) {
        const int qb = u >> 3, hd = u & 3, b = (u >> 2) & 1;
        diff_unit(p, lds, b, hd, 256 + 256 * qb, SP / 64, (size_t)b * S + 256 * qb, u, bg, bid, nb);
    }
    for (int u2 = bid; u2 < U_A; u2 += nb) {
        int tid = threadIdx.x; asm volatile("" : "+v"(tid));
        const int lane = tid & 63, r32 = lane & 31, hi = lane >> 5; const int w = __builtin_amdgcn_readfirstlane(tid >> 6);
        const int qb = u2 & 15, h = (u2 >> 4) & 7, b = u2 >> 7;
        LAS float* biasL = (LAS float*)(lds + att::L_BIAS);
        for (int i = tid; i < 15 * 31; i += blockDim.x) biasL[i] = p.na_rpb[h * 465 + i] * att::LOG2E;
        const int r0 = 8 * qb;
        const int tb0 = 4 + min(max(r0 - 4, 0), 120), tb1 = 4 + min(max(r0 + 3, 0), 120) + 8;
        att::f32x16 o[2][2]; float m[2], l[2];
        att::attn_pass<64, 2>(lds, Q + (size_t)(b * NQH + h) * SP * 64, Kb + (size_t)(b * 16 + h) * SP * 64, VT + ((size_t)b * 1024 + h * 64) * SP, 256 + 512 * qb + 64 * w, 0, true, 0, 4, tb0, tb1 - tb0, o, m, l, r0 + w, biasL);
#pragma unroll
        for (int j = 0; j < 2; ++j) att::store_out(Y + ((size_t)b * S + 512 * qb + 64 * w + 32 * j + r32) * D + h * 64, o[j], 1.f / att::xhalf_sum(l[j]), hi);
    }
    for (int u2 = bid; u2 < U_C; u2 += nb) {
        int tid = threadIdx.x; asm volatile("" : "+v"(tid));
        const int lane = tid & 63, r32 = lane & 31, hi = lane >> 5; const int w = __builtin_amdgcn_readfirstlane(tid >> 6);
        const int h = u2 & 7, b = u2 >> 3;
        att::f32x16 o[2][2]; float m[2], l[2];
        att::attn_pass<64, 0>(lds, Q + (size_t)(b * NQH + h) * SP * 64, Kb + (size_t)(b * 16 + h) * SP * 64, VT + ((size_t)b * 1024 + h * 64) * SP, 64 * (w & 3), 0, w < 4, 0, 4, 0, 0, o, m, l, 0, nullptr);
        if (w < 4) {
#pragma unroll
            for (int j = 0; j < 2; ++j) att::store_out(Y + ((size_t)NLAT + b * CTX + 64 * w + 32 * j + r32) * D + h * 64, o[j], 1.f / att::xhalf_sum(l[j]), hi);
        }
    }
    for (int u2 = bid; u2 < U_D; u2 += nb) {
        const int hd = u2 & 3, b = u2 >> 2;
        diff_unit(p, lds, b, hd, 0, 4, (size_t)NLAT + b * CTX, U_B + u2, bg, bid, nb);
    }
    while (bg.s < bg.end) { bg_start(lds, bg); bg_finish(p, lds, bg, bid); }
    for (int vb = bid + nb; vb < BG_VB; vb += nb) { bg.s = 0; bg.end = BG_SLOTS; bg_seek(p, bg, vb); while (bg.s < bg.end) { bg_start(lds, bg); bg_finish(p, lds, bg, vb); } }
}
__device__ __forceinline__ void phase_attn1(const Params& p, int bid, int nb, unsigned char* smem) {
    LAS unsigned char* lds = (LAS unsigned char*)smem;
    const bf16_t* Q = (const bf16_t*)(p.ws + WS_Q); const bf16_t* Kb = (const bf16_t*)(p.ws + WS_K); const bf16_t* VT = (const bf16_t*)(p.ws + WS_VT);
    bf16_t* Y = (bf16_t*)(p.ws + WS_Y);
    for (int u = bid; u < 256; u += nb) {
        int tid = threadIdx.x; asm volatile("" : "+v"(tid));
        const int lane = tid & 63, r32 = lane & 31, hi = lane >> 5; const int w = __builtin_amdgcn_readfirstlane(tid >> 6);
        att::f32x16 o[2][2]; float m[2], l[2];
        const int xc = (u & 7) >> 1, idx = (u & 1) * 32 + (u >> 3);
        const int b = xc >> 1, qh = (xc & 1) * 4 + (idx >> 4), qb = idx & 15;
        att::attn_pass<64, 0, true>(lds, Q + (size_t)(b * NQH + qh) * SP * 64, Kb + (size_t)(b * 4 + (qh >> 2)) * SP * 64, VT + ((size_t)b * 256 + (qh >> 2) * 64) * SP, 256 + 512 * qb + 64 * w, 0, true, 0, SP / 64, 0, 0, o, m, l, 0, nullptr, p.q_norm, (const float2*)(p.ws + WS_ROPE));
#pragma unroll
        for (int j = 0; j < 2; ++j) att::store_out(Y + ((size_t)b * S + 512 * qb + 64 * w + 32 * j + r32) * D + qh * 64, o[j], 1.f / att::xhalf_sum(l[j]), hi);
    }
    for (int u2 = bid; u2 < 256; u2 += nb) {
        int tid = threadIdx.x; asm volatile("" : "+v"(tid));
        const int lane = tid & 63, r32 = lane & 31, hi = lane >> 5; const int w = __builtin_amdgcn_readfirstlane(tid >> 6);
        att::f32x16 o[2][2]; float m[2], l[2];
        const int qb = u2 & 15, qh = (u2 >> 4) & 7, b = u2 >> 7;
        const int t0 = 512 * qb;
        const int tb0 = 4 + max(t0 - 128, 0) / 64, tb1 = 4 + min(t0 + 511 + 128, S - 1) / 64 + 1;
        att::attn_pass<64, 1>(lds, Q + (size_t)(b * NQH + 8 + qh) * SP * 64, Kb + (size_t)(b * 4 + 2 + (qh >> 2)) * SP * 64, VT + ((size_t)b * 256 + 128 + (qh >> 2) * 64) * SP, 256 + t0 + 64 * w, 0, true, 0, 4, tb0, tb1 - tb0, o, m, l, 0, nullptr);
        const float sk = p.sink[qh] * att::LOG2E;
#pragma unroll
        for (int j = 0; j < 2; ++j) {
            const float lt = att::xhalf_sum(l[j]), ml2 = m[j];
            const float mn = fmaxf(ml2, sk), corr = __builtin_amdgcn_exp2f(ml2 - mn);
            const float den = lt * corr + __builtin_amdgcn_exp2f(sk - mn);
            att::store_out(Y + ((size_t)b * S + t0 + 64 * w + 32 * j + r32) * D + 512 + qh * 64, o[j], corr / den, hi);
        }
    }
}
#define XB_TMO      128
#define XB_XCNT(j)  (256  + 64 * (j))
#define XB_XSUB(j)  (1280 + 64 * (j))
#define XB_XGEN(j)  (2304 + 64 * (j))
#define XB_TOP      3328
#define XB_TOPGEN   3392
#define XCD_BAR_WORDS 3456
#define XB_SPIN_CAP (1u << 18)

__device__ __forceinline__ unsigned xb_ld(unsigned* p)              { return __hip_atomic_load(p, __ATOMIC_RELAXED, __HIP_MEMORY_SCOPE_AGENT); }
__device__ __forceinline__ unsigned xb_add(unsigned* p, unsigned v) { return __hip_atomic_fetch_add(p, v, __ATOMIC_RELAXED, __HIP_MEMORY_SCOPE_AGENT); }
__device__ __forceinline__ unsigned xb_xcc_id() { return (unsigned)__builtin_amdgcn_s_getreg((3 << 11) | 20) & 0xFu; }
#define XB_SPIN(cond, bar) do { unsigned _sp = 0; while (cond) { __builtin_amdgcn_s_sleep(1); \
    if ((++_sp & 255u) == 0u) { if (xb_ld(&(bar)[XB_TMO])) break; if (_sp > XB_SPIN_CAP) { atomicAdd(&(bar)[XB_TMO], 1u); break; } } } } while (0)

struct XcdBarrier {
    unsigned* bar; unsigned x;
    volatile LAS unsigned* st;
};

__device__ __forceinline__ XcdBarrier xcd_barrier_post(unsigned* bar, volatile LAS unsigned* st) {
    XcdBarrier b; b.bar = bar; b.x = xb_xcc_id(); b.st = st;
    if (threadIdx.x == 0) (void)xb_add(&bar[XB_XCNT(b.x)], 1u);
    return b;
}
__device__ __forceinline__ void xcd_barrier_complete(unsigned* bar, unsigned x, unsigned& nloc, unsigned& nx) {
    const unsigned G = gridDim.x * gridDim.y * gridDim.z;
    unsigned sum, cnt, mine, sp = 0u;
    for (;;) {
        sum = 0u; cnt = 0u; mine = 0u;
#pragma unroll
        for (unsigned j = 0; j < 16; ++j) { const unsigned c = xb_ld(&bar[XB_XCNT(j)]); sum += c; cnt += (c > 0u) ? 1u : 0u; mine = (j == x) ? c : mine; }
        if (sum == G) break;
        __builtin_amdgcn_s_sleep(1);
        if ((++sp & 255u) == 0u) { if (xb_ld(&bar[XB_TMO])) break; if (sp > XB_SPIN_CAP) { atomicAdd(&bar[XB_TMO], 1u); break; } }
    }
    nloc = mine > 0u ? mine : 1u; nx = cnt > 0u ? cnt : 1u;
}

__device__ __forceinline__ void xcd_barrier(const XcdBarrier& b) {
    asm volatile("s_waitcnt vmcnt(0)" ::: "memory");
    __syncthreads();
    if (threadIdx.x == 0) {
        unsigned* bar = b.bar;
        __builtin_amdgcn_s_waitcnt(0);
        unsigned nloc = b.st[0], nx = b.st[1];
        if (nloc == 0u) { xcd_barrier_complete(bar, b.x, nloc, nx); b.st[0] = nloc; b.st[1] = nx; }
        const unsigned old = xb_add(&bar[XB_XSUB(b.x)], 1u);
        const unsigned gen = old / nloc;
        if (old + 1u == (gen + 1u) * nloc) {
            __builtin_amdgcn_fence(__ATOMIC_RELEASE, "agent");
            asm volatile("s_waitcnt vmcnt(0)" ::: "memory");
            const unsigned og = xb_add(&bar[XB_TOP], 1u);
            const unsigned tg = og / nx;
            if (og + 1u == (tg + 1u) * nx) xb_add(&bar[XB_TOPGEN], 1u);
            else XB_SPIN(xb_ld(&bar[XB_TOPGEN]) == tg, bar);
            __builtin_amdgcn_fence(__ATOMIC_ACQUIRE, "agent");
            xb_add(&bar[XB_XGEN(b.x)], 1u);
            asm volatile("s_waitcnt vmcnt(0)" ::: "memory");
        } else {
            XB_SPIN(xb_ld(&bar[XB_XGEN(b.x)]) == gen, bar);
            __builtin_amdgcn_fence(__ATOMIC_ACQUIRE, "agent");
            asm volatile("s_waitcnt vmcnt(0)" ::: "memory");
        }
    }
    __syncthreads();
}

constexpr int NPHASE = 2 + 9 * 2;
constexpr int NTH = 512;
constexpr int PROBE_DUP = -1;
constexpr int CTL_BAR_WORD = 4096;
constexpr int CTL_BYTES = 65536;
template <bool COOP>
__global__ void __launch_bounds__(NTH, 2) fwd_kernel(Params p, int lo, int hi) {
    extern __shared__ __attribute__((aligned(16))) unsigned char smem[];
    const int bid = blockIdx.x, nb = gridDim.x;
    XcdBarrier bar; bar.bar = nullptr; bar.x = 0; bar.st = nullptr;
    if (COOP) {
        volatile LAS unsigned* st = (volatile LAS unsigned*)((LAS unsigned char*)smem + LDS_MISC + 2048);
        if (threadIdx.x < 2) st[threadIdx.x] = 0u;
        __syncthreads();
        if (bid == 0) { uint4* z = (uint4*)(p.ws + WS_CTL); for (int i = threadIdx.x; i < CTL_BYTES / 16; i += NTH) z[i] = make_uint4(0u, 0u, 0u, 0u); }
    }
#define SEAM(k) do { if (COOP) { if ((k) == 0) { cg::this_grid().sync(); bar = xcd_barrier_post((unsigned*)(p.ws + WS_CTL) + CTL_BAR_WORD, (volatile LAS unsigned*)((LAS unsigned char*)smem + LDS_MISC + 2048)); } else xcd_barrier(bar); } } while (0)
#define RUN(k, stmt) if (lo <= (k) && (k) < hi) { stmt; if (PROBE_DUP == (k)) { SEAM(1); stmt; } if ((k) + 1 < hi) SEAM(k); }
    RUN(0, phase_pre(p, bid, nb, smem))
    RUN(1, phase_h0(p, bid, nb))
    RUN(2, phase_qkv(p, 0, bid, nb, smem))
    RUN(4, phase_attn0(p, bid, nb, smem))
    RUN(5, phase_oproj(p, 0, bid, nb, smem))
    RUN(6, phase_ln1(p, 0, bid, nb, smem))
    RUN(8, phase_moe1(p, 0, bid, nb, smem))
    RUN(9, phase_moe2(p, 0, bid, nb, smem))
    RUN(10, phase_ln2(p, 0, bid, nb))
    RUN(11, phase_qkv(p, 1, bid, nb, smem))
    RUN(12, phase_knorm(p, bid, nb))
    RUN(13, phase_attn1(p, bid, nb, smem))
    RUN(14, phase_oproj(p, 1, bid, nb, smem))
    RUN(15, phase_ln1(p, 1, bid, nb, smem))
    RUN(17, phase_moe1(p, 1, bid, nb, smem))
    RUN(18, phase_moe2(p, 1, bid, nb, smem))
    RUN(19, phase_ln2(p, 1, bid, nb))
#undef RUN
#undef SEAM
}

extern "C" void kernel_launch(void* const* d_in, const int* in_sizes, int n_in, void* d_out, int out_size, void* d_ws, size_t ws_size, hipStream_t stream) {
    static int grid = 0;
    if (grid == 0) {
        if (n_in != 29 || ws_size < WS_END) { fprintf(stderr, "kernel_launch: unexpected n_in %d / ws %zu (need %zu)\n", n_in, ws_size, (size_t)WS_END); grid = -1; return; }
        int dev = 0, cus = 0, per_cu = 0;
        (void)hipGetDevice(&dev); (void)hipDeviceGetAttribute(&cus, hipDeviceAttributeMultiprocessorCount, dev);
        if (hipFuncSetAttribute((const void*)fwd_kernel<true>, hipFuncAttributeMaxDynamicSharedMemorySize, LDS_TOTAL) != hipSuccess) { fprintf(stderr, "kernel_launch: hipFuncSetAttribute failed\n"); grid = -1; return; }
        if (hipOccupancyMaxActiveBlocksPerMultiprocessor(&per_cu, (const void*)fwd_kernel<true>, NTH, LDS_TOTAL) != hipSuccess || per_cu < 1) { fprintf(stderr, "kernel_launch: occupancy query says %d\n", per_cu); per_cu = 1; }
        grid = cus;
        (void)hipGetLastError();
    }
    if (grid < 0) return;
    Params p{};
    const float* const* in = (const float* const*)d_in;
    p.x = in[0]; p.c = in[1]; p.ctx = in[2]; p.c_ctx = in[3]; p.mod_w = in[4]; p.mod_b = in[5]; p.ln1_g = in[6]; p.ln1_b = in[7]; p.ln2_g = in[8]; p.ln2_b = in[9];
    p.router_w = in[10]; p.router_b = in[11]; p.moe_w_in = in[12]; p.moe_b_in = in[13]; p.moe_w_out = in[14]; p.moe_b_out = in[15]; p.ab_w_in = in[16]; p.ab_w_out = in[17];
    p.na_rpb = in[18]; p.lq1 = in[19]; p.lk1 = in[20]; p.lq2 = in[21]; p.lk2 = in[22]; p.subln = in[23]; p.cd_w_in = in[24]; p.cd_w_out = in[25]; p.q_norm = in[26]; p.k_norm = in[27]; p.sink = in[28];
    p.out = (float*)d_out; p.ws = (unsigned char*)d_ws;
    int lo = 0, hi = NPHASE;
    void* args[] = {(void*)&p, (void*)&lo, (void*)&hi};
    hipError_t e = hipLaunchCooperativeKernel((const void*)fwd_kernel<true>, dim3(grid), dim3(NTH), args, LDS_TOTAL, stream);
    if (e != hipSuccess) fprintf(stderr, "kernel_launch: cooperative launch failed: %s (grid %d)\n", hipGetErrorString(e), grid);
}
```

```cpp
#include <hip/hip_runtime.h>
#include <hip/hip_cooperative_groups.h>
#include <cstdio>
#include <cstdint>
namespace cg = cooperative_groups;

typedef unsigned short bf16_t;

constexpr int D = 1024, NB = 2, S = 8192, NLAT = NB * S, CTX = 256, NCTX = NB * CTX, NTOK = NLAT + NCTX;
constexpr int SP = S + CTX;
constexpr int NE = 32, TOPK = 4;
constexpr int CNT_STRIDE = 32;
constexpr int MAXSLOT = (NTOK * TOPK / 256 + NE) * 256;
constexpr int NQH = 16;
constexpr float ALPHA = 1.41421356237309515f;
constexpr float LN_EPS = 1e-5f, RMS_EPS = 1e-6f, SCALE = 0.125f;
constexpr float SW_LIMIT = 7.0f, SW_ALPHA = 1.702f;
constexpr float W8O_SCALE = 128.0f, ACT8_SCALE = 4.0f;
constexpr float WQKV8_SCALE = 64.0f, WO8_SCALE = 128.0f, Y8_SCALE = 64.0f;
constexpr float YP8_SCALE = 16.0f;
constexpr float W8_SCALE = 64.0f;

constexpr size_t MiB = 1ull << 20;
constexpr size_t WS_CTL = 0;
constexpr size_t WS_MOD = 1 * MiB;
constexpr size_t WS_SCAL = 2 * MiB;
constexpr size_t WS_ROPE = 3 * MiB;
constexpr size_t WS_PAIR = 6 * MiB;
constexpr size_t WS_SLOTG = 8 * MiB;
constexpr size_t WS_H = 10 * MiB;
constexpr size_t WS_Q = 150 * MiB;
constexpr size_t WS_K = 186 * MiB;
constexpr size_t WS_VT = 222 * MiB;
constexpr size_t WS_Y = 258 * MiB;
constexpr size_t WS_YO = 294 * MiB;
constexpr size_t WS_X1 = 364 * MiB;
constexpr size_t WS_X2 = 434 * MiB;
constexpr size_t WS_TOK = 504 * MiB;
constexpr size_t WS_XB = 540 * MiB;
constexpr size_t WS_ACT = 696 * MiB;
constexpr size_t WS_YP = 852 * MiB;
constexpr size_t WS_SCR = 1008 * MiB;
constexpr size_t WS_WT_ABIN = WS_H + 66 * 262144;
constexpr size_t WS_WT_ABOUT = 1054 * MiB;
constexpr size_t WS_WT_CDIN = WS_H + 78 * 262144;
constexpr size_t WS_WT_CDOUT = 1059 * MiB;
constexpr size_t WS_WT_MIN = 1062 * MiB;
constexpr size_t WS_WT_MOUT = 1318 * MiB;
constexpr size_t WS_END = 1446 * MiB;

struct Params {
    const float *x, *c, *ctx, *c_ctx, *mod_w, *mod_b, *ln1_g, *ln1_b, *ln2_g, *ln2_b, *router_w, *router_b;
    const float *moe_w_in, *moe_b_in, *moe_w_out, *moe_b_out, *ab_w_in, *ab_w_out, *na_rpb;
    const float *lq1, *lk1, *lq2, *lk2, *subln, *cd_w_in, *cd_w_out, *q_norm, *k_norm, *sink;
    float* out;
    unsigned char* ws;
};

__device__ __forceinline__ float bf2f(unsigned v) { return __uint_as_float(v << 16); }
__device__ __forceinline__ unsigned f2bf(float f) { unsigned u = __float_as_uint(f); return (u + 0x7fffu + ((u >> 16) & 1u)) >> 16; }
__device__ __forceinline__ unsigned pk2(float lo, float hi) { return f2bf(lo) | (f2bf(hi) << 16); }
template <int CTRL> __device__ __forceinline__ float dpp_xadd(float v) { const int t = __builtin_amdgcn_update_dpp(0, __float_as_int(v), CTRL, 0xf, 0xf, true); return v + __int_as_float(t); }
__device__ __forceinline__ float wave_sum(float v) {
    v = dpp_xadd<0xB1>(v); v = dpp_xadd<0x4E>(v); v = dpp_xadd<0x141>(v); v = dpp_xadd<0x140>(v);
    v += __int_as_float(__builtin_amdgcn_ds_swizzle(__float_as_int(v), 0x401f));
    auto rr = __builtin_amdgcn_permlane32_swap(__float_as_uint(v), __float_as_uint(v), false, false);
    return __uint_as_float(rr[0]) + __uint_as_float(rr[1]);
}
typedef float f2v __attribute__((ext_vector_type(2)));
__device__ __forceinline__ float silu_f(float v) { return v / (1.f + __expf(-v)); }
#define LAS __attribute__((address_space(3)))
typedef float float4v __attribute__((ext_vector_type(4)));

namespace pg8 {
#define PG8_LAS __attribute__((address_space(3)))
typedef unsigned short bf16_t;
typedef short bf16x8 __attribute__((ext_vector_type(8)));
typedef float f32x4 __attribute__((ext_vector_type(4)));
typedef unsigned u32x4 __attribute__((ext_vector_type(4)));
constexpr int BM = 256, BK = 64, HALF = 128, HTB = HALF * BK * 2  , STAGE_BYTES = 8 * HTB, NXCD = 8, WGM = 8;

__host__ __device__ __forceinline__ int lds_byte(int r, int c) { const int st = (r >> 4) * 2 + (c >> 5), rr = r & 15, cc = c & 31, ob = rr * 64 + cc * 2; return st * 1024 + (ob ^ (((ob >> 9) & 1) << 5)); }
__host__ __device__ __forceinline__ void stage_rc(int b, int& R, int& C) { const int st = b / 1024, sb = b % 1024, swz = sb ^ (((sb >> 9) & 1) << 5); R = (st >> 1) * 16 + swz / 64; C = (st & 1) * 32 + (swz % 64) / 2; }
__host__ __device__ __forceinline__ int perm32(int rho) { const int n = rho >> 4, i = rho & 15; return 8 * (i >> 2) + 4 * n + (i & 3); }

struct Unit { int pm, pn; };
struct Gemm { const bf16_t* A; const bf16_t* Bt; int M, N, K; const int* arow; };

struct StaticOrder {
    int nM, nN, nwg, G, c;
    __host__ __device__ void init(int M, int N, int G_, int c_) { nM = M / BM; nN = N / BM; nwg = nM * nN; G = G_; c = c_; }
    __host__ __device__ bool next(int i, Unit& u) const {
        const long L = (long)i * G + c; if (L >= nwg) return false;
        int wgid = (int)L; { const int q = nwg / NXCD, r = nwg % NXCD, xcd = wgid % NXCD, off = wgid / NXCD; wgid = (xcd < r ? xcd * (q + 1) : r * (q + 1) + (xcd - r) * q) + off; }
        const int nig = WGM * nN, gid = wgid / nig, fm = gid * WGM, gsz = (nM - fm) < WGM ? (nM - fm) : WGM;
        u.pm = fm + ((wgid % nig) % gsz); u.pn = (wgid % nig) / gsz; return true;
    }
    __device__ __forceinline__ void a_ready(const Unit&) const {}
    __device__ __forceinline__ void done(const Unit&) const {}
};

typedef int v8i_t __attribute__((ext_vector_type(8)));
typedef int v4i_t __attribute__((ext_vector_type(4)));
__device__ __forceinline__ v8i_t cat8(bf16x8 a, bf16x8 b) { const v4i_t x = __builtin_bit_cast(v4i_t, a), y = __builtin_bit_cast(v4i_t, b); return __builtin_shufflevector(x, y, 0, 1, 2, 3, 4, 5, 6, 7); }
template <bool FP8>
__device__ __forceinline__ void mma_block(f32x4 (&c)[4][2], const bf16x8 (&At)[4][2], const bf16x8 (&Bt)[2][2], const v8i_t (&a8)[4], const v8i_t (&b8)[2]) {
    if constexpr (FP8) {
#pragma unroll
        for (int m = 0; m < 4; ++m)
#pragma unroll
            for (int n = 0; n < 2; ++n)
                asm volatile("s_nop 1\n\tv_mfma_f32_16x16x128_f8f6f4 %0, %1, %2, %0" : "+v"(c[m][n]) : "v"(b8[n]), "v"(a8[m]));
    } else {
#pragma unroll
        for (int m = 0; m < 4; ++m)
#pragma unroll
            for (int n = 0; n < 2; ++n)
#pragma unroll
                for (int k = 0; k < 2; ++k) c[m][n] = __builtin_amdgcn_mfma_f32_16x16x32_bf16(Bt[n][k], At[m][k], c[m][n], 0, 0, 0);
    }
}
template <class Epi, class Sched, bool ALIGN_EPI = false, bool SP2 = false, bool FP8 = false, bool GATHER = false>
__device__ __forceinline__ void gemm_phase(PG8_LAS unsigned char* lds, const Gemm g, const Sched& S, const Epi& E) {
    int tid_ = threadIdx.x; asm volatile("" : "+v"(tid_));
    const int tid = tid_, wid = __builtin_amdgcn_readfirstlane(tid >> 6), lane = tid & 63, wr = wid >> 2, wc = wid & 3, fr = lane & 15, fq = lane >> 4;
    const int K = g.K, nt = K / BK;
    unsigned voffA[2], voffB[2];
#pragma unroll
    for (int i = 0; i < 2; ++i) { int R, C; stage_rc(tid * 16 + i * 8192, R, C); const int Rb = Epi::PERM ? ((R & ~31) + perm32(R & 31)) : R;
        voffA[i] = (unsigned)(R * K + C) * 2u; voffB[i] = (unsigned)(Rb * K + C) * 2u; }
    const size_t kstep = (size_t)(BK * 2);
    const size_t hstep = (size_t)HALF * K * 2;
    const size_t tstep = 2 * hstep;
    const unsigned ldsw = (unsigned)wid * 1024u;
    const int aoff = lds_byte(wr * 64 + fr, fq * 8), boff = lds_byte(wc * 32 + fr, fq * 8);
#define PG8_SA(b, h) (((b) * 2 + (h)) * HTB)
#define PG8_SB(b, h) ((4 + (b) * 2 + (h)) * HTB)
#define PG8_STAGE(bufoff, gbase, voff) do { _Pragma("unroll") for (int _i = 0; _i < 2; ++_i) \
        __builtin_amdgcn_global_load_lds((const unsigned*)((const char*)(gbase) + (voff)[_i]), (PG8_LAS unsigned*)(lds + (bufoff) + ldsw + _i * 8192), 16, 0, 0); } while (0)
#define PG8_STAGE_A(bufoff, gbase, HALF_, NEXT_) do { if constexpr (GATHER) { _Pragma("unroll") for (int _i = 0; _i < 2; ++_i) \
        __builtin_amdgcn_global_load_lds((const unsigned*)((const char*)(gbase) + ((NEXT_) ? gN[HALF_][_i] : gC[HALF_][_i])), (PG8_LAS unsigned*)(lds + (bufoff) + ldsw + _i * 8192), 16, 0, 0); } \
    else { PG8_STAGE(bufoff, (gbase) + ((HALF_) ? hstep : 0), voffA); } } while (0)
#define PG8_LDA(dst, b, h) do { if constexpr (FP8) { _Pragma("unroll") for (int m = 0; m < 4; ++m) dst##8[m] = cat8(*(const PG8_LAS bf16x8*)(lds + PG8_SA(b, h) + aoff + m * 2048), *(const PG8_LAS bf16x8*)(lds + PG8_SA(b, h) + aoff + m * 2048 + 1024)); } \
        else { _Pragma("unroll") for (int m = 0; m < 4; ++m) _Pragma("unroll") for (int k = 0; k < 2; ++k) dst[m][k] = *(const PG8_LAS bf16x8*)(lds + PG8_SA(b, h) + aoff + m * 2048 + k * 1024); } } while (0)
#define PG8_LDB(dst, b, h) do { if constexpr (FP8) { _Pragma("unroll") for (int n = 0; n < 2; ++n) dst##8[n] = cat8(*(const PG8_LAS bf16x8*)(lds + PG8_SB(b, h) + boff + n * 2048), *(const PG8_LAS bf16x8*)(lds + PG8_SB(b, h) + boff + n * 2048 + 1024)); } \
        else { _Pragma("unroll") for (int n = 0; n < 2; ++n) _Pragma("unroll") for (int k = 0; k < 2; ++k) dst[n][k] = *(const PG8_LAS bf16x8*)(lds + PG8_SB(b, h) + boff + n * 2048 + k * 1024); } } while (0)
#define PG8_MMA(ai, bj, At, Bt) do { __builtin_amdgcn_s_setprio(1); mma_block<FP8>(acc[ai][bj], At, Bt, At##8, Bt##8); __builtin_amdgcn_s_setprio(0); } while (0)
#define PG8_WAIT_V(n) asm volatile("s_waitcnt vmcnt(" #n ")" ::: "memory")
#define PG8_WAIT_L(n) asm volatile("s_waitcnt lgkmcnt(" #n ")" ::: "memory")
#define PG8_BAR __builtin_amdgcn_s_barrier()
#define PG8_SCHED __builtin_amdgcn_sched_barrier(0)
    Unit cur, nxt; int ui = 0;
    if (!S.next(0, cur)) return;
    static_assert(!GATHER || SP2, "GATHER is wired into the SP2 loop only");
    unsigned gC[2][2] = {{0u, 0u}, {0u, 0u}}, gN[2][2] = {{0u, 0u}, {0u, 0u}}; int gR[2] = {0, 0}; unsigned gCc[2] = {0u, 0u};
    if constexpr (GATHER) {
#pragma unroll
        for (int i = 0; i < 2; ++i) { int R, C; stage_rc(tid * 16 + i * 8192, R, C); gR[i] = R; gCc[i] = (unsigned)C * 2u; }
#pragma unroll
        for (int h = 0; h < 2; ++h)
#pragma unroll
            for (int i = 0; i < 2; ++i) gC[h][i] = (unsigned)g.arow[S.aoff(cur.pm) + cur.pm * BM + h * HALF + gR[i]] * (unsigned)(K * 2) + gCc[i];
        asm volatile("s_waitcnt vmcnt(0)" ::: "memory"); asm volatile("" : "+v"(gC[0][0]), "+v"(gC[0][1]), "+v"(gC[1][0]), "+v"(gC[1][1]));
    }
    f32x4 acc[2][2][4][2];
#pragma unroll
    for (int a = 0; a < 2; ++a)
#pragma unroll
        for (int b = 0; b < 2; ++b)
#pragma unroll
            for (int m = 0; m < 4; ++m)
#pragma unroll
                for (int n = 0; n < 2; ++n) acc[a][b][m][n] = (f32x4){0.f, 0.f, 0.f, 0.f};
    bf16x8 At[4][2], B0[2][2], B1[2][2]; v8i_t At8[4], B08[2], B18[2];
    const char* cA = (const char*)g.A + (GATHER ? (size_t)0 : (size_t)cur.pm * tstep); const char* cB = (const char*)g.Bt + (size_t)cur.pn * tstep;
    S.a_ready(cur);
    if constexpr (SP2) {
        PG8_STAGE(PG8_SB(0, 0), cB, voffB); PG8_STAGE(PG8_SB(0, 1), cB + hstep, voffB); PG8_STAGE_A(PG8_SA(0, 0), cA, 0, false); PG8_STAGE_A(PG8_SA(0, 1), cA, 1, false);
        if (wr == 1) PG8_BAR;
        PG8_WAIT_V(2); PG8_BAR;
        PG8_STAGE(PG8_SB(1, 0), cB + kstep, voffB); PG8_STAGE_A(PG8_SA(1, 0), cA + kstep, 0, false); PG8_STAGE(PG8_SB(1, 1), cB + hstep + kstep, voffB);
        PG8_WAIT_V(6); PG8_BAR;
    } else {
        PG8_STAGE(PG8_SB(0, 0), cB, voffB); PG8_STAGE(PG8_SA(0, 0), cA, voffA); PG8_STAGE(PG8_SB(0, 1), cB + hstep, voffB); PG8_STAGE(PG8_SA(0, 1), cA + hstep, voffA);
        if (wr == 1) PG8_BAR;
        PG8_WAIT_V(4); PG8_BAR;
        PG8_STAGE(PG8_SB(1, 0), cB + kstep, voffB); PG8_STAGE(PG8_SA(1, 0), cA + kstep, voffA); PG8_STAGE(PG8_SB(1, 1), cB + hstep + kstep, voffB);
        PG8_WAIT_V(6); PG8_BAR;
    }
    for (;;) {
        const bool has_next = S.next(ui + 1, nxt);
        const char* nA = (has_next && !GATHER) ? (const char*)g.A + (size_t)nxt.pm * tstep : cA; const char* nB = has_next ? (const char*)g.Bt + (size_t)nxt.pn * tstep : cB;
        if constexpr (GATHER) {
            const int npm = has_next ? nxt.pm : cur.pm;
#pragma unroll
            for (int h = 0; h < 2; ++h)
#pragma unroll
                for (int i = 0; i < 2; ++i) gN[h][i] = (unsigned)g.arow[S.aoff(npm) + npm * BM + h * HALF + gR[i]] * (unsigned)(K * 2) + gCc[i];
            asm volatile("s_waitcnt vmcnt(0)" ::: "memory"); asm volatile("" : "+v"(gN[0][0]), "+v"(gN[0][1]), "+v"(gN[1][0]), "+v"(gN[1][1]));
        }
        for (int t = 0; t < nt; t += 2) {
            const bool last = (t == nt - 2);
            const char* a1 = cA + (size_t)(t + 1) * kstep;
            const char* a2 = last ? nA : cA + (size_t)(t + 2) * kstep; const char* b2 = last ? nB : cB + (size_t)(t + 2) * kstep;
            const char* a3 = a2 + kstep; const char* b3 = b2 + kstep;
            if (last && has_next) S.a_ready(nxt);
            if constexpr (SP2) {
            PG8_LDB(B0, 0, 0); PG8_LDB(B1, 0, 1); PG8_SCHED; PG8_LDA(At, 0, 0); PG8_STAGE_A(PG8_SA(1, 1), a1, 1, false);
            PG8_WAIT_V(8); PG8_WAIT_L(0); PG8_BAR; PG8_MMA(0, 0, At, B0); PG8_MMA(0, 1, At, B1); PG8_BAR; PG8_SCHED;
            PG8_LDA(At, 0, 1); PG8_STAGE(PG8_SB(0, 0), b2, voffB); PG8_STAGE(PG8_SB(0, 1), b2 + hstep, voffB); PG8_STAGE_A(PG8_SA(0, 0), a2, 0, last);
            PG8_WAIT_V(8); PG8_WAIT_L(0); PG8_BAR; PG8_MMA(1, 0, At, B0); PG8_MMA(1, 1, At, B1); PG8_BAR; PG8_SCHED;
            PG8_LDB(B0, 1, 0); PG8_LDB(B1, 1, 1); PG8_SCHED; PG8_LDA(At, 1, 0); PG8_STAGE_A(PG8_SA(0, 1), a2, 1, last);
            PG8_WAIT_V(8); PG8_WAIT_L(0); PG8_BAR; PG8_MMA(0, 0, At, B0); PG8_MMA(0, 1, At, B1); PG8_BAR; PG8_SCHED;
            PG8_LDA(At, 1, 1); PG8_STAGE(PG8_SB(1, 0), b3, voffB); PG8_STAGE(PG8_SB(1, 1), b3 + hstep, voffB); PG8_STAGE_A(PG8_SA(1, 0), a3, 0, last);
            PG8_WAIT_V(8); PG8_WAIT_L(0); PG8_BAR; PG8_MMA(1, 0, At, B0); PG8_MMA(1, 1, At, B1); PG8_BAR; PG8_SCHED;
            } else {
            PG8_LDB(B0, 0, 0); PG8_SCHED; PG8_LDA(At, 0, 0); PG8_STAGE(PG8_SA(1, 1), a1 + hstep, voffA);
            PG8_WAIT_L(8); PG8_BAR; PG8_WAIT_L(0); PG8_MMA(0, 0, At, B0); PG8_BAR; PG8_SCHED;
            PG8_LDB(B1, 0, 1); PG8_STAGE(PG8_SB(0, 0), b2, voffB);
            PG8_BAR; PG8_WAIT_L(0); PG8_MMA(0, 1, At, B1); PG8_BAR;
            PG8_LDA(At, 0, 1); PG8_STAGE(PG8_SA(0, 0), a2, voffA);
            PG8_BAR; PG8_WAIT_L(0); PG8_MMA(1, 0, At, B0); PG8_BAR; PG8_SCHED;
            PG8_STAGE(PG8_SB(0, 1), b2 + hstep, voffB);
            PG8_WAIT_V(6); PG8_BAR; PG8_MMA(1, 1, At, B1); PG8_BAR;
            PG8_LDB(B0, 1, 0); PG8_SCHED; PG8_LDA(At, 1, 0); PG8_STAGE(PG8_SA(0, 1), a2 + hstep, voffA);
            PG8_WAIT_L(8); PG8_BAR; PG8_WAIT_L(0); PG8_MMA(0, 0, At, B0); PG8_BAR; PG8_SCHED;
            PG8_LDB(B1, 1, 1); PG8_STAGE(PG8_SB(1, 0), b3, voffB);
            PG8_BAR; PG8_WAIT_L(0); PG8_MMA(0, 1, At, B1); PG8_BAR;
            PG8_LDA(At, 1, 1); PG8_STAGE(PG8_SA(1, 0), a3, voffA);
            PG8_BAR; PG8_WAIT_L(0); PG8_MMA(1, 0, At, B0); PG8_BAR; PG8_SCHED;
            PG8_STAGE(PG8_SB(1, 1), b3 + hstep, voffB);
            PG8_WAIT_V(6); PG8_BAR; PG8_MMA(1, 1, At, B1); PG8_BAR;
            }
        }
        if constexpr (ALIGN_EPI) { if (wr == 0) PG8_BAR; }
        if constexpr (!Epi::AFTER_DRAIN) { E(acc, cur, wr, wc, fr, fq); S.done(cur); }
        if (!has_next) break;
#pragma unroll
        for (int a = 0; a < 2; ++a)
#pragma unroll
            for (int b = 0; b < 2; ++b)
#pragma unroll
                for (int m = 0; m < 4; ++m)
#pragma unroll
                    for (int n = 0; n < 2; ++n) acc[a][b][m][n] = (f32x4){0.f, 0.f, 0.f, 0.f};
        cur = nxt; cA = nA; cB = nB; ++ui;
        if constexpr (GATHER) { gC[0][0] = gN[0][0]; gC[0][1] = gN[0][1]; gC[1][0] = gN[1][0]; gC[1][1] = gN[1][1]; }
        if constexpr (ALIGN_EPI) { if (wr == 1) PG8_BAR; }
    }
    PG8_WAIT_V(0);
    if constexpr (!ALIGN_EPI) { if (wr == 0) PG8_BAR; }
    PG8_BAR;
    if constexpr (Epi::AFTER_DRAIN) { E.fused(acc, cur, wr, wc, fr, fq, lds, wid, lane); S.done(cur); }
#undef PG8_SA
#undef PG8_SB
#undef PG8_STAGE
#undef PG8_STAGE_A
#undef PG8_LDA
#undef PG8_LDB
#undef PG8_MMA
#undef PG8_WAIT_V
#undef PG8_WAIT_L
#undef PG8_BAR
#undef PG8_SCHED
}
}
__device__ __forceinline__ unsigned pk4_fp8(float a, float b, float c, float d) { int r = __builtin_amdgcn_cvt_pk_fp8_f32(a, b, 0, false); r = __builtin_amdgcn_cvt_pk_fp8_f32(c, d, r, true); return (unsigned)r; }

constexpr int FLAG_WORD = 8192;
constexpr int ECAP = NTOK;
constexpr int TOFF_AT = 700, PSTART_AT = 330;
namespace pg8 {
__device__ __forceinline__ unsigned cvt_pk_bf16(float lo, float hi) { unsigned r; asm volatile("v_cvt_pk_bf16_f32 %0, %1, %2" : "=v"(r) : "v"(lo), "v"(hi)); return r; }

struct EpiStoreBf16 {
    static constexpr bool PERM = true, AFTER_DRAIN = false;
    bf16_t* O; int ldc;
    __device__ __forceinline__ void operator()(const f32x4 (&acc)[2][2][4][2], const Unit& u, int wr, int wc, int fr, int fq) const {
        const int row0 = u.pm * BM + wr * 64 + fr, col0 = u.pn * BM + wc * 32 + 8 * fq;
#pragma unroll
        for (int ai = 0; ai < 2; ++ai)
#pragma unroll
            for (int m = 0; m < 4; ++m) { bf16_t* rowp = O + (size_t)(row0 + ai * HALF + m * 16) * ldc + col0;
#pragma unroll
                for (int bj = 0; bj < 2; ++bj) { const f32x4 v0 = acc[ai][bj][m][0], v1 = acc[ai][bj][m][1];
                    u32x4 w; w.x = cvt_pk_bf16(v0[0], v0[1]); w.y = cvt_pk_bf16(v0[2], v0[3]); w.z = cvt_pk_bf16(v1[0], v1[1]); w.w = cvt_pk_bf16(v1[2], v1[3]);
                    *(u32x4*)(rowp + bj * HALF) = w; } }
    }
};
struct EpiStoreF32 {
    static constexpr bool PERM = false, AFTER_DRAIN = false;
    float* O; int ldc; float wsc;
    __device__ __forceinline__ void operator()(const f32x4 (&acc)[2][2][4][2], const Unit& u, int wr, int wc, int fr_in, int fq_in) const {
        int fr = fr_in, fq = fq_in; asm volatile("s_nop 15\n\ts_nop 15" : "+v"(fr), "+v"(fq)); __builtin_amdgcn_sched_barrier(0);
        const int row0 = u.pm * BM + wr * 64 + fr, col0 = u.pn * BM + wc * 32 + 4 * fq;
#pragma unroll
        for (int ai = 0; ai < 2; ++ai)
#pragma unroll
            for (int m = 0; m < 4; ++m) { float* rowp = O + (size_t)(row0 + ai * HALF + m * 16) * ldc + col0;
#pragma unroll
                for (int bj = 0; bj < 2; ++bj)
#pragma unroll
                    for (int n = 0; n < 2; ++n) *(f32x4*)(rowp + bj * HALF + n * 16) = acc[ai][bj][m][n] * wsc; }
    }
};
__device__ __forceinline__ float swiglu1(float g, float u) {
    g = fminf(g, SW_LIMIT); u = fminf(fmaxf(u, -SW_LIMIT), SW_LIMIT);
    return g * __builtin_amdgcn_rcpf(1.f + __builtin_amdgcn_exp2f(-SW_ALPHA * 1.4426950408889634f * g)) * (u + 1.f);
}
struct EpiMoe1 {
    static constexpr bool PERM = true, AFTER_DRAIN = false;
    bf16_t* ACT; const float* b_in; float wsc;
    __device__ __forceinline__ void operator()(const f32x4 (&acc)[2][2][4][2], const Unit& u, int wr, int wc, int fr, int fq) const {
        int fr_ = fr, fq_ = fq; asm volatile("s_nop 15\n\ts_nop 15" : "+v"(fr_), "+v"(fq_)); __builtin_amdgcn_sched_barrier(0);
        const int e = u.pn >> 3, pnl = u.pn & 7;
        const int row0 = u.pm * BM + wr * 64 + fr_, c0 = pnl * 128 + wc * 32 + 8 * fq_;
        f32x4 bg[2], bu[2];
#pragma unroll
        for (int n = 0; n < 2; ++n) { bg[n] = *(const f32x4*)(b_in + e * 2048 + c0 + 4 * n); bu[n] = *(const f32x4*)(b_in + e * 2048 + 1024 + c0 + 4 * n); }
#pragma unroll
        for (int ai = 0; ai < 2; ++ai)
#pragma unroll
            for (int m = 0; m < 4; ++m) {
                float a[8];
#pragma unroll
                for (int n = 0; n < 2; ++n) { const f32x4 g = acc[ai][0][m][n] * wsc + bg[n], uu = acc[ai][1][m][n] * wsc + bu[n];
#pragma unroll
                    for (int i = 0; i < 4; ++i) a[4 * n + i] = swiglu1(g[i], uu[i]); }
                uint2 w; w.x = pk4_fp8(a[0] * ACT8_SCALE, a[1] * ACT8_SCALE, a[2] * ACT8_SCALE, a[3] * ACT8_SCALE); w.y = pk4_fp8(a[4] * ACT8_SCALE, a[5] * ACT8_SCALE, a[6] * ACT8_SCALE, a[7] * ACT8_SCALE);
                *(uint2*)((unsigned char*)ACT + (size_t)(row0 + ai * HALF + m * 16) * D + c0) = w;
            }
    }
};
struct EpiMoe2 {
    static constexpr bool PERM = true, AFTER_DRAIN = false;
    bf16_t* YP; const float* b_out; const float* slot_gate; float wsc; const PG8_LAS int* tile_off;
    __device__ __forceinline__ void operator()(const f32x4 (&acc)[2][2][4][2], const Unit& u, int wr, int wc, int fr, int fq) const {
        int fr_ = fr, fq_ = fq; asm volatile("s_nop 15\n\ts_nop 15" : "+v"(fr_), "+v"(fq_)); __builtin_amdgcn_sched_barrier(0);
        const int e = u.pn >> 2, pnl = u.pn & 3;
        const int row0 = u.pm * BM + wr * 64 + fr_, c0 = pnl * 256 + wc * 32 + 8 * fq_;
        f32x4 bv[2][2];
#pragma unroll
        for (int bj = 0; bj < 2; ++bj)
#pragma unroll
            for (int n = 0; n < 2; ++n) bv[bj][n] = *(const f32x4*)(b_out + e * 1024 + c0 + bj * HALF + 4 * n);
#pragma unroll
        for (int ai = 0; ai < 2; ++ai)
#pragma unroll
            for (int m = 0; m < 4; ++m) { const int row = row0 + ai * HALF + m * 16; const float gt = slot_gate[tile_off[u.pm] + row] * YP8_SCALE;
#pragma unroll
                for (int bj = 0; bj < 2; ++bj) { const f32x4 v0 = (acc[ai][bj][m][0] * wsc + bv[bj][0]) * gt, v1 = (acc[ai][bj][m][1] * wsc + bv[bj][1]) * gt;
                    uint2 w; w.x = pk4_fp8(v0[0], v0[1], v0[2], v0[3]); w.y = pk4_fp8(v1[0], v1[1], v1[2], v1[3]);
                    *(uint2*)((unsigned char*)YP + (size_t)row * D + c0 + bj * HALF) = w; } }
    }
};
struct MoeSched {
    int T, NTN, tb, te, j, MR, G, c;
    const PG8_LAS int* tile_e;
    __device__ __forceinline__ int aoff(int pm) const { return tile_e[TOFF_AT + pm]; }
    __device__ void init(int T_, int NTN_, int G_, int bx, const PG8_LAS int* te_) {
        T = T_; NTN = NTN_; G = G_; c = bx; tile_e = te_;
        const int ngrp = (G % 8 == 0) ? 8 : 1, per = G / ngrp;
        const int x = bx % ngrp; j = bx / ngrp;
        tb = (int)((long)x * T / ngrp); te = (int)((long)(x + 1) * T / ngrp); MR = per / NTN;
    }
    __device__ bool next(int i, Unit& u) const {
        if (MR == 0) { const long Lx = (long)i * G + c; if (Lx >= (long)T * NTN) return false; u.pm = (int)(Lx / NTN); u.pn = tile_e[u.pm] * NTN + (int)(Lx % NTN); return true; }
        if (j >= MR * NTN) return false;
        const int pm = tb + i * MR + j / NTN; if (pm >= te) return false;
        u.pm = pm; u.pn = tile_e[pm] * NTN + j % NTN; return true;
    }
    __device__ __forceinline__ void a_ready(const Unit&) const {}
    __device__ __forceinline__ void done(const Unit&) const {}
};
struct OprojSched {
    int nM, G, c; unsigned* flag;
    __device__ void init(int M, int G_, int c_, unsigned* flag_) { nM = M / BM; G = G_; c = c_; flag = flag_; }
    __device__ bool next(int i, Unit& u) const {
        const int L = i * G + c;
        if (G == 256) { if (L < 256) { u.pm = (L & 7) * 8 + (L >> 5); u.pn = (L >> 3) & 3; } else { const int j = L - 256; u.pm = 64 + (j >> 2); u.pn = j & 3; } }
        else { u.pm = L >> 2; u.pn = L & 3; }
        return u.pm < nM;
    }
    __device__ __forceinline__ void a_ready(const Unit&) const {}
    __device__ __forceinline__ void done(const Unit& u) const {
        asm volatile("s_waitcnt vmcnt(0)" ::: "memory");
        __syncthreads();
        if (threadIdx.x == 0) {
            __builtin_amdgcn_fence(__ATOMIC_RELEASE, "agent");
            asm volatile("s_waitcnt vmcnt(0)" ::: "memory");
            (void)__hip_atomic_fetch_add(&flag[u.pm], 1u, __ATOMIC_RELAXED, __HIP_MEMORY_SCOPE_AGENT);
        }
    }
};
}

__device__ __forceinline__ int tid_fresh() { int t = threadIdx.x; asm volatile("" : "+v"(t)); return t; }
constexpr int LDS_GEMM = 131072, LDS_MISC = 131072, LDS_PAR = 131072 + 4096, LDS_TOTAL = 131072 + 4096 + 20480;

__device__ __forceinline__ void conv_item(const float* W, int ldw, int k0, int n0, bf16_t* WT, int dst_row, LAS float* scr, int lane) {
    float4 v[16];
    const float* src = W + (size_t)(k0 + (lane >> 4)) * ldw + n0 + 4 * (lane & 15);
#pragma unroll
    for (int j = 0; j < 16; ++j) v[j] = *(const float4*)(src + (size_t)(4 * j) * ldw);
    LAS float* d = scr + (lane >> 4) * 65 + 4 * (lane & 15);
#pragma unroll
    for (int j = 0; j < 16; ++j) { d[(4 * j) * 65 + 0] = v[j].x; d[(4 * j) * 65 + 1] = v[j].y; d[(4 * j) * 65 + 2] = v[j].z; d[(4 * j) * 65 + 3] = v[j].w; }
    asm volatile("s_waitcnt lgkmcnt(0)" ::: "memory");
    const int kc = lane & 7;
#pragma unroll
    for (int j = 0; j < 8; ++j) { const int n = 8 * j + (lane >> 3); const LAS float* sp = scr + (8 * kc) * 65 + n;
        uint4 o; o.x = pk2(sp[0 * 65], sp[1 * 65]); o.y = pk2(sp[2 * 65], sp[3 * 65]); o.z = pk2(sp[4 * 65], sp[5 * 65]); o.w = pk2(sp[6 * 65], sp[7 * 65]);
        *(uint4*)(WT + (size_t)(dst_row + n) * 1024 + k0 + 8 * kc) = o; }
    asm volatile("s_waitcnt lgkmcnt(0)" ::: "memory");
}
__device__ __forceinline__ void conv_item8(const float* W, int ldw, int k0, int n0, unsigned char* WT8, int dst_row, LAS float* scr, int lane, float wscale) {
    float4 v[16];
    const float* src = W + (size_t)(k0 + (lane >> 4)) * ldw + n0 + 4 * (lane & 15);
#pragma unroll
    for (int j = 0; j < 16; ++j) v[j] = *(const float4*)(src + (size_t)(4 * j) * ldw);
    LAS float* d = scr + (lane >> 4) * 65 + 4 * (lane & 15);
#pragma unroll
    for (int j = 0; j < 16; ++j) { d[(4 * j) * 65 + 0] = v[j].x * wscale; d[(4 * j) * 65 + 1] = v[j].y * wscale; d[(4 * j) * 65 + 2] = v[j].z * wscale; d[(4 * j) * 65 + 3] = v[j].w * wscale; }
    asm volatile("s_waitcnt lgkmcnt(0)" ::: "memory");
    const int kc = lane & 3;
#pragma unroll
    for (int j = 0; j < 4; ++j) { const int n = 16 * j + (lane >> 2); const LAS float* sp = scr + (16 * kc) * 65 + n;
        uint4 o; o.x = pk4_fp8(sp[0 * 65], sp[1 * 65], sp[2 * 65], sp[3 * 65]); o.y = pk4_fp8(sp[4 * 65], sp[5 * 65], sp[6 * 65], sp[7 * 65]);
        o.z = pk4_fp8(sp[8 * 65], sp[9 * 65], sp[10 * 65], sp[11 * 65]); o.w = pk4_fp8(sp[12 * 65], sp[13 * 65], sp[14 * 65], sp[15 * 65]);
        *(uint4*)(WT8 + (size_t)(dst_row + n) * 1024 + k0 + 16 * kc) = o; }
    asm volatile("s_waitcnt lgkmcnt(0)" ::: "memory");
}
__device__ __forceinline__ void conv8_load(float4 (&v)[16], const float* W, int ldw, int k0, int n0, int lane) {
    const float* src = W + (size_t)(k0 + (lane >> 4)) * ldw + n0 + 4 * (lane & 15);
#pragma unroll
    for (int j = 0; j < 16; ++j) v[j] = *(const float4*)(src + (size_t)(4 * j) * ldw);
}
__device__ __forceinline__ void conv8_store(const float4 (&v)[16], unsigned char* WT8, int dst_row, int k0, LAS float* scr, int lane, float wscale) {
    LAS float* d = scr + (lane >> 4) * 65 + 4 * (lane & 15);
#pragma unroll
    for (int j = 0; j < 16; ++j) { d[(4 * j) * 65 + 0] = v[j].x * wscale; d[(4 * j) * 65 + 1] = v[j].y * wscale; d[(4 * j) * 65 + 2] = v[j].z * wscale; d[(4 * j) * 65 + 3] = v[j].w * wscale; }
    asm volatile("s_waitcnt lgkmcnt(0)" ::: "memory");
    const int kc = lane & 3;
#pragma unroll
    for (int j = 0; j < 4; ++j) { const int n = 16 * j + (lane >> 2); const LAS float* sp = scr + (16 * kc) * 65 + n;
        uint4 o; o.x = pk4_fp8(sp[0 * 65], sp[1 * 65], sp[2 * 65], sp[3 * 65]); o.y = pk4_fp8(sp[4 * 65], sp[5 * 65], sp[6 * 65], sp[7 * 65]);
        o.z = pk4_fp8(sp[8 * 65], sp[9 * 65], sp[10 * 65], sp[11 * 65]); o.w = pk4_fp8(sp[12 * 65], sp[13 * 65], sp[14 * 65], sp[15 * 65]);
        *(uint4*)(WT8 + (size_t)(dst_row + n) * 1024 + k0 + 16 * kc) = o; }
    asm volatile("s_waitcnt lgkmcnt(0)" ::: "memory");
}
__device__ __forceinline__ void conv8h_load(float4 (&v)[16], const float* W, int ldw, int k0, int n0, int lane) {
    const float* src = W + (size_t)(k0 + 4 * (lane >> 4)) * ldw + n0 + 4 * (lane & 15);
#pragma unroll
    for (int j = 0; j < 4; ++j)
#pragma unroll
        for (int i = 0; i < 4; ++i) v[4 * j + i] = *(const float4*)(src + (size_t)(16 * j + i) * ldw);
}
__device__ __forceinline__ void conv8h_stage(const float4 (&v)[16], LAS unsigned* img, int half, int lane, float s) {
    const int kq = lane >> 4, nq = lane & 15;
#pragma unroll
    for (int j = 0; j < 4; ++j) {
        LAS unsigned* d = img + (4 * nq) * 33 + 16 * half + 4 * j + kq;
        d[0 * 33] = pk4_fp8(v[4 * j].x * s, v[4 * j + 1].x * s, v[4 * j + 2].x * s, v[4 * j + 3].x * s);
        d[1 * 33] = pk4_fp8(v[4 * j].y * s, v[4 * j + 1].y * s, v[4 * j + 2].y * s, v[4 * j + 3].y * s);
        d[2 * 33] = pk4_fp8(v[4 * j].z * s, v[4 * j + 1].z * s, v[4 * j + 2].z * s, v[4 * j + 3].z * s);
        d[3 * 33] = pk4_fp8(v[4 * j].w * s, v[4 * j + 1].w * s, v[4 * j + 2].w * s, v[4 * j + 3].w * s);
    }
}
__device__ __forceinline__ void conv8h_flush(const LAS unsigned* img, unsigned char* WT8, int dst_row, int k0, int lane) {
    asm volatile("s_waitcnt lgkmcnt(0)" ::: "memory");
    const int ch = lane & 7;
#pragma unroll
    for (int j = 0; j < 8; ++j) { const int n = 8 * j + (lane >> 3); const LAS unsigned* sp = img + n * 33 + 4 * ch;
        uint4 o; o.x = sp[0]; o.y = sp[1]; o.z = sp[2]; o.w = sp[3];
        *(uint4*)(WT8 + (size_t)(dst_row + n) * 1024 + k0 + 16 * ch) = o; }
    asm volatile("s_waitcnt lgkmcnt(0)" ::: "memory");
}
struct MoeConvItem { const float* W; unsigned char* WT8; int ldw, k0, n0, drow; float scale; };
__device__ __forceinline__ MoeConvItem moe_conv_item(const Params& p, int r) {
    MoeConvItem it; const int le = r / 384, q = r % 384;
    if (q < 256) { it.n0 = (q % 32) * 64; it.k0 = (q / 32) * 128; it.ldw = 2048; it.W = p.moe_w_in + (size_t)le * 1024 * 2048; it.WT8 = p.ws + WS_WT_MIN + (size_t)le * 2048 * 1024;
        const int nn = it.n0 & 1023; it.drow = 256 * (nn >> 7) + (nn & 127) + (it.n0 >= 1024 ? 128 : 0); it.scale = W8_SCALE; }
    else { const int q2 = q - 256; it.n0 = (q2 % 16) * 64; it.k0 = (q2 / 16) * 128; it.ldw = 1024; it.W = p.moe_w_out + (size_t)le * 1024 * 1024; it.WT8 = p.ws + WS_WT_MOUT + (size_t)le * 1024 * 1024;
        it.drow = it.n0; it.scale = W8O_SCALE; }
    return it;
}
__device__ __forceinline__ void phase_pre(const Params& p, int bid, int nb, unsigned char* smem) {
    const int nth = blockDim.x, tid = threadIdx.x;
    const int lane = tid & 63, wv = tid >> 6, nw = nth / 64;
    float* MOD = (float*)(p.ws + WS_MOD);
    {
        LAS float* sl = (LAS float*)smem;
        LAS float* part = (LAS float*)(smem + 12288);
        for (int it = bid; it < 192; it += nb) {
            for (int i = tid; i < 3072; i += nth) { const float cv = i < 2048 ? p.c[i] : p.c_ctx[i - 2048]; sl[i] = silu_f(cv); }
            __syncthreads();
            const int L = it / 96, n = (it % 96) * 64 + lane;
            const float* W = p.mod_w + (size_t)L * 1024 * 6144 + n;
            float a0 = 0.f, a1 = 0.f, a2 = 0.f;
#pragma unroll 8
            for (int k = 128 * wv; k < 128 * wv + 128; ++k) { const float w = W[(size_t)k * 6144]; a0 += sl[k] * w; a1 += sl[1024 + k] * w; a2 += sl[2048 + k] * w; }
            part[(wv * 3 + 0) * 64 + lane] = a0; part[(wv * 3 + 1) * 64 + lane] = a1; part[(wv * 3 + 2) * 64 + lane] = a2;
            __syncthreads();
            if (tid < 192) { const int r = tid >> 6, nn = (it % 96) * 64 + (tid & 63); float sum = p.mod_b[L * 6144 + nn];
                for (int q = 0; q < nw; ++q) sum += part[(q * 3 + r) * 64 + (tid & 63)];
                MOD[(L * 3 + r) * 6144 + nn] = sum; }
            __syncthreads();
        }
    }
    const int gt = bid * nth + tid, gs = nb * nth;
    float2* ROPE = (float2*)(p.ws + WS_ROPE);
    for (int idx = gt; idx < 8192 * 32; idx += gs) {
        const int t = idx >> 5, i = idx & 31;
        const float pos = (i < 16) ? (float)(t >> 6) : (float)(t & 63);
        const float fr = powf(10000.0f, -(float)(i & 15) / 16.0f);
        const float ang = pos * fr;
        ROPE[idx] = make_float2(cosf(ang), sinf(ang));
    }
    if (gt == 0) {
        float s1 = 0.f, s2 = 0.f;
        for (int k = 0; k < 64; ++k) { s1 += p.lq1[k] * p.lk1[k]; s2 += p.lq2[k] * p.lk2[k]; }
        ((float*)(p.ws + WS_SCAL))[0] = expf(s1) - expf(s2) + 0.2f;
    }
    LAS float* scr = (LAS float*)(smem + wv * 16640);
    constexpr int I_ABIN = 16 * 48, I_ABOUT = 16 * 16, I_CDIN = 16 * 24, I_CDOUT = 16 * 16, I_MIN = 16 * 32, I_MOUT = 16 * 16;
    constexpr int I_SMALL = I_ABIN + I_ABOUT + I_CDIN + I_CDOUT;
    for (int it = bid * nw + wv; it < I_SMALL; it += nb * nw) {
        int r = it;
        if (r < I_ABIN) { conv_item8(p.ab_w_in, 3072, (r / 48) * 64, (r % 48) * 64, p.ws + WS_WT_ABIN, (r % 48) * 64, scr, lane, WQKV8_SCALE); continue; } r -= I_ABIN;
        if (r < I_ABOUT) { conv_item(p.ab_w_out, 1024, (r / 16) * 64, (r % 16) * 64, (bf16_t*)(p.ws + WS_WT_ABOUT), (r % 16) * 64, scr, lane); continue; } r -= I_ABOUT;
        if (r < I_CDIN) { const int n0 = (r % 24) * 64; const int np = n0 < 512 ? n0 : n0 < 640 ? 1024 + (n0 - 512) : n0 < 768 ? 1280 + (n0 - 640) : n0 < 1280 ? 512 + (n0 - 768) : n0 < 1408 ? 1152 + (n0 - 1280) : n0;
            conv_item8(p.cd_w_in, 1536, (r / 24) * 64, n0, p.ws + WS_WT_CDIN, np, scr, lane, WQKV8_SCALE); continue; } r -= I_CDIN;
        conv_item(p.cd_w_out, 1024, (r / 16) * 64, (r % 16) * 64, (bf16_t*)(p.ws + WS_WT_CDOUT), (r % 16) * 64, scr, lane);
    }
    {
        uint4* z0 = (uint4*)(p.ws + WS_XB); uint4* z1 = (uint4*)(p.ws + WS_XB + 4 * MiB);
        for (int i = gt; i < NE * ECAP / 4; i += gs) { z0[i] = make_uint4(0u, 0u, 0u, 0u); z1[i] = make_uint4(0u, 0u, 0u, 0u); }
    }
}

__device__ __forceinline__ void phase_h0(const Params& p, int bid, int nb) {
    const float* MOD = (const float*)(p.ws + WS_MOD);
    unsigned char* H8 = p.ws + WS_H;
    const int lane = threadIdx.x & 63, wv = threadIdx.x >> 6, nw = blockDim.x / 64;
    for (int rq = bid * nw + wv; rq < NTOK / 4; rq += nb * nw) {
        const int row0 = rq * 4;
        const bool lat = row0 < NLAT; const int r = lat ? (row0 >> 13) : 2;
        const float* xin = lat ? p.x + (size_t)row0 * D : p.ctx + (size_t)(row0 - NLAT) * D;
        const float* sh = MOD + (0 * 3 + r) * 6144; const float* sc = sh + 1024;
        float4 v[4][4];
#pragma unroll
        for (int q = 0; q < 4; ++q)
#pragma unroll
            for (int j = 0; j < 4; ++j) v[q][j] = *(const float4*)(xin + (size_t)q * D + 4 * lane + 256 * j);
#pragma unroll
        for (int j = 0; j < 4; ++j) {
            const int k = 4 * lane + 256 * j;
            const float4 a = *(const float4*)(sc + k), b = *(const float4*)(sh + k);
#pragma unroll
            for (int q = 0; q < 4; ++q)
                *(unsigned*)(H8 + (size_t)(row0 + q) * D + k) = pk4_fp8(v[q][j].x * (1.f + a.x) + b.x, v[q][j].y * (1.f + a.y) + b.y, v[q][j].z * (1.f + a.z) + b.z, v[q][j].w * (1.f + a.w) + b.w);
        }
    }
}

__device__ __forceinline__ void chunk_desc(int L, int ch, int& kind, int& idx, int& flags) {
    if (L == 0) {
        const int g = ch >> 3, u = ch & 7;
        kind = g % 3; idx = (g >= 3 ? 8 : 0) + u; flags = (g == 3 || g == 4) ? 1 : 0;
    } else {
        if (ch < 8) { kind = 0; idx = ch; flags = 0; }
        else if (ch < 16) { kind = 0; idx = ch; flags = 1; }
        else if (ch < 18) { kind = 1; idx = ch - 16; flags = 0; }
        else if (ch < 20) { kind = 1; idx = ch - 16; flags = 1; }
        else { kind = 2; idx = ch - 20; flags = 0; }
    }
}
namespace pg8 {
struct QkvSched {
    int L, nwg, G, c;
    __device__ __forceinline__ void init(int L_, int G_, int c_) { L = L_; G = G_; c = c_; nwg = 66 * (L_ == 0 ? 12 : 6); }
    __device__ __forceinline__ bool next(int i, Unit& u) const {
        const long Lx = (long)i * G + c; if (Lx >= nwg) return false;
        int wgid = (int)Lx; { const int q = nwg / NXCD, r = nwg % NXCD, xcd = wgid % NXCD, off = wgid / NXCD; wgid = (xcd < r ? xcd * (q + 1) : r * (q + 1) + (xcd - r) * q) + off; }
        if (L == 0) { const int t = wgid / 12, j = wgid % 12;
            if (j < 8) { u.pm = t; u.pn = 66 + (j < 4 ? j : j + 2); } else { u.pm = 66 + (j < 10 ? j - 4 : j); u.pn = t; } }
        else { const int t = wgid / 6, j = wgid % 6;
            if (j < 5) { u.pm = t; u.pn = 78 + j; } else { u.pm = 78 + 5; u.pn = t; } }
        return true;
    }
    __device__ __forceinline__ void a_ready(const Unit&) const {}
    __device__ __forceinline__ void done(const Unit&) const {}
};
struct EpiQkv {
    static constexpr bool PERM = true, AFTER_DRAIN = false;
    int L; bf16_t* Q; bf16_t* Kb; bf16_t* VT; const float2* ROPE; float wsc;
    __device__ __forceinline__ void operator()(const f32x4 (&acc)[2][2][4][2], const Unit& u, int wr, int wc, int fr_in, int fq_in) const {
        int fr = fr_in, fq = fq_in; asm volatile("s_nop 15\n\ts_nop 15" : "+v"(fr), "+v"(fq)); __builtin_amdgcn_sched_barrier(0);
        const int WT0 = L == 0 ? 66 : 78, NKH = L == 0 ? 16 : 4, NVR = L == 0 ? 1024 : 256;
        if (u.pm < 66) {
            const int wt = u.pn - WT0, cic = (wc & 1) * 32 + 8 * fq;
#pragma unroll
            for (int bj = 0; bj < 2; ++bj) {
                int kind, idx, flags; chunk_desc(L, wt * 4 + bj * 2 + (wc >> 1), kind, idx, flags);
                bf16_t* base = kind == 0 ? Q + (size_t)idx * SP * 64 : Kb + (size_t)idx * SP * 64;
                const size_t bstride = (size_t)(kind == 0 ? NQH : NKH) * SP * 64;
#pragma unroll
                for (int ai = 0; ai < 2; ++ai)
#pragma unroll
                    for (int m = 0; m < 4; ++m) {
                        const int row = u.pm * BM + ai * HALF + wr * 64 + m * 16 + fr;
                        const bool lat = row < NLAT;
                        const int b = lat ? (row >> 13) : ((row - NLAT) >> 8), t = row & 8191, pos = lat ? 256 + t : ((row - NLAT) & 255);
                        f32x4 v0 = acc[ai][bj][m][0] * wsc, v1 = acc[ai][bj][m][1] * wsc;
                        if ((flags & 1) && lat) {
                            const f32x4 c01 = *(const f32x4*)(ROPE + t * 32 + (cic >> 1)), c23 = *(const f32x4*)(ROPE + t * 32 + (cic >> 1) + 2);
                            const f32x4 a = v0, bq = v1;
                            v0[0] = a[0] * c01[0] - a[1] * c01[1]; v0[1] = a[0] * c01[1] + a[1] * c01[0];
                            v0[2] = a[2] * c01[2] - a[3] * c01[3]; v0[3] = a[2] * c01[3] + a[3] * c01[2];
                            v1[0] = bq[0] * c23[0] - bq[1] * c23[1]; v1[1] = bq[0] * c23[1] + bq[1] * c23[0];
                            v1[2] = bq[2] * c23[2] - bq[3] * c23[3]; v1[3] = bq[2] * c23[3] + bq[3] * c23[2];
                        }
                        u32x4 w; w.x = cvt_pk_bf16(v0[0], v0[1]); w.y = cvt_pk_bf16(v0[2], v0[3]); w.z = cvt_pk_bf16(v1[0], v1[1]); w.w = cvt_pk_bf16(v1[2], v1[3]);
                        *(u32x4*)(base + (size_t)b * bstride + (size_t)pos * 64 + cic) = w;
                    }
            }
        } else {
            const int wt = u.pm - WT0;
            const int vbase = L == 0 ? (wt == 4 ? 0 : wt == 5 ? 256 : wt == 10 ? 512 : 768) : 0;
            const int t = u.pn, b = t < 64 ? (t >> 5) : (t - 64), pos0 = t < 64 ? 256 + (t & 31) * 256 : 0;
#pragma unroll
            for (int ai = 0; ai < 2; ++ai)
#pragma unroll
                for (int m = 0; m < 4; ++m) {
                    bf16_t* rowp = VT + ((size_t)b * NVR + vbase + ai * HALF + wr * 64 + m * 16 + fr) * SP + pos0 + wc * 32 + 8 * fq;
#pragma unroll
                    for (int bj = 0; bj < 2; ++bj) { const f32x4 v0 = acc[ai][bj][m][0] * wsc, v1 = acc[ai][bj][m][1] * wsc;
                        u32x4 w; w.x = cvt_pk_bf16(v0[0], v0[1]); w.y = cvt_pk_bf16(v0[2], v0[3]); w.z = cvt_pk_bf16(v1[0], v1[1]); w.w = cvt_pk_bf16(v1[2], v1[3]);
                        *(u32x4*)(rowp + bj * HALF) = w; }
                }
        }
    }
};
}
__device__ __forceinline__ void phase_qkv(const Params& p, int L, int bid, int nb, unsigned char* smem) {
    pg8::Gemm g{(const bf16_t*)(p.ws + WS_H), (const bf16_t*)(p.ws + WS_H), 0, 0, D / 2};
    pg8::QkvSched So; So.init(L, nb, bid);
    pg8::EpiQkv E{L, (bf16_t*)(p.ws + WS_Q), (bf16_t*)(p.ws + WS_K), (bf16_t*)(p.ws + WS_VT), (const float2*)(p.ws + WS_ROPE), 1.0f / WQKV8_SCALE};
    pg8::gemm_phase<pg8::EpiQkv, pg8::QkvSched, true, true, true>((PG8_LAS unsigned char*)smem, g, So, E);
}

__device__ __forceinline__ void phase_knorm(const Params& p, int bid, int nb) {
    bf16_t* Kb = (bf16_t*)(p.ws + WS_K);
    const float2* ROPE = (const float2*)(p.ws + WS_ROPE);
    const int lane = threadIdx.x & 63, wv = threadIdx.x >> 6, nw = blockDim.x / 64;
    const float nwt = p.k_norm[lane];
    for (int it = bid * nw + wv; it < 2 * 2 * (SP / 8); it += nb * nw) {
        const int tile8 = it % (SP / 8), hb = it / (SP / 8), hd = hb & 1, b = hb >> 1;
        bf16_t* base = Kb + ((size_t)(b * 4 + hd) * SP + tile8 * 8) * 64 + lane;
#pragma unroll
        for (int i = 0; i < 8; ++i) {
            float v = bf2f(base[i * 64]);
            const float ss = wave_sum(v * v); v = v * rsqrtf(ss * (1.f / 64.f) + RMS_EPS) * nwt;
            if (tile8 >= 32) {
                const float2 cs = ROPE[(tile8 * 8 + i - 256) * 32 + (lane >> 1)];
                const float o = __shfl_xor(v, 1);
                v = (lane & 1) ? (o * cs.y + v * cs.x) : (v * cs.x - o * cs.y);
            }
            base[i * 64] = (bf16_t)f2bf(v);
        }
    }
}

__device__ __forceinline__ void phase_oproj(const Params& p, int L, int bid, int nb, unsigned char* smem) {
    const int M = L == 0 ? NTOK : NLAT;
    pg8::Gemm g{(const bf16_t*)(p.ws + WS_Y), (const bf16_t*)(p.ws + (L == 0 ? WS_WT_ABOUT : WS_WT_CDOUT)), M, D, D};
    pg8::OprojSched So; So.init(M, nb, bid, (unsigned*)(p.ws + WS_CTL) + FLAG_WORD + L * 128);
    pg8::EpiStoreBf16 E{(bf16_t*)(p.ws + WS_YO), D};
    pg8::gemm_phase<pg8::EpiStoreBf16, pg8::OprojSched, true, true, false>((PG8_LAS unsigned char*)smem, g, So, E);
    __syncthreads();
}

__device__ __forceinline__ void phase_ln1(const Params& p, int L, int bid, int nb, unsigned char* smem) {
    typedef float f32x4v __attribute__((ext_vector_type(4)));
    const float* MOD = (const float*)(p.ws + WS_MOD);
    const bf16_t* YO = (const bf16_t*)(p.ws + WS_YO);
    const bf16_t* X2 = (const bf16_t*)(p.ws + WS_X2);
    bf16_t* X1 = (bf16_t*)(p.ws + WS_X1);
    unsigned char* TOK8 = p.ws + WS_TOK;
    int* cnt = (int*)(p.ws + WS_CTL) + L * 32 * CNT_STRIDE;
    int* pair_e = (int*)(p.ws + WS_PAIR); int* pair_pos = pair_e + NTOK * 4; float* pair_gate = (float*)(pair_e + 3 * NTOK * 4);
    const int tidf = tid_fresh(); const int lane = tidf & 63, wv = tidf >> 6;
    constexpr int TKS = 1025;
    float* tokA = (float*)smem;
    float* part = (float*)(smem + 16 * TKS * 4 + 64);
    const LAS float* pl = (const LAS float*)(smem + LDS_PAR);
    int* lcnt = (int*)(smem + LDS_MISC);
    if (threadIdx.x < 2 * NE) lcnt[threadIdx.x] = 0;
    const int nrows = L == 0 ? NTOK : NLAT, ngrp = nrows / 16;
    const float* lg = p.ln1_g + L * D; const float* lb = p.ln1_b + L * D;
    const float* rw = p.router_w + (size_t)L * D * NE; const float* rb = p.router_b + L * NE;
    float4 xa[2][4]; uint2 ya[2][4];
    auto load_rows = [&](int g) {
        const int row0 = g * 16 + 2 * wv; const bool lt = row0 < NLAT;
        const float* xin0 = lt ? p.x + (size_t)row0 * D : p.ctx + (size_t)(row0 - NLAT) * D;
#pragma unroll
        for (int q = 0; q < 2; ++q)
#pragma unroll
            for (int j = 0; j < 4; ++j) { const int k = 4 * lane + 256 * j;
                if (L == 0) xa[q][j] = *(const float4*)(xin0 + (size_t)q * D + k);
                else { const uint2 xw = *(const uint2*)(X2 + (size_t)(row0 + q) * D + k); xa[q][j] = make_float4(bf2f(xw.x & 0xffffu), bf2f(xw.x >> 16), bf2f(xw.y & 0xffffu), bf2f(xw.y >> 16)); }
                ya[q][j] = *(const uint2*)(YO + (size_t)(row0 + q) * D + k); }
    };
    unsigned* oflag = (unsigned*)(p.ws + WS_CTL) + FLAG_WORD + L * 128;
    auto wait_tile = [&](int g) {
        if (threadIdx.x == 0) {
            unsigned sp = 0;
            while (__hip_atomic_load(&oflag[g >> 4], __ATOMIC_RELAXED, __HIP_MEMORY_SCOPE_AGENT) < 4u) { __builtin_amdgcn_s_sleep(1); if (++sp > (1u << 22)) break; }
            __builtin_amdgcn_fence(__ATOMIC_ACQUIRE, "agent");
            asm volatile("s_waitcnt vmcnt(0)" ::: "memory");
        }
    };
    const int g0 = nb - 1 - bid;
    if (g0 < ngrp) wait_tile(g0);
    __syncthreads();
    if (g0 < ngrp) load_rows(g0);
    for (int grp = g0; grp < ngrp; grp += nb) {
        const int rowb = grp * 16; const bool lat = rowb < NLAT; const int rbat = lat ? (rowb >> 13) : 2;
        {
            const float* modb = MOD + (L * 3 + rbat) * 6144;
            if (grp + nb < ngrp) wait_tile(grp + nb);
            __syncthreads();
            for (int i = threadIdx.x; i < 1280; i += blockDim.x) { const int vsel = i >> 8, idx = (i & 255) * 4;
                const float* src = vsel == 0 ? modb + 2048 : vsel == 1 ? modb + 3072 : vsel == 2 ? modb + 4096 : vsel == 3 ? lg : lb;
                const float4 t = *(const float4*)(src + idx);
                *(LAS float4v*)(smem + LDS_PAR + (vsel * 1024 + idx) * 4) = (float4v){t.x, t.y, t.z, t.w}; }
            __syncthreads();
        }
        {
            const int row0 = rowb + 2 * wv;
            float4 vq[2][4]; float sq[2];
#pragma unroll
            for (int q = 0; q < 2; ++q) {
                sq[q] = 0.f;
#pragma unroll
                for (int j = 0; j < 4; ++j) {
                    const int k = 4 * lane + 256 * j;
                    const float4 a = xa[q][j]; const uint2 yw = ya[q][j]; const float4 y = make_float4(bf2f(yw.x & 0xffffu), bf2f(yw.x >> 16), bf2f(yw.y & 0xffffu), bf2f(yw.y >> 16)); const float4v g = *(const LAS float4v*)(pl + k);
                    vq[q][j] = make_float4(ALPHA * a.x + g.x * y.x, ALPHA * a.y + g.y * y.y, ALPHA * a.z + g.z * y.z, ALPHA * a.w + g.w * y.w);
                    sq[q] += (vq[q][j].x + vq[q][j].y) + (vq[q][j].z + vq[q][j].w);
                }
            }
            if (grp + nb < ngrp) load_rows(grp + nb);
#pragma unroll
            for (int q = 0; q < 2; ++q) {
                const int row = row0 + q;
                float4 v[4]; float s = sq[q];
#pragma unroll
                for (int j = 0; j < 4; ++j) v[j] = vq[q][j];
                const float mean = wave_sum(s) * (1.f / D); float s2 = 0.f;
#pragma unroll
                for (int j = 0; j < 4; ++j) { v[j].x -= mean; v[j].y -= mean; v[j].z -= mean; v[j].w -= mean; s2 += (v[j].x * v[j].x + v[j].y * v[j].y) + (v[j].z * v[j].z + v[j].w * v[j].w); }
                const float rstd = rsqrtf(wave_sum(s2) * (1.f / D) + LN_EPS);
#pragma unroll
                for (int j = 0; j < 4; ++j) {
                    const int k = 4 * lane + 256 * j;
                    const float4v g = *(const LAS float4v*)(pl + 3072 + k), bb = *(const LAS float4v*)(pl + 4096 + k), a = *(const LAS float4v*)(pl + 2048 + k), b2 = *(const LAS float4v*)(pl + 1024 + k);
                    float4 x1 = make_float4(v[j].x * rstd * g.x + bb.x, v[j].y * rstd * g.y + bb.y, v[j].z * rstd * g.z + bb.z, v[j].w * rstd * g.w + bb.w);
                    { uint2 xo; xo.x = pk2(x1.x, x1.y); xo.y = pk2(x1.z, x1.w); *(uint2*)(X1 + (size_t)row * D + k) = xo; }
                    float4 tk = make_float4(x1.x * (1.f + a.x) + b2.x, x1.y * (1.f + a.y) + b2.y, x1.z * (1.f + a.z) + b2.z, x1.w * (1.f + a.w) + b2.w);
                    float* td = tokA + (2 * wv + q) * TKS + k; td[0] = tk.x; td[1] = tk.y; td[2] = tk.z; td[3] = tk.w;
                    *(unsigned*)(TOK8 + (size_t)row * D + k) = pk4_fp8(tk.x, tk.y, tk.z, tk.w);
                }
            }
        }
        __syncthreads();
        {
            f32x4v c0 = {0.f, 0.f, 0.f, 0.f}, c1 = {0.f, 0.f, 0.f, 0.f};
            const float* ta = tokA + (lane & 15) * TKS + 128 * wv + (lane >> 4);
            const float* wb = rw + (size_t)(128 * wv + (lane >> 4)) * NE + (lane & 15);
#pragma unroll 8
            for (int ks = 0; ks < 32; ++ks) {
                const float a = ta[4 * ks], b0 = wb[(size_t)(4 * ks) * NE], b1 = wb[(size_t)(4 * ks) * NE + 16];
                c0 = __builtin_amdgcn_mfma_f32_16x16x4f32(a, b0, c0, 0, 0, 0);
                c1 = __builtin_amdgcn_mfma_f32_16x16x4f32(a, b1, c1, 0, 0, 0);
            }
#pragma unroll
            for (int r = 0; r < 4; ++r) { float* pd = part + (wv * 16 + 4 * (lane >> 4) + r) * 32 + (lane & 15); pd[0] = c0[r]; pd[16] = c1[r]; }
        }
        __syncthreads();
        {
            const int e = lane & 31; const float rbe = rb[e];
#pragma unroll 1
            for (int q = 0; q < 2; ++q) {
                const int rl = 2 * wv + q, row = rowb + rl;
                float val = rbe;
#pragma unroll
                for (int w8 = 0; w8 < 8; ++w8) val += part[(w8 * 16 + rl) * 32 + e];
                int rank = 0;
#pragma unroll
                for (int j = 0; j < 32; ++j) { const float vj = __builtin_bit_cast(float, __builtin_amdgcn_readlane(__builtin_bit_cast(int, val), j)); rank += (vj > val || (vj == val && j < e)) ? 1 : 0; }
                float tv[4]; int ti[4];
#pragma unroll
                for (int rr = 0; rr < 4; ++rr) {
                    const unsigned msk = (unsigned)__ballot(rank == rr);
                    const int idx = __builtin_amdgcn_readfirstlane(__builtin_ctz(msk));
                    ti[rr] = idx; tv[rr] = __builtin_bit_cast(float, __builtin_amdgcn_readlane(__builtin_bit_cast(int, val), idx));
                }
                const float e0 = 1.f, e1 = __expf(tv[1] - tv[0]), e2 = __expf(tv[2] - tv[0]), e3 = __expf(tv[3] - tv[0]);
                const float inv = 1.f / (e0 + e1 + e2 + e3);
                const float gs4[4] = {e0 * inv, e1 * inv, e2 * inv, e3 * inv};
                if (lane == 0) {
#pragma unroll
                    for (int rr = 0; rr < 4; ++rr) {
                        const int pos = atomicAdd(&lcnt[ti[rr]], 1);
                        pair_e[row * 4 + rr] = ti[rr]; pair_pos[row * 4 + rr] = pos; pair_gate[row * 4 + rr] = gs4[rr];
                    }
                }
            }
        }
    }
    __syncthreads();
    if (threadIdx.x < NE) lcnt[NE + threadIdx.x] = atomicAdd(&cnt[threadIdx.x * CNT_STRIDE], lcnt[threadIdx.x]);
    __syncthreads();
    int* etok = (int*)(p.ws + WS_XB); float* egate = (float*)(p.ws + WS_XB + 4 * MiB);
    for (int grp = g0; grp < ngrp; grp += nb)
        if (threadIdx.x < 64) { const int pr = grp * 64 + threadIdx.x, e = pair_e[pr], pos = pair_pos[pr] + lcnt[NE + e];
            pair_pos[pr] = pos; etok[e * ECAP + pos] = pr >> 2; egate[e * ECAP + pos] = pair_gate[pr]; }
    __syncthreads();
}

__device__ __forceinline__ int moe_tile_table(const Params& p, int L, unsigned char* smem) {
    const int* cnt = (const int*)(p.ws + WS_CTL) + L * 32 * CNT_STRIDE;
    LAS int* tab = (LAS int*)(smem + LDS_MISC);
    __syncthreads();
    if (threadIdx.x == 0) { int t = 0;
        for (int e = 0; e < NE; ++e) { const int n = (cnt[e * CNT_STRIDE] + 255) / 256; tab[PSTART_AT + e] = t * 256; for (int q = 0; q < n; ++q) { tab[TOFF_AT + t] = e * ECAP - (t - q) * 256; tab[t++] = e; } }
        tab[320] = t; }
    __syncthreads();
    return tab[320];
}
__device__ __forceinline__ void phase_moe1(const Params& p, int L, int bid, int nb, unsigned char* smem) {
    const int T = moe_tile_table(p, L, smem);
    {
        const PG8_LAS int* tab = (const PG8_LAS int*)(smem + LDS_MISC);
        const int* pair_e = (const int*)(p.ws + WS_PAIR); const int* pair_pos = pair_e + NTOK * 4; int* pair_slot = (int*)pair_e + 2 * NTOK * 4;
        const int npairs = (L == 0 ? NTOK : NLAT) * 4;
        for (int pr = bid * blockDim.x + threadIdx.x; pr < npairs; pr += nb * blockDim.x) pair_slot[pr] = tab[PSTART_AT + pair_e[pr]] + pair_pos[pr];
    }
    pg8::Gemm g{(const bf16_t*)(p.ws + WS_TOK), (const bf16_t*)(p.ws + WS_WT_MIN + (size_t)L * 32 * 2048 * 1024), MAXSLOT, 32 * 2048, D / 2, (const int*)(p.ws + WS_XB)};
    pg8::MoeSched So; So.init(T, 8, nb, bid, (const PG8_LAS int*)(smem + LDS_MISC));
    pg8::EpiMoe1 E{(bf16_t*)(p.ws + WS_ACT), p.moe_b_in + (size_t)L * 32 * 2048, 1.0f / W8_SCALE};
    pg8::gemm_phase<pg8::EpiMoe1, pg8::MoeSched, true, true, true, true>((PG8_LAS unsigned char*)smem, g, So, E);
}
__device__ __forceinline__ void phase_moe2(const Params& p, int L, int bid, int nb, unsigned char* smem) {
    const int T = moe_tile_table(p, L, smem);
    pg8::Gemm g{(const bf16_t*)(p.ws + WS_ACT), (const bf16_t*)(p.ws + WS_WT_MOUT + (size_t)L * 32 * 1024 * 1024), MAXSLOT, 32 * 1024, D / 2};
    pg8::MoeSched So; So.init(T, 4, nb, bid, (const PG8_LAS int*)(smem + LDS_MISC));
    pg8::EpiMoe2 E{(bf16_t*)(p.ws + WS_YP), p.moe_b_out + (size_t)L * 32 * 1024, (const float*)(p.ws + WS_XB + 4 * MiB), 1.0f / (ACT8_SCALE * W8O_SCALE), (const PG8_LAS int*)(smem + LDS_MISC) + TOFF_AT};
    pg8::gemm_phase<pg8::EpiMoe2, pg8::MoeSched, true, true, true>((PG8_LAS unsigned char*)smem, g, So, E);
}

__device__ __forceinline__ void phase_ln2(const Params& p, int L, int bid, int nb) {
    const float* MOD = (const float*)(p.ws + WS_MOD);
    const bf16_t* X1 = (const bf16_t*)(p.ws + WS_X1);
    const unsigned char* YP8 = p.ws + WS_YP;
    const int* pair_slot = (const int*)(p.ws + WS_PAIR) + 2 * NTOK * 4;
    bf16_t* X2 = (bf16_t*)(p.ws + WS_X2); unsigned char* H8 = p.ws + WS_H;
    const int lane = threadIdx.x & 63, wv = threadIdx.x >> 6, nw = blockDim.x / 64;
    const int nrows = L == 0 ? NTOK : NLAT;
    const float* lg = p.ln2_g + L * D; const float* lb = p.ln2_b + L * D;
    for (int rp = bid * nw + wv; rp < nrows / 2; rp += nb * nw) {
        const int row0 = rp * 2;
        const bool lat = row0 < NLAT; const int r = lat ? (row0 >> 13) : 2;
        const float* mod = MOD + (L * 3 + r) * 6144; const float* g2 = mod + 5120;
        const float* modn = MOD + ((L == 0 ? 1 : 0) * 3 + r) * 6144;
        int sl[2][4];
#pragma unroll
        for (int q = 0; q < 2; ++q)
#pragma unroll
            for (int t = 0; t < 4; ++t) sl[q][t] = pair_slot[(row0 + q) * 4 + t];
        float4 xa[2][4]; unsigned yw[2][4][4];
#pragma unroll
        for (int q = 0; q < 2; ++q)
#pragma unroll
            for (int j = 0; j < 4; ++j) { const int k = 4 * lane + 256 * j; { const uint2 xw = *(const uint2*)(X1 + (size_t)(row0 + q) * D + k); xa[q][j] = make_float4(bf2f(xw.x & 0xffffu), bf2f(xw.x >> 16), bf2f(xw.y & 0xffffu), bf2f(xw.y >> 16)); }
#pragma unroll
                for (int t = 0; t < 4; ++t) yw[q][j][t] = *(const unsigned*)(YP8 + (size_t)sl[q][t] * D + k); }
        float4 fs[2][4];
#pragma unroll
        for (int q = 0; q < 2; ++q)
#pragma unroll
            for (int j = 0; j < 4; ++j) { float4 f = make_float4(0.f, 0.f, 0.f, 0.f);
#pragma unroll
                for (int t = 0; t < 4; ++t) { const unsigned w = yw[q][j][t]; const f2v lo = __builtin_amdgcn_cvt_pk_f32_fp8(w, false), hi = __builtin_amdgcn_cvt_pk_f32_fp8(w, true); f.x += lo.x; f.y += lo.y; f.z += hi.x; f.w += hi.y; }
                fs[q][j] = make_float4(f.x * (1.f / YP8_SCALE), f.y * (1.f / YP8_SCALE), f.z * (1.f / YP8_SCALE), f.w * (1.f / YP8_SCALE)); }
#pragma unroll 1
        for (int q = 0; q < 2; ++q) {
            const int row = row0 + q;
            float4 v[4]; float s = 0.f;
#pragma unroll
            for (int j = 0; j < 4; ++j) {
                const int k = 4 * lane + 256 * j;
                float4 f = q == 0 ? fs[0][j] : fs[1][j];
                const float4 a = q == 0 ? xa[0][j] : xa[1][j], g = *(const float4*)(g2 + k);
                v[j] = make_float4(ALPHA * a.x + g.x * f.x, ALPHA * a.y + g.y * f.y, ALPHA * a.z + g.z * f.z, ALPHA * a.w + g.w * f.w);
                s += (v[j].x + v[j].y) + (v[j].z + v[j].w);
            }
            const float mean = wave_sum(s) * (1.f / D); float s2 = 0.f;
#pragma unroll
            for (int j = 0; j < 4; ++j) { v[j].x -= mean; v[j].y -= mean; v[j].z -= mean; v[j].w -= mean; s2 += (v[j].x * v[j].x + v[j].y * v[j].y) + (v[j].z * v[j].z + v[j].w * v[j].w); }
            const float rstd = rsqrtf(wave_sum(s2) * (1.f / D) + LN_EPS);
#pragma unroll
            for (int j = 0; j < 4; ++j) {
                const int k = 4 * lane + 256 * j;
                const float4 g = *(const float4*)(lg + k), bb = *(const float4*)(lb + k);
                const float4 x2 = make_float4(v[j].x * rstd * g.x + bb.x, v[j].y * rstd * g.y + bb.y, v[j].z * rstd * g.z + bb.z, v[j].w * rstd * g.w + bb.w);
                if (L == 0) {
                    { uint2 xo; xo.x = pk2(x2.x, x2.y); xo.y = pk2(x2.z, x2.w); *(uint2*)(X2 + (size_t)row * D + k) = xo; }
                    const float4 b = *(const float4*)(modn + k), a = *(const float4*)(modn + 1024 + k);
                    *(unsigned*)(H8 + (size_t)row * D + k) = pk4_fp8(x2.x * (1.f + a.x) + b.x, x2.y * (1.f + a.y) + b.y, x2.z * (1.f + a.z) + b.z, x2.w * (1.f + a.w) + b.w);
                } else {
                    *(float4*)(p.out + (size_t)row * D + k) = x2;
                }
            }
        }
    }
}

namespace att {
typedef short bf16x8 __attribute__((ext_vector_type(8)));
typedef float f32x16 __attribute__((ext_vector_type(16)));
typedef unsigned u4v __attribute__((ext_vector_type(4)));
typedef unsigned u2v __attribute__((ext_vector_type(2)));
constexpr int KROWB = 144, VROWB = 136, KBUF = 64 * KROWB, VBUF = 128 * VROWB;
constexpr int L_K = 0, L_V = 4 * KBUF, L_BIAS = 4 * KBUF + 4 * VBUF, L_X = L_BIAS + 2048, L_END = L_X + 2048;
constexpr float LOG2E = 1.4426950408889634f, C2 = 0.125f * LOG2E, NEGBIG = -1e30f;
constexpr float THR_L2 = 8.0f;
__device__ __forceinline__ int crow(int r, int hi) { return (r & 3) + 8 * (r >> 2) + 4 * hi; }
__device__ __forceinline__ unsigned cvtpk(float lo, float hi) { unsigned r; asm volatile("v_cvt_pk_bf16_f32 %0, %1, %2" : "=v"(r) : "v"(lo), "v"(hi)); return r; }
__device__ __forceinline__ float xhalf_max(float v) { auto rr = __builtin_amdgcn_permlane32_swap(__float_as_uint(v), __float_as_uint(v), false, false); return fmaxf(__uint_as_float(rr[0]), __uint_as_float(rr[1])); }
__device__ __forceinline__ float xhalf_sum(float v) { auto rr = __builtin_amdgcn_permlane32_swap(__float_as_uint(v), __float_as_uint(v), false, false); return __uint_as_float(rr[0]) + __uint_as_float(rr[1]); }

template <int VR> struct TileRegs { u4v k; u4v v[VR / 64]; };
template <int VR>
__device__ __forceinline__ void tile_load(TileRegs<VR>& t, const bf16_t* Kh, const bf16_t* VTh, int pos0, int tid) {
    const int row = tid >> 3, ch = tid & 7;
    t.k = *(const u4v*)(Kh + (size_t)(pos0 + row) * 64 + ch * 8);
#pragma unroll
    for (int i = 0; i < VR / 64; ++i) t.v[i] = *(const u4v*)(VTh + (size_t)(row + 64 * i) * SP + pos0 + ch * 8);
}
template <int VR>
__device__ __forceinline__ void tile_store(const TileRegs<VR>& t, LAS unsigned char* lds, int buf, int tid) {
    const int row = tid >> 3, ch = tid & 7;
    *(LAS u4v*)(lds + L_K + buf * KBUF + row * KROWB + ch * 16) = t.k;
#pragma unroll
    for (int i = 0; i < VR / 64; ++i) {
        LAS u2v* d = (LAS u2v*)(lds + L_V + buf * VBUF + (row + 64 * i) * VROWB + ch * 16);
        d[0] = (u2v){t.v[i].x, t.v[i].y}; d[1] = (u2v){t.v[i].z, t.v[i].w};
    }
}

struct MaskArgs { int rq, cq; const LAS float* biasL; };

template <int MODE>
__device__ __forceinline__ void softmax_half(f32x16& p, bf16x8 (&pb)[2], f32x16 (&o)[2], float& m, float& l, bf16x8& qx, int kpos0  , bool lat, int qp, int rq, int cq, const LAS float* biasL, int hi) {
    float mx = NEGBIG;
#pragma unroll
    for (int r = 0; r < 16; ++r) {
        float t = p[r];
        if (MODE == 1) { if (lat) { const int dd = qp - (kpos0 + crow(r, hi)); if (dd > 128 || dd < -128) t = NEGBIG; } }
        if (MODE == 2) {
            if (lat) {
                const int krow = (kpos0 - 256) >> 6, kc = ((kpos0 - 256) & 63) + crow(r, hi);
                const int ws = min(max(cq - 8, 0), 48);
                const bool valid = (unsigned)(kc - ws) < 16u;
                const int dc = min(max(kc - cq + 15, 0), 30);
                const float bv = biasL[(krow - rq + 7) * 31 + dc];
                t = valid ? t + bv : NEGBIG; } }
        if (MODE != 0) p[r] = t;
        mx = fmaxf(mx, t);
    }
    mx = xhalf_max(mx);
    if (__any(mx > THR_L2)) {
        const float mn = bf2f(f2bf(m + fmaxf(mx, 0.f))), dl = mn - m, alpha = __builtin_amdgcn_exp2f(-dl);
        m = mn; l *= alpha;
#pragma unroll
        for (int dt = 0; dt < 2; ++dt)
#pragma unroll
            for (int r = 0; r < 16; ++r) o[dt][r] *= alpha;
#pragma unroll
        for (int r = 0; r < 16; ++r) p[r] -= dl;
        qx[0] = (short)(hi == 0 ? f2bf(-mn) : 0u);
    }
    float sum = 0.f;
#pragma unroll
    for (int r = 0; r < 16; ++r) { const float e = __builtin_amdgcn_exp2f(p[r]); p[r] = e; sum += e; }
    l += sum;
#pragma unroll
    for (int s = 0; s < 2; ++s) {
        const int s8 = s * 8;
        u4v w; w.x = cvtpk(p[s8 + 0], p[s8 + 1]); w.y = cvtpk(p[s8 + 2], p[s8 + 3]); w.z = cvtpk(p[s8 + 4], p[s8 + 5]); w.w = cvtpk(p[s8 + 6], p[s8 + 7]);
        pb[s] = __builtin_bit_cast(bf16x8, w);
    }
}

template <int VR, int MODE, bool QPROC = false>
__device__ __forceinline__ void attn_pass(LAS unsigned char* lds, const bf16_t* Qh, const bf16_t* Kh, const bf16_t* VTh, int qpw, int vrow, bool wave_on, int ta0, int na, int tb0, int nbt,
                                          f32x16 (&o)[2][2], float (&m)[2], float (&l)[2], int rq, const LAS float* biasL, const float* qw = nullptr, const float2* ROPE = nullptr) {
    int tid = threadIdx.x; asm volatile("" : "+v"(tid));
    const int lane = tid & 63, r32 = lane & 31, hi = lane >> 5;
    bf16x8 qf[2][4];
#pragma unroll
    for (int j = 0; j < 2; ++j)
#pragma unroll
        for (int ks = 0; ks < 4; ++ks) qf[j][ks] = *(const bf16x8*)(Qh + (size_t)(qpw + 32 * j + r32) * 64 + ks * 16 + hi * 8);
    if (QPROC) {
#pragma unroll
        for (int j = 0; j < 2; ++j) {
            float v[4][8]; float ss = 0.f;
#pragma unroll
            for (int ks = 0; ks < 4; ++ks)
#pragma unroll
                for (int e = 0; e < 8; ++e) { v[ks][e] = bf2f((unsigned short)qf[j][ks][e]); ss += v[ks][e] * v[ks][e]; }
            const float sc = rsqrtf(xhalf_sum(ss) * (1.f / 64.f) + RMS_EPS) * C2;
            const int t = qpw + 32 * j + r32 - 256;
#pragma unroll
            for (int ks = 0; ks < 4; ++ks) {
                const int d0 = 16 * ks + 8 * hi;
                const float4 w0 = *(const float4*)(qw + d0), w1 = *(const float4*)(qw + d0 + 4);
                const float4 c01 = *(const float4*)(ROPE + t * 32 + (d0 >> 1)), c23 = *(const float4*)(ROPE + t * 32 + (d0 >> 1) + 2);
                const float x0 = v[ks][0] * sc * w0.x, x1 = v[ks][1] * sc * w0.y, x2 = v[ks][2] * sc * w0.z, x3 = v[ks][3] * sc * w0.w;
                const float x4 = v[ks][4] * sc * w1.x, x5 = v[ks][5] * sc * w1.y, x6 = v[ks][6] * sc * w1.z, x7 = v[ks][7] * sc * w1.w;
                u4v w; w.x = cvtpk(x0 * c01.x - x1 * c01.y, x0 * c01.y + x1 * c01.x); w.y = cvtpk(x2 * c01.z - x3 * c01.w, x2 * c01.w + x3 * c01.z);
                w.z = cvtpk(x4 * c23.x - x5 * c23.y, x4 * c23.y + x5 * c23.x); w.w = cvtpk(x6 * c23.z - x7 * c23.w, x6 * c23.w + x7 * c23.z);
                qf[j][ks] = __builtin_bit_cast(bf16x8, w);
            }
        }
    }
    if (!QPROC) {
#pragma unroll
        for (int j = 0; j < 2; ++j)
#pragma unroll
            for (int ks = 0; ks < 4; ++ks) { u4v w;
#pragma unroll
                for (int e2 = 0; e2 < 4; ++e2) w[e2] = cvtpk(bf2f((unsigned short)qf[j][ks][2 * e2]) * C2, bf2f((unsigned short)qf[j][ks][2 * e2 + 1]) * C2);
                qf[j][ks] = __builtin_bit_cast(bf16x8, w); }
    }
    bf16x8 qx[2]; bf16x8 kone;
#pragma unroll
    for (int e = 0; e < 8; ++e) { qx[0][e] = 0; qx[1][e] = 0; kone[e] = 0; }
    kone[0] = (short)(hi == 0 ? 0x3f80 : 0);
#pragma unroll
    for (int j = 0; j < 2; ++j) {
        m[j] = 0.f; l[j] = 0.f;
#pragma unroll
        for (int dt = 0; dt < 2; ++dt)
#pragma unroll
            for (int r = 0; r < 16; ++r) o[j][dt][r] = 0.f;
    }
    const int n = na + nbt;
    TileRegs<VR> tr;
#define ATT_TPOS(i_) (((i_) < na ? ta0 + (i_) : tb0 + ((i_) - na)) * 64)
    tile_load<VR>(tr, Kh, VTh, ATT_TPOS(0), tid); tile_store<VR>(tr, lds, 0, tid);
    if (n > 1) { tile_load<VR>(tr, Kh, VTh, ATT_TPOS(1), tid); tile_store<VR>(tr, lds, 1, tid); }
    __syncthreads();
    for (int ip = 0; 2 * ip < n; ++ip) {
        const int cb = ip & 1;
#pragma unroll
        for (int h2 = 0; h2 < 2; ++h2) {
            const int i = 2 * ip + h2, inx = i + 2;
            if (inx < n) tile_load<VR>(tr, Kh, VTh, ATT_TPOS(inx), tid);
            if (i < n) {
                const int pos0 = ATT_TPOS(i), slot = 2 * cb + h2;
                bool active = wave_on;
                if (MODE == 1 && pos0 >= 256) active = active && (pos0 <= qpw + 63 + 128) && (pos0 + 63 >= qpw - 128);
                if (MODE == 2 && pos0 >= 256) { const int krow = (pos0 - 256) >> 6, rs = min(max(rq - 4, 0), 120); active = active && (krow >= rs) && (krow < rs + 8); }
        if (active) {
                    const LAS unsigned char* kb = lds + L_K + slot * KBUF;
                    const LAS unsigned char* vb = lds + L_V + slot * VBUF + vrow * VROWB;
        #pragma unroll
                    for (int kt = 0; kt < 2; ++kt) {
                        f32x16 p[2];
        #pragma unroll
                        for (int r = 0; r < 16; ++r) { p[0][r] = 0.f; p[1][r] = 0.f; }
        #pragma unroll
                        for (int ks = 0; ks < 4; ++ks) {
                            const bf16x8 a = *(const LAS bf16x8*)(kb + (32 * kt + r32) * KROWB + ks * 32 + hi * 16);
                            p[0] = __builtin_amdgcn_mfma_f32_32x32x16_bf16(a, qf[0][ks], p[0], 0, 0, 0);
                            p[1] = __builtin_amdgcn_mfma_f32_32x32x16_bf16(a, qf[1][ks], p[1], 0, 0, 0);
                        }
                        p[0] = __builtin_amdgcn_mfma_f32_32x32x16_bf16(kone, qx[0], p[0], 0, 0, 0);
                        p[1] = __builtin_amdgcn_mfma_f32_32x32x16_bf16(kone, qx[1], p[1], 0, 0, 0);
                        bf16x8 pb[2][2];
                        softmax_half<MODE>(p[0], pb[0], o[0], m[0], l[0], qx[0], pos0 + 32 * kt, pos0 >= 256, qpw + r32, rq, r32, biasL, hi);
                        softmax_half<MODE>(p[1], pb[1], o[1], m[1], l[1], qx[1], pos0 + 32 * kt, pos0 >= 256, qpw + 32 + r32, rq, 32 + r32, biasL, hi);
        #pragma unroll
                        for (int dt = 0; dt < 2; ++dt)
        #pragma unroll
                            for (int s = 0; s < 2; ++s) {
                                const int sp = 2 * kt + s;
                                const LAS unsigned char* vp = vb + (32 * dt + r32) * VROWB + (16 * sp + 4 * hi) * 2;
                                const u2v lo = *(const LAS u2v*)vp, hi2 = *(const LAS u2v*)(vp + 16);
                                const bf16x8 a = __builtin_bit_cast(bf16x8, (u4v){lo.x, lo.y, hi2.x, hi2.y});
                                o[0][dt] = __builtin_amdgcn_mfma_f32_32x32x16_bf16(a, pb[0][s], o[0][dt], 0, 0, 0);
                                o[1][dt] = __builtin_amdgcn_mfma_f32_32x32x16_bf16(a, pb[1][s], o[1][dt], 0, 0, 0);
                            }
                    }
                }
            }
            if (inx < n) tile_store<VR>(tr, lds, 2 * (cb ^ 1) + h2, tid);
        }
        __syncthreads();
    }
#undef ATT_TPOS
}

__device__ __forceinline__ void store_out(bf16_t* yrow  , const f32x16 (&o)[2], float sc, int hi) {
#pragma unroll
    for (int dt = 0; dt < 2; ++dt)
#pragma unroll
        for (int g = 0; g < 4; ++g) {
            uint2 w; w.x = cvtpk(o[dt][4 * g + 0] * sc, o[dt][4 * g + 1] * sc); w.y = cvtpk(o[dt][4 * g + 2] * sc, o[dt][4 * g + 3] * sc);
            *(uint2*)(yrow + 32 * dt + 8 * g + 4 * hi) = w;
        }
}
}


constexpr int BG_OFF = 110592;
__device__ __forceinline__ int bg_region(int w) { return w < 5 ? BG_OFF + w * 4096 : LDS_PAR + (w - 5) * 4096; }
constexpr int BG_SLOTS = 96, BG_VB = 256;
struct BgConv { int s, end; bool fly; const float* src; unsigned char* dst; };
__device__ __forceinline__ void bg_seek(const Params& p, BgConv& bg, int vb) {
    if (bg.s < 64) {
        const int n0 = (vb & 31) * 64, k0 = (vb >> 5) * 128, nn = n0 & 1023, drow = 256 * (nn >> 7) + (nn & 127) + (n0 >= 1024 ? 128 : 0);
        bg.src = p.moe_w_in + (size_t)bg.s * 1024 * 2048 + (size_t)k0 * 2048 + n0;
        bg.dst = p.ws + WS_WT_MIN + (size_t)bg.s * 2048 * 1024 + (size_t)drow * 1024 + k0;
    } else {
        const int le = 2 * (bg.s - 64) + (vb >> 7), q2 = vb & 127, n0 = (q2 & 15) * 64, k0 = (q2 >> 4) * 128;
        bg.src = p.moe_w_out + (size_t)le * 1024 * 1024 + (size_t)k0 * 1024 + n0;
        bg.dst = p.ws + WS_WT_MOUT + (size_t)le * 1024 * 1024 + (size_t)n0 * 1024 + k0;
    }
}
__device__ __forceinline__ void bg_start(LAS unsigned char* lds, BgConv& bg) {
    if (bg.s < bg.end) {
        int tid = threadIdx.x; asm volatile("" : "+v"(tid));
        const int lane = tid & 63, w = __builtin_amdgcn_readfirstlane(tid >> 6);
        const int sh = bg.s < 64 ? 11 : 10;
        bg.fly = true;
        const float* src = bg.src + (((size_t)(16 * w + (lane >> 4))) << sh) + 4 * (lane & 15);
        const unsigned l0 = __builtin_amdgcn_readfirstlane((unsigned)(size_t)(lds + bg_region(w)));
        const size_t st = (size_t)4 << sh;
        const float* s1 = src + st; const float* s2 = src + 2 * st; const float* s3 = src + 3 * st;
        asm volatile("s_mov_b32 m0, %4\n\ts_nop 0\n\tglobal_load_lds_dwordx4 %0, off\n\t"
                     "s_mov_b32 m0, %5\n\ts_nop 0\n\tglobal_load_lds_dwordx4 %1, off\n\t"
                     "s_mov_b32 m0, %6\n\ts_nop 0\n\tglobal_load_lds_dwordx4 %2, off\n\t"
                     "s_mov_b32 m0, %7\n\ts_nop 0\n\tglobal_load_lds_dwordx4 %3, off"
                     :: "v"(src), "v"(s1), "v"(s2), "v"(s3), "s"(l0), "s"(l0 + 1024u), "s"(l0 + 2048u), "s"(l0 + 3072u) : "m0", "memory");
    }
}
__device__ __forceinline__ void bg_finish(const Params& p, LAS unsigned char* lds, BgConv& bg, int vb) {
    if (bg.fly) {
        asm volatile("s_waitcnt vmcnt(0)" ::: "memory");
        int tid = threadIdx.x; asm volatile("" : "+v"(tid));
        const int lane = tid & 63, w = __builtin_amdgcn_readfirstlane(tid >> 6);
        const LAS float* sp = (const LAS float*)(lds + bg_region(w)) + lane;
        const float sc = bg.s < 64 ? W8_SCALE : W8O_SCALE;
        float v[16];
#pragma unroll
        for (int i = 0; i < 16; ++i) v[i] = sp[i * 64] * sc;
        uint4 o; o.x = pk4_fp8(v[0], v[1], v[2], v[3]); o.y = pk4_fp8(v[4], v[5], v[6], v[7]); o.z = pk4_fp8(v[8], v[9], v[10], v[11]); o.w = pk4_fp8(v[12], v[13], v[14], v[15]);
        *(uint4*)(bg.dst + (size_t)lane * 1024 + 16 * w) = o;
        asm volatile("s_waitcnt lgkmcnt(0)" ::: "memory");
        bg.fly = false; ++bg.s;
        if (bg.s == 64) bg_seek(p, bg, vb); else { bg.src += 2 * 1024 * 1024; bg.dst += 2 * 1024 * 1024; }
    }
}
namespace attd {
typedef short bf16x8 __attribute__((ext_vector_type(8)));
typedef float f32x16 __attribute__((ext_vector_type(16)));
typedef unsigned u4v __attribute__((ext_vector_type(4)));
typedef unsigned u2v __attribute__((ext_vector_type(2)));
constexpr int KROWB = 144, VROWB = 136, KBUF = 64 * KROWB, VBUF = 128 * VROWB;
constexpr int L_K = 0, L_V = 4 * KBUF, L_BIAS = 4 * KBUF + 4 * VBUF, L_END = L_BIAS + 2048;
constexpr float LOG2E = 1.4426950408889634f, C2 = 0.125f * LOG2E, NEGBIG = -1e30f;
__device__ __forceinline__ int crow(int r, int hi) { return (r & 3) + 8 * (r >> 2) + 4 * hi; }
__device__ __forceinline__ unsigned cvtpk(float lo, float hi) { unsigned r; asm volatile("v_cvt_pk_bf16_f32 %0, %1, %2" : "=v"(r) : "v"(lo), "v"(hi)); return r; }

template <int DV> struct TileRegs { u4v k; u4v v[DV / 64]; };
template <int DV>
__device__ __forceinline__ void tile_load(TileRegs<DV>& t, const bf16_t* Kh, const bf16_t* VTh, int pos0, int tid) {
    const int row = tid >> 3, ch = tid & 7;
    t.k = *(const u4v*)(Kh + (size_t)(pos0 + row) * 64 + ch * 8);
#pragma unroll
    for (int i = 0; i < DV / 64; ++i) t.v[i] = *(const u4v*)(VTh + (size_t)(row + 64 * i) * SP + pos0 + ch * 8);
}
template <int DV>
__device__ __forceinline__ void tile_store(const TileRegs<DV>& t, LAS unsigned char* lds, int kbuf, int vbuf, int tid) {
    const int row = tid >> 3, ch = tid & 7;
    *(LAS u4v*)(lds + L_K + kbuf * KBUF + row * KROWB + ch * 16) = t.k;
#pragma unroll
    for (int i = 0; i < DV / 64; ++i) {
        LAS u2v* d = (LAS u2v*)(lds + L_V + vbuf * VBUF + (row + 64 * i) * VROWB + ch * 16);
        d[0] = (u2v){t.v[i].x, t.v[i].y}; d[1] = (u2v){t.v[i].z, t.v[i].w};
    }
}

struct MaskArgs { int rq, cq; const LAS float* biasL; };
constexpr float THR_L2 = 8.0f;

__device__ __forceinline__ void qk_step(f32x16 (&p)[2], const LAS unsigned char* kb, const bf16x8 (&qf)[4], int r32, int hi) {
#pragma unroll
    for (int kt = 0; kt < 2; ++kt) {
#pragma unroll
        for (int r = 0; r < 16; ++r) p[kt][r] = 0.f;
#pragma unroll
        for (int ks = 0; ks < 4; ++ks) {
            const bf16x8 a = *(const LAS bf16x8*)(kb + (32 * kt + r32) * KROWB + ks * 32 + hi * 16);
            p[kt] = __builtin_amdgcn_mfma_f32_32x32x16_bf16(a, qf[ks], p[kt], 0, 0, 0);
        }
    }
}
template <int DV, int MODE>
__device__ __forceinline__ void softmax_step(f32x16 (&p)[2], bf16x8 (&pb)[4], f32x16 (&o)[DV / 32], float& m, float& l, int pos0, int qp, const MaskArgs& ma, int hi) {
    constexpr float XS = (MODE == 2) ? 1.0f : C2;
    constexpr float THR = THR_L2 / XS;
    float mx; float mxp[4] = {NEGBIG, NEGBIG, NEGBIG, NEGBIG};
#pragma unroll
    for (int kt = 0; kt < 2; ++kt)
#pragma unroll
        for (int r = 0; r < 16; ++r) {
            float t = p[kt][r];
            if (MODE == 1) { if (pos0 >= 256) { const int dd = qp - (pos0 + 32 * kt + crow(r, hi)); if (dd > 128 || dd < -128) t = NEGBIG; } }
            if (MODE == 2) {
                t *= C2;
                if (pos0 >= 256) {
                    const int krow = (pos0 - 256) >> 6, kc = 32 * kt + crow(r, hi);
                    const int ws = min(max(ma.cq - 8, 0), 48);
                    const bool valid = (unsigned)(kc - ws) < 16u;
                    const int dc = min(max(kc - ma.cq + 15, 0), 30);
                    const float bv = ma.biasL[(krow - ma.rq + 7) * 31 + dc];
                    t = valid ? t + bv : NEGBIG; } }
            p[kt][r] = t; mxp[r & 3] = fmaxf(mxp[r & 3], t);
        }
    mx = fmaxf(fmaxf(mxp[0], mxp[1]), fmaxf(mxp[2], mxp[3]));
    { auto rr = __builtin_amdgcn_permlane32_swap(__float_as_uint(mx), __float_as_uint(mx), false, false);
      mx = fmaxf(__uint_as_float(rr[0]), __uint_as_float(rr[1])); }
    if (__any(mx > m + THR)) {
        const float mn = fmaxf(m, mx), alpha = __builtin_amdgcn_exp2f((m - mn) * XS);
        m = mn; l *= alpha;
#pragma unroll
        for (int dt = 0; dt < DV / 32; ++dt)
#pragma unroll
            for (int r = 0; r < 16; ++r) o[dt][r] *= alpha;
    }
    const float nm = -m * XS;
    float sm[4] = {0.f, 0.f, 0.f, 0.f};
#pragma unroll
    for (int kt = 0; kt < 2; ++kt)
#pragma unroll
        for (int r = 0; r < 16; ++r) { const float e = __builtin_amdgcn_exp2f(MODE == 2 ? p[kt][r] + nm : fmaf(p[kt][r], C2, nm)); p[kt][r] = e; sm[r & 3] += e; }
    l += (sm[0] + sm[1]) + (sm[2] + sm[3]);
#pragma unroll
    for (int sp = 0; sp < 4; ++sp) {
        const int kt = sp >> 1, s8 = (sp & 1) * 8;
        u4v w; w.x = cvtpk(p[kt][s8 + 0], p[kt][s8 + 1]); w.y = cvtpk(p[kt][s8 + 2], p[kt][s8 + 3]); w.z = cvtpk(p[kt][s8 + 4], p[kt][s8 + 5]); w.w = cvtpk(p[kt][s8 + 6], p[kt][s8 + 7]);
        pb[sp] = __builtin_bit_cast(bf16x8, w);
    }
}
template <int DV>
__device__ __forceinline__ void pv_step(f32x16 (&o)[DV / 32], const LAS unsigned char* vb, const bf16x8 (&pb)[4], int r32, int hi) {
#pragma unroll
    for (int dt = 0; dt < DV / 32; ++dt)
#pragma unroll
        for (int sp = 0; sp < 4; ++sp) {
            const LAS unsigned char* vp = vb + (32 * dt + r32) * VROWB + (16 * sp + 4 * hi) * 2;
            const u2v lo = *(const LAS u2v*)vp, hi2 = *(const LAS u2v*)(vp + 16);
            const u4v w = (u4v){lo.x, lo.y, hi2.x, hi2.y};
            o[dt] = __builtin_amdgcn_mfma_f32_32x32x16_bf16(__builtin_bit_cast(bf16x8, w), pb[sp], o[dt], 0, 0, 0);
        }
}

template <int DV, int MODE, int PINGPONG = 1>
__device__ __forceinline__ void attn_pass(LAS unsigned char* lds, const bf16_t* Qh, const bf16_t* Kh, const bf16_t* VTh, int qpos0, int ta0, int na, int tb0, int nbt,
                                          f32x16 (&o)[DV / 32], float& m, float& l, const MaskArgs& ma, const float* qnorm_w, const Params& prm, BgConv& bg, int bid, int nb) {
    int tid = threadIdx.x; asm volatile("" : "+v"(tid));
    const int lane = tid & 63, w = __builtin_amdgcn_readfirstlane(tid >> 6), r32 = lane & 31, hi = lane >> 5;
    const int qp = qpos0 + 32 * w + r32;
    bf16x8 qf[4];
#pragma unroll
    for (int ks = 0; ks < 4; ++ks) qf[ks] = *(const bf16x8*)(Qh + (size_t)qp * 64 + ks * 16 + hi * 8);
#pragma unroll
    for (int dt = 0; dt < DV / 32; ++dt)
#pragma unroll
        for (int r = 0; r < 16; ++r) o[dt][r] = 0.f;
    m = NEGBIG; l = 0.f;
    const int n = na + nbt;
    TileRegs<DV> tr, tr1;
#define ATT_TPOS(i_) (((i_) < na ? ta0 + (i_) : tb0 + ((i_) - na)) * 64)
    static_assert(PINGPONG == 0, "the pair loop is the in-step form");
    tile_load<DV>(tr, Kh, VTh, ATT_TPOS(0), tid); tile_store<DV>(tr, lds, 0, 0, tid);
    if (n > 1) { tile_load<DV>(tr, Kh, VTh, ATT_TPOS(1), tid); tile_store<DV>(tr, lds, 1, 1, tid); }
    __syncthreads();
    const int qlo = qpos0 + 32 * w;
    f32x16 p[2]; bf16x8 pb[4];
    for (int ip = 0; 2 * ip < n; ++ip) {
        const int cb = ip & 1, i0 = 2 * ip + 2;
        if (i0 < n) tile_load<DV>(tr, Kh, VTh, ATT_TPOS(i0), tid);
        if (i0 + 1 < n) tile_load<DV>(tr1, Kh, VTh, ATT_TPOS(i0 + 1), tid);
        bg_start(lds, bg);
#pragma unroll
        for (int h2 = 0; h2 < 2; ++h2) {
            const int i = 2 * ip + h2;
            if (i < n) {
                const int pos0 = ATT_TPOS(i), slot = 2 * cb + h2;
                bool active = true;
                if (MODE == 1 && pos0 >= 256) active = (pos0 <= qlo + 31 + 128) && (pos0 + 63 >= qlo - 128);
                if (MODE == 2 && pos0 >= 256) { const int krow = (pos0 - 256) >> 6, rs = min(max(ma.rq - 4, 0), 120); active = (krow >= rs) && (krow < rs + 8); }
                if (active) {
                    qk_step(p, lds + L_K + slot * KBUF, qf, r32, hi);
                    softmax_step<DV, MODE>(p, pb, o, m, l, pos0, qp, ma, hi);
                    pv_step<DV>(o, lds + L_V + slot * VBUF, pb, r32, hi);
                }
            }
        }
        if (i0 < n) tile_store<DV>(tr, lds, 2 * (cb ^ 1), 2 * (cb ^ 1), tid);
        if (i0 + 1 < n) tile_store<DV>(tr1, lds, 2 * (cb ^ 1) + 1, 2 * (cb ^ 1) + 1, tid);
        __syncthreads();
        bg_finish(prm, lds, bg, bid);
    }
#undef ATT_TPOS
}

template <int DV>
__device__ __forceinline__ void store_out(bf16_t* yrow  , const f32x16 (&o)[DV / 32], float sc, int hi) {
#pragma unroll
    for (int dt = 0; dt < DV / 32; ++dt)
#pragma unroll
        for (int g = 0; g < 4; ++g) {
            uint2 w; w.x = cvtpk(o[dt][4 * g + 0] * sc, o[dt][4 * g + 1] * sc); w.y = cvtpk(o[dt][4 * g + 2] * sc, o[dt][4 * g + 3] * sc);
            *(uint2*)(yrow + 32 * dt + 8 * g + 4 * hi) = w;
        }
}
}
__device__ __forceinline__ void diff_unit(const Params& p, LAS unsigned char* lds, int b, int hd, int qpos0, int ntile_a, size_t yrow0, int scr_unit, BgConv& bg, int bid, int nb) {
    const bf16_t* Q = (const bf16_t*)(p.ws + WS_Q); const bf16_t* Kb = (const bf16_t*)(p.ws + WS_K); const bf16_t* VT = (const bf16_t*)(p.ws + WS_VT);
    const bf16_t* VTh = VT + ((size_t)b * 1024 + 512 + hd * 128) * SP;
    attd::MaskArgs ma{0, 0, nullptr};
    attd::f32x16 o[4]; float m, l;
    attd::attn_pass<128, 0, 0>(lds, Q + (size_t)(b * NQH + 8 + 2 * hd) * SP * 64, Kb + (size_t)(b * 16 + 8 + 2 * hd) * SP * 64, VTh, qpos0, 0, ntile_a, 0, 0, o, m, l, ma, nullptr, p, bg, bid, nb);
    { int t1 = threadIdx.x; asm volatile("" : "+v"(t1));
      float4* SCR = (float4*)(p.ws + WS_SCR) + ((size_t)(scr_unit * 8 + (t1 >> 6)) * 16) * 64 + (t1 & 63);
      float lt = l; { auto rr = __builtin_amdgcn_permlane32_swap(__float_as_uint(lt), __float_as_uint(lt), false, false); lt = __uint_as_float(rr[0]) + __uint_as_float(rr[1]); }
      const float il = 1.f / lt;
#pragma unroll
      for (int dt = 0; dt < 4; ++dt)
#pragma unroll
          for (int g = 0; g < 4; ++g) SCR[(dt * 4 + g) * 64] = make_float4(o[dt][4 * g] * il, o[dt][4 * g + 1] * il, o[dt][4 * g + 2] * il, o[dt][4 * g + 3] * il); }
    attd::attn_pass<128, 0, 0>(lds, Q + (size_t)(b * NQH + 8 + 2 * hd + 1) * SP * 64, Kb + (size_t)(b * 16 + 8 + 2 * hd + 1) * SP * 64, VTh, qpos0, 0, ntile_a, 0, 0, o, m, l, ma, nullptr, p, bg, bid, nb);
    int t2 = threadIdx.x; asm volatile("" : "+v"(t2));
    const int lane = t2 & 63, w = t2 >> 6, r32 = lane & 31, hi = lane >> 5;
    const float4* SCR = (const float4*)(p.ws + WS_SCR) + ((size_t)(scr_unit * 8 + w) * 16) * 64 + lane;
    const float lam = ((const float*)(p.ws + WS_SCAL))[0];
    float lt = l; { auto rr = __builtin_amdgcn_permlane32_swap(__float_as_uint(lt), __float_as_uint(lt), false, false); lt = __uint_as_float(rr[0]) + __uint_as_float(rr[1]); }
    const float il2 = lam / lt;
    float ss = 0.f;
#pragma unroll
    for (int dt = 0; dt < 4; ++dt)
#pragma unroll
        for (int g = 0; g < 4; ++g) {
            const float4 a = SCR[(dt * 4 + g) * 64];
            o[dt][4 * g] = a.x - o[dt][4 * g] * il2; o[dt][4 * g + 1] = a.y - o[dt][4 * g + 1] * il2; o[dt][4 * g + 2] = a.z - o[dt][4 * g + 2] * il2; o[dt][4 * g + 3] = a.w - o[dt][4 * g + 3] * il2;
            ss += o[dt][4 * g] * o[dt][4 * g] + o[dt][4 * g + 1] * o[dt][4 * g + 1] + o[dt][4 * g + 2] * o[dt][4 * g + 2] + o[dt][4 * g + 3] * o[dt][4 * g + 3];
        }
    { auto rr = __builtin_amdgcn_permlane32_swap(__float_as_uint(ss), __float_as_uint(ss), false, false); ss = __uint_as_float(rr[0]) + __uint_as_float(rr[1]); }
    const float sc = rsqrtf(ss * (1.f / 128.f) + RMS_EPS) * 0.8f;
    bf16_t* yrow = (bf16_t*)(p.ws + WS_Y) + (yrow0 + 32 * w + r32) * D + 512 + hd * 128;
#pragma unroll
    for (int dt = 0; dt < 4; ++dt)
#pragma unroll
        for (int g = 0; g < 4; ++g) {
            const int d0 = 32 * dt + 8 * g + 4 * hi;
            const float4 sw = *(const float4*)(p.subln + d0);
            uint2 wv; wv.x = attd::cvtpk(o[dt][4 * g] * sc * sw.x, o[dt][4 * g + 1] * sc * sw.y); wv.y = attd::cvtpk(o[dt][4 * g + 2] * sc * sw.z, o[dt][4 * g + 3] * sc * sw.w);
            *(uint2*)(yrow + d0) = wv;
        }
}
__device__ __forceinline__ void phase_attn0(const Params& p, int bid, int nb, unsigned char* smem) {
    LAS unsigned char* lds = (LAS unsigned char*)smem;
    const bf16_t* Q = (const bf16_t*)(p.ws + WS_Q); const bf16_t* Kb = (const bf16_t*)(p.ws + WS_K); const bf16_t* VT = (const bf16_t*)(p.ws + WS_VT);
    bf16_t* Y = (bf16_t*)(p.ws + WS_Y);
    constexpr int U_B = 256, U_A = 256, U_C = 16, U_D = 8;
    BgConv bg; bg.s = 0; bg.end = bid < BG_VB ? BG_SLOTS : 0; bg.fly = false; bg_seek(p, bg, bid);
    for (int u = bid; u < U_B; u += nb) {
        const int qb = u >> 3, hd = u & 3, b = (u >> 2) & 1;
        diff_unit(p, lds, b, hd, 256 + 256 * qb, SP / 64, (size_t)b * S + 256 * qb, u, bg, bid, nb);
    }
    for (int u2 = bid; u2 < U_A; u2 += nb) {
        int tid = threadIdx.x; asm volatile("" : "+v"(tid));
        const int lane = tid & 63, r32 = lane & 31, hi = lane >> 5; const int w = __builtin_amdgcn_readfirstlane(tid >> 6);
        const int qb = u2 & 15, h = (u2 >> 4) & 7, b = u2 >> 7;
        LAS float* biasL = (LAS float*)(lds + att::L_BIAS);
        for (int i = tid; i < 15 * 31; i += blockDim.x) biasL[i] = p.na_rpb[h * 465 + i] * att::LOG2E;
        const int r0 = 8 * qb;
        const int tb0 = 4 + min(max(r0 - 4, 0), 120), tb1 = 4 + min(max(r0 + 3, 0), 120) + 8;
        att::f32x16 o[2][2]; float m[2], l[2];
        att::attn_pass<64, 2>(lds, Q + (size_t)(b * NQH + h) * SP * 64, Kb + (size_t)(b * 16 + h) * SP * 64, VT + ((size_t)b * 1024 + h * 64) * SP, 256 + 512 * qb + 64 * w, 0, true, 0, 4, tb0, tb1 - tb0, o, m, l, r0 + w, biasL);
#pragma unroll
        for (int j = 0; j < 2; ++j) att::store_out(Y + ((size_t)b * S + 512 * qb + 64 * w + 32 * j + r32) * D + h * 64, o[j], 1.f / att::xhalf_sum(l[j]), hi);
    }
    for (int u2 = bid; u2 < U_C; u2 += nb) {
        int tid = threadIdx.x; asm volatile("" : "+v"(tid));
        const int lane = tid & 63, r32 = lane & 31, hi = lane >> 5; const int w = __builtin_amdgcn_readfirstlane(tid >> 6);
        const int h = u2 & 7, b = u2 >> 3;
        att::f32x16 o[2][2]; float m[2], l[2];
        att::attn_pass<64, 0>(lds, Q + (size_t)(b * NQH + h) * SP * 64, Kb + (size_t)(b * 16 + h) * SP * 64, VT + ((size_t)b * 1024 + h * 64) * SP, 64 * (w & 3), 0, w < 4, 0, 4, 0, 0, o, m, l, 0, nullptr);
        if (w < 4) {
#pragma unroll
            for (int j = 0; j < 2; ++j) att::store_out(Y + ((size_t)NLAT + b * CTX + 64 * w + 32 * j + r32) * D + h * 64, o[j], 1.f / att::xhalf_sum(l[j]), hi);
        }
    }
    for (int u2 = bid; u2 < U_D; u2 += nb) {
        const int hd = u2 & 3, b = u2 >> 2;
        diff_unit(p, lds, b, hd, 0, 4, (size_t)NLAT + b * CTX, U_B + u2, bg, bid, nb);
    }
    while (bg.s < bg.end) { bg_start(lds, bg); bg_finish(p, lds, bg, bid); }
    for (int vb = bid + nb; vb < BG_VB; vb += nb) { bg.s = 0; bg.end = BG_SLOTS; bg_seek(p, bg, vb); while (bg.s < bg.end) { bg_start(lds, bg); bg_finish(p, lds, bg, vb); } }
}
__device__ __forceinline__ void phase_attn1(const Params& p, int bid, int nb, unsigned char* smem) {
    LAS unsigned char* lds = (LAS unsigned char*)smem;
    const bf16_t* Q = (const bf16_t*)(p.ws + WS_Q); const bf16_t* Kb = (const bf16_t*)(p.ws + WS_K); const bf16_t* VT = (const bf16_t*)(p.ws + WS_VT);
    bf16_t* Y = (bf16_t*)(p.ws + WS_Y);
    for (int u = bid; u < 256; u += nb) {
        int tid = threadIdx.x; asm volatile("" : "+v"(tid));
        const int lane = tid & 63, r32 = lane & 31, hi = lane >> 5; const int w = __builtin_amdgcn_readfirstlane(tid >> 6);
        att::f32x16 o[2][2]; float m[2], l[2];
        const int xc = (u & 7) >> 1, idx = (u & 1) * 32 + (u >> 3);
        const int b = xc >> 1, qh = (xc & 1) * 4 + (idx >> 4), qb = idx & 15;
        att::attn_pass<64, 0, true>(lds, Q + (size_t)(b * NQH + qh) * SP * 64, Kb + (size_t)(b * 4 + (qh >> 2)) * SP * 64, VT + ((size_t)b * 256 + (qh >> 2) * 64) * SP, 256 + 512 * qb + 64 * w, 0, true, 0, SP / 64, 0, 0, o, m, l, 0, nullptr, p.q_norm, (const float2*)(p.ws + WS_ROPE));
#pragma unroll
        for (int j = 0; j < 2; ++j) att::store_out(Y + ((size_t)b * S + 512 * qb + 64 * w + 32 * j + r32) * D + qh * 64, o[j], 1.f / att::xhalf_sum(l[j]), hi);
    }
    for (int u2 = bid; u2 < 256; u2 += nb) {
        int tid = threadIdx.x; asm volatile("" : "+v"(tid));
        const int lane = tid & 63, r32 = lane & 31, hi = lane >> 5; const int w = __builtin_amdgcn_readfirstlane(tid >> 6);
        att::f32x16 o[2][2]; float m[2], l[2];
        const int qb = u2 & 15, qh = (u2 >> 4) & 7, b = u2 >> 7;
        const int t0 = 512 * qb;
        const int tb0 = 4 + max(t0 - 128, 0) / 64, tb1 = 4 + min(t0 + 511 + 128, S - 1) / 64 + 1;
        att::attn_pass<64, 1>(lds, Q + (size_t)(b * NQH + 8 + qh) * SP * 64, Kb + (size_t)(b * 4 + 2 + (qh >> 2)) * SP * 64, VT + ((size_t)b * 256 + 128 + (qh >> 2) * 64) * SP, 256 + t0 + 64 * w, 0, true, 0, 4, tb0, tb1 - tb0, o, m, l, 0, nullptr);
        const float sk = p.sink[qh] * att::LOG2E;
#pragma unroll
        for (int j = 0; j < 2; ++j) {
            const float lt = att::xhalf_sum(l[j]), ml2 = m[j];
            const float mn = fmaxf(ml2, sk), corr = __builtin_amdgcn_exp2f(ml2 - mn);
            const float den = lt * corr + __builtin_amdgcn_exp2f(sk - mn);
            att::store_out(Y + ((size_t)b * S + t0 + 64 * w + 32 * j + r32) * D + 512 + qh * 64, o[j], corr / den, hi);
        }
    }
}
#define XB_TMO      128
#define XB_XCNT(j)  (256  + 64 * (j))
#define XB_XSUB(j)  (1280 + 64 * (j))
#define XB_XGEN(j)  (2304 + 64 * (j))
#define XB_TOP      3328
#define XB_TOPGEN   3392
#define XCD_BAR_WORDS 3456
#define XB_SPIN_CAP (1u << 18)

__device__ __forceinline__ unsigned xb_ld(unsigned* p)              { return __hip_atomic_load(p, __ATOMIC_RELAXED, __HIP_MEMORY_SCOPE_AGENT); }
__device__ __forceinline__ unsigned xb_add(unsigned* p, unsigned v) { return __hip_atomic_fetch_add(p, v, __ATOMIC_RELAXED, __HIP_MEMORY_SCOPE_AGENT); }
__device__ __forceinline__ unsigned xb_xcc_id() { return (unsigned)__builtin_amdgcn_s_getreg((3 << 11) | 20) & 0xFu; }
#define XB_SPIN(cond, bar) do { unsigned _sp = 0; while (cond) { __builtin_amdgcn_s_sleep(1); \
    if ((++_sp & 255u) == 0u) { if (xb_ld(&(bar)[XB_TMO])) break; if (_sp > XB_SPIN_CAP) { atomicAdd(&(bar)[XB_TMO], 1u); break; } } } } while (0)

struct XcdBarrier {
    unsigned* bar; unsigned x;
    volatile LAS unsigned* st;
};

__device__ __forceinline__ XcdBarrier xcd_barrier_post(unsigned* bar, volatile LAS unsigned* st) {
    XcdBarrier b; b.bar = bar; b.x = xb_xcc_id(); b.st = st;
    if (threadIdx.x == 0) (void)xb_add(&bar[XB_XCNT(b.x)], 1u);
    return b;
}
__device__ __forceinline__ void xcd_barrier_complete(unsigned* bar, unsigned x, unsigned& nloc, unsigned& nx) {
    const unsigned G = gridDim.x * gridDim.y * gridDim.z;
    unsigned sum, cnt, mine, sp = 0u;
    for (;;) {
        sum = 0u; cnt = 0u; mine = 0u;
#pragma unroll
        for (unsigned j = 0; j < 16; ++j) { const unsigned c = xb_ld(&bar[XB_XCNT(j)]); sum += c; cnt += (c > 0u) ? 1u : 0u; mine = (j == x) ? c : mine; }
        if (sum == G) break;
        __builtin_amdgcn_s_sleep(1);
        if ((++sp & 255u) == 0u) { if (xb_ld(&bar[XB_TMO])) break; if (sp > XB_SPIN_CAP) { atomicAdd(&bar[XB_TMO], 1u); break; } }
    }
    nloc = mine > 0u ? mine : 1u; nx = cnt > 0u ? cnt : 1u;
}

__device__ __forceinline__ void xcd_barrier(const XcdBarrier& b) {
    asm volatile("s_waitcnt vmcnt(0)" ::: "memory");
    __syncthreads();
    if (threadIdx.x == 0) {
        unsigned* bar = b.bar;
        __builtin_amdgcn_s_waitcnt(0);
        unsigned nloc = b.st[0], nx = b.st[1];
        if (nloc == 0u) { xcd_barrier_complete(bar, b.x, nloc, nx); b.st[0] = nloc; b.st[1] = nx; }
        const unsigned old = xb_add(&bar[XB_XSUB(b.x)], 1u);
        const unsigned gen = old / nloc;
        if (old + 1u == (gen + 1u) * nloc) {
            __builtin_amdgcn_fence(__ATOMIC_RELEASE, "agent");
            asm volatile("s_waitcnt vmcnt(0)" ::: "memory");
            const unsigned og = xb_add(&bar[XB_TOP], 1u);
            const unsigned tg = og / nx;
            if (og + 1u == (tg + 1u) * nx) xb_add(&bar[XB_TOPGEN], 1u);
            else XB_SPIN(xb_ld(&bar[XB_TOPGEN]) == tg, bar);
            __builtin_amdgcn_fence(__ATOMIC_ACQUIRE, "agent");
            xb_add(&bar[XB_XGEN(b.x)], 1u);
            asm volatile("s_waitcnt vmcnt(0)" ::: "memory");
        } else {
            XB_SPIN(xb_ld(&bar[XB_XGEN(b.x)]) == gen, bar);
            __builtin_amdgcn_fence(__ATOMIC_ACQUIRE, "agent");
            asm volatile("s_waitcnt vmcnt(0)" ::: "memory");
        }
    }
    __syncthreads();
}

constexpr int NPHASE = 2 + 9 * 2;
constexpr int NTH = 512;
constexpr int PROBE_DUP = -1;
constexpr int CTL_BAR_WORD = 4096;
constexpr int CTL_BYTES = 65536;
template <bool COOP>
__global__ void __launch_bounds__(NTH, 2) fwd_kernel(Params p, int lo, int hi) {
    extern __shared__ __attribute__((aligned(16))) unsigned char smem[];
    const int bid = blockIdx.x, nb = gridDim.x;
    XcdBarrier bar; bar.bar = nullptr; bar.x = 0; bar.st = nullptr;
    if (COOP) {
        volatile LAS unsigned* st = (volatile LAS unsigned*)((LAS unsigned char*)smem + LDS_MISC + 2048);
        if (threadIdx.x < 2) st[threadIdx.x] = 0u;
        __syncthreads();
        if (bid == 0) { uint4* z = (uint4*)(p.ws + WS_CTL); for (int i = threadIdx.x; i < CTL_BYTES / 16; i += NTH) z[i] = make_uint4(0u, 0u, 0u, 0u); }
    }
#define SEAM(k) do { if (COOP) { if ((k) == 0) { cg::this_grid().sync(); bar = xcd_barrier_post((unsigned*)(p.ws + WS_CTL) + CTL_BAR_WORD, (volatile LAS unsigned*)((LAS unsigned char*)smem + LDS_MISC + 2048)); } else xcd_barrier(bar); } } while (0)
#define RUN(k, stmt) if (lo <= (k) && (k) < hi) { stmt; if (PROBE_DUP == (k)) { SEAM(1); stmt; } if ((k) + 1 < hi) SEAM(k); }
    RUN(0, phase_pre(p, bid, nb, smem))
    RUN(1, phase_h0(p, bid, nb))
    RUN(2, phase_qkv(p, 0, bid, nb, smem))
    RUN(4, phase_attn0(p, bid, nb, smem))
    RUN(5, { phase_oproj(p, 0, bid, nb, smem); phase_ln1(p, 0, bid, nb, smem); })
    RUN(8, phase_moe1(p, 0, bid, nb, smem))
    RUN(9, phase_moe2(p, 0, bid, nb, smem))
    RUN(10, phase_ln2(p, 0, bid, nb))
    RUN(11, phase_qkv(p, 1, bid, nb, smem))
    RUN(12, phase_knorm(p, bid, nb))
    RUN(13, phase_attn1(p, bid, nb, smem))
    RUN(14, { phase_oproj(p, 1, bid, nb, smem); phase_ln1(p, 1, bid, nb, smem); })
    RUN(17, phase_moe1(p, 1, bid, nb, smem))
    RUN(18, phase_moe2(p, 1, bid, nb, smem))
    RUN(19, phase_ln2(p, 1, bid, nb))
#undef RUN
#undef SEAM
}

extern "C" void kernel_launch(void* const* d_in, const int* in_sizes, int n_in, void* d_out, int out_size, void* d_ws, size_t ws_size, hipStream_t stream) {
    static int grid = 0;
    if (grid == 0) {
        if (n_in != 29 || ws_size < WS_END) { fprintf(stderr, "kernel_launch: unexpected n_in %d / ws %zu (need %zu)\n", n_in, ws_size, (size_t)WS_END); grid = -1; return; }
        int dev = 0, cus = 0, per_cu = 0;
        (void)hipGetDevice(&dev); (void)hipDeviceGetAttribute(&cus, hipDeviceAttributeMultiprocessorCount, dev);
        if (hipFuncSetAttribute((const void*)fwd_kernel<true>, hipFuncAttributeMaxDynamicSharedMemorySize, LDS_TOTAL) != hipSuccess) { fprintf(stderr, "kernel_launch: hipFuncSetAttribute failed\n"); grid = -1; return; }
        if (hipOccupancyMaxActiveBlocksPerMultiprocessor(&per_cu, (const void*)fwd_kernel<true>, NTH, LDS_TOTAL) != hipSuccess || per_cu < 1) { fprintf(stderr, "kernel_launch: occupancy query says %d\n", per_cu); per_cu = 1; }
        grid = cus;
        (void)hipGetLastError();
    }
    if (grid < 0) return;
    Params p{};
    const float* const* in = (const float* const*)d_in;
    p.x = in[0]; p.c = in[1]; p.ctx = in[2]; p.c_ctx = in[3]; p.mod_w = in[4]; p.mod_b = in[5]; p.ln1_g = in[6]; p.ln1_b = in[7]; p.ln2_g = in[8]; p.ln2_b = in[9];
    p.router_w = in[10]; p.router_b = in[11]; p.moe_w_in = in[12]; p.moe_b_in = in[13]; p.moe_w_out = in[14]; p.moe_b_out = in[15]; p.ab_w_in = in[16]; p.ab_w_out = in[17];
    p.na_rpb = in[18]; p.lq1 = in[19]; p.lk1 = in[20]; p.lq2 = in[21]; p.lk2 = in[22]; p.subln = in[23]; p.cd_w_in = in[24]; p.cd_w_out = in[25]; p.q_norm = in[26]; p.k_norm = in[27]; p.sink = in[28];
    p.out = (float*)d_out; p.ws = (unsigned char*)d_ws;
    int lo = 0, hi = NPHASE;
    void* args[] = {(void*)&p, (void*)&lo, (void*)&hi};
    hipError_t e = hipLaunchCooperativeKernel((const void*)fwd_kernel<true>, dim3(grid), dim3(NTH), args, LDS_TOTAL, stream);
    if (e != hipSuccess) fprintf(stderr, "kernel_launch: cooperative launch failed: %s (grid %d)\n", hipGetErrorString(e), grid);
}
```

```cpp
#include <hip/hip_runtime.h>
#include <hip/hip_cooperative_groups.h>
#include <cstdio>
#include <cstdint>
namespace cg = cooperative_groups;

typedef unsigned short bf16_t;

constexpr int D = 1024, NB = 2, S = 8192, NLAT = NB * S, CTX = 256, NCTX = NB * CTX, NTOK = NLAT + NCTX;
constexpr int SP = S + CTX;
constexpr int NE = 32, TOPK = 4;
constexpr int CNT_STRIDE = 32;
constexpr int MAXSLOT = (NTOK * TOPK / 256 + NE) * 256;
constexpr int NQH = 16;
constexpr float ALPHA = 1.41421356237309515f;
constexpr float LN_EPS = 1e-5f, RMS_EPS = 1e-6f, SCALE = 0.125f;
constexpr float SW_LIMIT = 7.0f, SW_ALPHA = 1.702f;
constexpr float W8O_SCALE = 128.0f, ACT8_SCALE = 4.0f;
constexpr float WQKV8_SCALE = 64.0f, WO8_SCALE = 128.0f, Y8_SCALE = 64.0f;
constexpr float YP8_SCALE = 16.0f;
constexpr float W8_SCALE = 64.0f;

constexpr size_t MiB = 1ull << 20;
constexpr size_t WS_CTL = 0;
constexpr size_t WS_MOD = 1 * MiB;
constexpr size_t WS_SCAL = 2 * MiB;
constexpr size_t WS_ROPE = 3 * MiB;
constexpr size_t WS_PAIR = 6 * MiB;
constexpr size_t WS_SLOTG = 8 * MiB;
constexpr size_t WS_H = 10 * MiB;
constexpr size_t WS_Q = 150 * MiB;
constexpr size_t WS_K = 186 * MiB;
constexpr size_t WS_VT = 222 * MiB;
constexpr size_t WS_Y = 258 * MiB;
constexpr size_t WS_YO = 294 * MiB;
constexpr size_t WS_X1 = 364 * MiB;
constexpr size_t WS_X2 = 434 * MiB;
constexpr size_t WS_TOK = 504 * MiB;
constexpr size_t WS_XB = 540 * MiB;
constexpr size_t WS_ACT = 696 * MiB;
constexpr size_t WS_YP = 852 * MiB;
constexpr size_t WS_SCR = 1008 * MiB;
constexpr size_t WS_WT_ABIN = WS_H + 66 * 262144;
constexpr size_t WS_WT_ABOUT = 1054 * MiB;
constexpr size_t WS_WT_CDIN = WS_H + 78 * 262144;
constexpr size_t WS_WT_CDOUT = 1059 * MiB;
constexpr size_t WS_WT_MIN = 1062 * MiB;
constexpr size_t WS_WT_MOUT = 1318 * MiB;
constexpr size_t WS_END = 1446 * MiB;

struct Params {
    const float *x, *c, *ctx, *c_ctx, *mod_w, *mod_b, *ln1_g, *ln1_b, *ln2_g, *ln2_b, *router_w, *router_b;
    const float *moe_w_in, *moe_b_in, *moe_w_out, *moe_b_out, *ab_w_in, *ab_w_out, *na_rpb;
    const float *lq1, *lk1, *lq2, *lk2, *subln, *cd_w_in, *cd_w_out, *q_norm, *k_norm, *sink;
    float* out;
    unsigned char* ws;
};

__device__ __forceinline__ float bf2f(unsigned v) { return __uint_as_float(v << 16); }
__device__ __forceinline__ unsigned f2bf(float f) { unsigned u = __float_as_uint(f); return (u + 0x7fffu + ((u >> 16) & 1u)) >> 16; }
__device__ __forceinline__ unsigned pk2(float lo, float hi) { return f2bf(lo) | (f2bf(hi) << 16); }
template <int CTRL> __device__ __forceinline__ float dpp_xadd(float v) { const int t = __builtin_amdgcn_update_dpp(0, __float_as_int(v), CTRL, 0xf, 0xf, true); return v + __int_as_float(t); }
__device__ __forceinline__ float wave_sum(float v) {
    v = dpp_xadd<0xB1>(v); v = dpp_xadd<0x4E>(v); v = dpp_xadd<0x141>(v); v = dpp_xadd<0x140>(v);
    v += __int_as_float(__builtin_amdgcn_ds_swizzle(__float_as_int(v), 0x401f));
    auto rr = __builtin_amdgcn_permlane32_swap(__float_as_uint(v), __float_as_uint(v), false, false);
    return __uint_as_float(rr[0]) + __uint_as_float(rr[1]);
}
typedef float f2v __attribute__((ext_vector_type(2)));
__device__ __forceinline__ float silu_f(float v) { return v / (1.f + __expf(-v)); }
#define LAS __attribute__((address_space(3)))
typedef float float4v __attribute__((ext_vector_type(4)));

namespace pg8 {
#define PG8_LAS __attribute__((address_space(3)))
typedef unsigned short bf16_t;
typedef short bf16x8 __attribute__((ext_vector_type(8)));
typedef float f32x4 __attribute__((ext_vector_type(4)));
typedef unsigned u32x4 __attribute__((ext_vector_type(4)));
constexpr int BM = 256, BK = 64, HALF = 128, HTB = HALF * BK * 2  , STAGE_BYTES = 8 * HTB, NXCD = 8, WGM = 8;

__host__ __device__ __forceinline__ int lds_byte(int r, int c) { const int st = (r >> 4) * 2 + (c >> 5), rr = r & 15, cc = c & 31, ob = rr * 64 + cc * 2; return st * 1024 + (ob ^ (((ob >> 9) & 1) << 5)); }
__host__ __device__ __forceinline__ void stage_rc(int b, int& R, int& C) { const int st = b / 1024, sb = b % 1024, swz = sb ^ (((sb >> 9) & 1) << 5); R = (st >> 1) * 16 + swz / 64; C = (st & 1) * 32 + (swz % 64) / 2; }
__host__ __device__ __forceinline__ int perm32(int rho) { const int n = rho >> 4, i = rho & 15; return 8 * (i >> 2) + 4 * n + (i & 3); }

struct Unit { int pm, pn; };
struct Gemm { const bf16_t* A; const bf16_t* Bt; int M, N, K; const int* arow; };

struct StaticOrder {
    int nM, nN, nwg, G, c;
    __host__ __device__ void init(int M, int N, int G_, int c_) { nM = M / BM; nN = N / BM; nwg = nM * nN; G = G_; c = c_; }
    __host__ __device__ bool next(int i, Unit& u) const {
        const long L = (long)i * G + c; if (L >= nwg) return false;
        int wgid = (int)L; { const int q = nwg / NXCD, r = nwg % NXCD, xcd = wgid % NXCD, off = wgid / NXCD; wgid = (xcd < r ? xcd * (q + 1) : r * (q + 1) + (xcd - r) * q) + off; }
        const int nig = WGM * nN, gid = wgid / nig, fm = gid * WGM, gsz = (nM - fm) < WGM ? (nM - fm) : WGM;
        u.pm = fm + ((wgid % nig) % gsz); u.pn = (wgid % nig) / gsz; return true;
    }
    __device__ __forceinline__ void a_ready(const Unit&) const {}
    __device__ __forceinline__ void done(const Unit&) const {}
};

typedef int v8i_t __attribute__((ext_vector_type(8)));
typedef int v4i_t __attribute__((ext_vector_type(4)));
__device__ __forceinline__ v8i_t cat8(bf16x8 a, bf16x8 b) { const v4i_t x = __builtin_bit_cast(v4i_t, a), y = __builtin_bit_cast(v4i_t, b); return __builtin_shufflevector(x, y, 0, 1, 2, 3, 4, 5, 6, 7); }
template <bool FP8>
__device__ __forceinline__ void mma_block(f32x4 (&c)[4][2], const bf16x8 (&At)[4][2], const bf16x8 (&Bt)[2][2], const v8i_t (&a8)[4], const v8i_t (&b8)[2]) {
    if constexpr (FP8) {
#pragma unroll
        for (int m = 0; m < 4; ++m)
#pragma unroll
            for (int n = 0; n < 2; ++n)
                asm volatile("s_nop 1\n\tv_mfma_f32_16x16x128_f8f6f4 %0, %1, %2, %0" : "+v"(c[m][n]) : "v"(b8[n]), "v"(a8[m]));
    } else {
#pragma unroll
        for (int m = 0; m < 4; ++m)
#pragma unroll
            for (int n = 0; n < 2; ++n)
#pragma unroll
                for (int k = 0; k < 2; ++k) c[m][n] = __builtin_amdgcn_mfma_f32_16x16x32_bf16(Bt[n][k], At[m][k], c[m][n], 0, 0, 0);
    }
}
template <class Epi, class Sched, bool ALIGN_EPI = false, bool SP2 = false, bool FP8 = false, bool GATHER = false>
__device__ __forceinline__ void gemm_phase(PG8_LAS unsigned char* lds, const Gemm g, const Sched& S, const Epi& E) {
    int tid_ = threadIdx.x; asm volatile("" : "+v"(tid_));
    const int tid = tid_, wid = __builtin_amdgcn_readfirstlane(tid >> 6), lane = tid & 63, wr = wid >> 2, wc = wid & 3, fr = lane & 15, fq = lane >> 4;
    const int K = g.K, nt = K / BK;
    unsigned voffA[2], voffB[2];
#pragma unroll
    for (int i = 0; i < 2; ++i) { int R, C; stage_rc(tid * 16 + i * 8192, R, C); const int Rb = Epi::PERM ? ((R & ~31) + perm32(R & 31)) : R;
        voffA[i] = (unsigned)(R * K + C) * 2u; voffB[i] = (unsigned)(Rb * K + C) * 2u; }
    const size_t kstep = (size_t)(BK * 2);
    const size_t hstep = (size_t)HALF * K * 2;
    const size_t tstep = 2 * hstep;
    const unsigned ldsw = (unsigned)wid * 1024u;
    const int aoff = lds_byte(wr * 64 + fr, fq * 8), boff = lds_byte(wc * 32 + fr, fq * 8);
#define PG8_SA(b, h) (((b) * 2 + (h)) * HTB)
#define PG8_SB(b, h) ((4 + (b) * 2 + (h)) * HTB)
#define PG8_STAGE(bufoff, gbase, voff) do { _Pragma("unroll") for (int _i = 0; _i < 2; ++_i) \
        __builtin_amdgcn_global_load_lds((const unsigned*)((const char*)(gbase) + (voff)[_i]), (PG8_LAS unsigned*)(lds + (bufoff) + ldsw + _i * 8192), 16, 0, 0); } while (0)
#define PG8_STAGE_A(bufoff, gbase, HALF_, NEXT_) do { if constexpr (GATHER) { _Pragma("unroll") for (int _i = 0; _i < 2; ++_i) \
        __builtin_amdgcn_global_load_lds((const unsigned*)((const char*)(gbase) + ((NEXT_) ? gN[HALF_][_i] : gC[HALF_][_i])), (PG8_LAS unsigned*)(lds + (bufoff) + ldsw + _i * 8192), 16, 0, 0); } \
    else { PG8_STAGE(bufoff, (gbase) + ((HALF_) ? hstep : 0), voffA); } } while (0)
#define PG8_LDA(dst, b, h) do { if constexpr (FP8) { _Pragma("unroll") for (int m = 0; m < 4; ++m) dst##8[m] = cat8(*(const PG8_LAS bf16x8*)(lds + PG8_SA(b, h) + aoff + m * 2048), *(const PG8_LAS bf16x8*)(lds + PG8_SA(b, h) + aoff + m * 2048 + 1024)); } \
        else { _Pragma("unroll") for (int m = 0; m < 4; ++m) _Pragma("unroll") for (int k = 0; k < 2; ++k) dst[m][k] = *(const PG8_LAS bf16x8*)(lds + PG8_SA(b, h) + aoff + m * 2048 + k * 1024); } } while (0)
#define PG8_LDB(dst, b, h) do { if constexpr (FP8) { _Pragma("unroll") for (int n = 0; n < 2; ++n) dst##8[n] = cat8(*(const PG8_LAS bf16x8*)(lds + PG8_SB(b, h) + boff + n * 2048), *(const PG8_LAS bf16x8*)(lds + PG8_SB(b, h) + boff + n * 2048 + 1024)); } \
        else { _Pragma("unroll") for (int n = 0; n < 2; ++n) _Pragma("unroll") for (int k = 0; k < 2; ++k) dst[n][k] = *(const PG8_LAS bf16x8*)(lds + PG8_SB(b, h) + boff + n * 2048 + k * 1024); } } while (0)
#define PG8_MMA(ai, bj, At, Bt) do { __builtin_amdgcn_s_setprio(1); mma_block<FP8>(acc[ai][bj], At, Bt, At##8, Bt##8); __builtin_amdgcn_s_setprio(0); } while (0)
#define PG8_WAIT_V(n) asm volatile("s_waitcnt vmcnt(" #n ")" ::: "memory")
#define PG8_WAIT_L(n) asm volatile("s_waitcnt lgkmcnt(" #n ")" ::: "memory")
#define PG8_BAR __builtin_amdgcn_s_barrier()
#define PG8_SCHED __builtin_amdgcn_sched_barrier(0)
    Unit cur, nxt; int ui = 0;
    if (!S.next(0, cur)) return;
    static_assert(!GATHER || SP2, "GATHER is wired into the SP2 loop only");
    unsigned gC[2][2] = {{0u, 0u}, {0u, 0u}}, gN[2][2] = {{0u, 0u}, {0u, 0u}}; int gR[2] = {0, 0}; unsigned gCc[2] = {0u, 0u};
    if constexpr (GATHER) {
#pragma unroll
        for (int i = 0; i < 2; ++i) { int R, C; stage_rc(tid * 16 + i * 8192, R, C); gR[i] = R; gCc[i] = (unsigned)C * 2u; }
#pragma unroll
        for (int h = 0; h < 2; ++h)
#pragma unroll
            for (int i = 0; i < 2; ++i) gC[h][i] = (unsigned)g.arow[S.aoff(cur.pm) + cur.pm * BM + h * HALF + gR[i]] * (unsigned)(K * 2) + gCc[i];
        asm volatile("s_waitcnt vmcnt(0)" ::: "memory"); asm volatile("" : "+v"(gC[0][0]), "+v"(gC[0][1]), "+v"(gC[1][0]), "+v"(gC[1][1]));
    }
    f32x4 acc[2][2][4][2];
#pragma unroll
    for (int a = 0; a < 2; ++a)
#pragma unroll
        for (int b = 0; b < 2; ++b)
#pragma unroll
            for (int m = 0; m < 4; ++m)
#pragma unroll
                for (int n = 0; n < 2; ++n) acc[a][b][m][n] = (f32x4){0.f, 0.f, 0.f, 0.f};
    bf16x8 At[4][2], B0[2][2], B1[2][2]; v8i_t At8[4], B08[2], B18[2];
    const char* cA = (const char*)g.A + (GATHER ? (size_t)0 : (size_t)cur.pm * tstep); const char* cB = (const char*)g.Bt + (size_t)cur.pn * tstep;
    S.a_ready(cur);
    if constexpr (SP2) {
        PG8_STAGE(PG8_SB(0, 0), cB, voffB); PG8_STAGE(PG8_SB(0, 1), cB + hstep, voffB); PG8_STAGE_A(PG8_SA(0, 0), cA, 0, false); PG8_STAGE_A(PG8_SA(0, 1), cA, 1, false);
        if (wr == 1) PG8_BAR;
        PG8_WAIT_V(2); PG8_BAR;
        PG8_STAGE(PG8_SB(1, 0), cB + kstep, voffB); PG8_STAGE_A(PG8_SA(1, 0), cA + kstep, 0, false); PG8_STAGE(PG8_SB(1, 1), cB + hstep + kstep, voffB);
        PG8_WAIT_V(6); PG8_BAR;
    } else {
        PG8_STAGE(PG8_SB(0, 0), cB, voffB); PG8_STAGE(PG8_SA(0, 0), cA, voffA); PG8_STAGE(PG8_SB(0, 1), cB + hstep, voffB); PG8_STAGE(PG8_SA(0, 1), cA + hstep, voffA);
        if (wr == 1) PG8_BAR;
        PG8_WAIT_V(4); PG8_BAR;
        PG8_STAGE(PG8_SB(1, 0), cB + kstep, voffB); PG8_STAGE(PG8_SA(1, 0), cA + kstep, voffA); PG8_STAGE(PG8_SB(1, 1), cB + hstep + kstep, voffB);
        PG8_WAIT_V(6); PG8_BAR;
    }
    for (;;) {
        const bool has_next = S.next(ui + 1, nxt);
        const char* nA = (has_next && !GATHER) ? (const char*)g.A + (size_t)nxt.pm * tstep : cA; const char* nB = has_next ? (const char*)g.Bt + (size_t)nxt.pn * tstep : cB;
        if constexpr (GATHER) {
            const int npm = has_next ? nxt.pm : cur.pm;
#pragma unroll
            for (int h = 0; h < 2; ++h)
#pragma unroll
                for (int i = 0; i < 2; ++i) gN[h][i] = (unsigned)g.arow[S.aoff(npm) + npm * BM + h * HALF + gR[i]] * (unsigned)(K * 2) + gCc[i];
            asm volatile("s_waitcnt vmcnt(0)" ::: "memory"); asm volatile("" : "+v"(gN[0][0]), "+v"(gN[0][1]), "+v"(gN[1][0]), "+v"(gN[1][1]));
        }
        for (int t = 0; t < nt; t += 2) {
            const bool last = (t == nt - 2);
            const char* a1 = cA + (size_t)(t + 1) * kstep;
            const char* a2 = last ? nA : cA + (size_t)(t + 2) * kstep; const char* b2 = last ? nB : cB + (size_t)(t + 2) * kstep;
            const char* a3 = a2 + kstep; const char* b3 = b2 + kstep;
            if (last && has_next) S.a_ready(nxt);
            if constexpr (SP2) {
            PG8_LDB(B0, 0, 0); PG8_LDB(B1, 0, 1); PG8_SCHED; PG8_LDA(At, 0, 0); PG8_STAGE_A(PG8_SA(1, 1), a1, 1, false);
            PG8_WAIT_V(8); PG8_WAIT_L(0); PG8_BAR; PG8_MMA(0, 0, At, B0); PG8_MMA(0, 1, At, B1); PG8_BAR; PG8_SCHED;
            PG8_LDA(At, 0, 1); PG8_STAGE(PG8_SB(0, 0), b2, voffB); PG8_STAGE(PG8_SB(0, 1), b2 + hstep, voffB); PG8_STAGE_A(PG8_SA(0, 0), a2, 0, last);
            PG8_WAIT_V(8); PG8_WAIT_L(0); PG8_BAR; PG8_MMA(1, 0, At, B0); PG8_MMA(1, 1, At, B1); PG8_BAR; PG8_SCHED;
            PG8_LDB(B0, 1, 0); PG8_LDB(B1, 1, 1); PG8_SCHED; PG8_LDA(At, 1, 0); PG8_STAGE_A(PG8_SA(0, 1), a2, 1, last);
            PG8_WAIT_V(8); PG8_WAIT_L(0); PG8_BAR; PG8_MMA(0, 0, At, B0); PG8_MMA(0, 1, At, B1); PG8_BAR; PG8_SCHED;
            PG8_LDA(At, 1, 1); PG8_STAGE(PG8_SB(1, 0), b3, voffB); PG8_STAGE(PG8_SB(1, 1), b3 + hstep, voffB); PG8_STAGE_A(PG8_SA(1, 0), a3, 0, last);
            PG8_WAIT_V(8); PG8_WAIT_L(0); PG8_BAR; PG8_MMA(1, 0, At, B0); PG8_MMA(1, 1, At, B1); PG8_BAR; PG8_SCHED;
            } else {
            PG8_LDB(B0, 0, 0); PG8_SCHED; PG8_LDA(At, 0, 0); PG8_STAGE(PG8_SA(1, 1), a1 + hstep, voffA);
            PG8_WAIT_L(8); PG8_BAR; PG8_WAIT_L(0); PG8_MMA(0, 0, At, B0); PG8_BAR; PG8_SCHED;
            PG8_LDB(B1, 0, 1); PG8_STAGE(PG8_SB(0, 0), b2, voffB);
            PG8_BAR; PG8_WAIT_L(0); PG8_MMA(0, 1, At, B1); PG8_BAR;
            PG8_LDA(At, 0, 1); PG8_STAGE(PG8_SA(0, 0), a2, voffA);
            PG8_BAR; PG8_WAIT_L(0); PG8_MMA(1, 0, At, B0); PG8_BAR; PG8_SCHED;
            PG8_STAGE(PG8_SB(0, 1), b2 + hstep, voffB);
            PG8_WAIT_V(6); PG8_BAR; PG8_MMA(1, 1, At, B1); PG8_BAR;
            PG8_LDB(B0, 1, 0); PG8_SCHED; PG8_LDA(At, 1, 0); PG8_STAGE(PG8_SA(0, 1), a2 + hstep, voffA);
            PG8_WAIT_L(8); PG8_BAR; PG8_WAIT_L(0); PG8_MMA(0, 0, At, B0); PG8_BAR; PG8_SCHED;
            PG8_LDB(B1, 1, 1); PG8_STAGE(PG8_SB(1, 0), b3, voffB);
            PG8_BAR; PG8_WAIT_L(0); PG8_MMA(0, 1, At, B1); PG8_BAR;
            PG8_LDA(At, 1, 1); PG8_STAGE(PG8_SA(1, 0), a3, voffA);
            PG8_BAR; PG8_WAIT_L(0); PG8_MMA(1, 0, At, B0); PG8_BAR; PG8_SCHED;
            PG8_STAGE(PG8_SB(1, 1), b3 + hstep, voffB);
            PG8_WAIT_V(6); PG8_BAR; PG8_MMA(1, 1, At, B1); PG8_BAR;
            }
        }
        if constexpr (ALIGN_EPI) { if (wr == 0) PG8_BAR; }
        if constexpr (!Epi::AFTER_DRAIN) { E(acc, cur, wr, wc, fr, fq); S.done(cur); }
        if (!has_next) break;
#pragma unroll
        for (int a = 0; a < 2; ++a)
#pragma unroll
            for (int b = 0; b < 2; ++b)
#pragma unroll
                for (int m = 0; m < 4; ++m)
#pragma unroll
                    for (int n = 0; n < 2; ++n) acc[a][b][m][n] = (f32x4){0.f, 0.f, 0.f, 0.f};
        cur = nxt; cA = nA; cB = nB; ++ui;
        if constexpr (GATHER) { gC[0][0] = gN[0][0]; gC[0][1] = gN[0][1]; gC[1][0] = gN[1][0]; gC[1][1] = gN[1][1]; }
        if constexpr (ALIGN_EPI) { if (wr == 1) PG8_BAR; }
    }
    PG8_WAIT_V(0);
    if constexpr (!ALIGN_EPI) { if (wr == 0) PG8_BAR; }
    PG8_BAR;
    if constexpr (Epi::AFTER_DRAIN) { E.fused(acc, cur, wr, wc, fr, fq, lds, wid, lane); S.done(cur); }
#undef PG8_SA
#undef PG8_SB
#undef PG8_STAGE
#undef PG8_STAGE_A
#undef PG8_LDA
#undef PG8_LDB
#undef PG8_MMA
#undef PG8_WAIT_V
#undef PG8_WAIT_L
#undef PG8_BAR
#undef PG8_SCHED
}
}
__device__ __forceinline__ unsigned pk4_fp8(float a, float b, float c, float d) { int r = __builtin_amdgcn_cvt_pk_fp8_f32(a, b, 0, false); r = __builtin_amdgcn_cvt_pk_fp8_f32(c, d, r, true); return (unsigned)r; }

constexpr int FLAG_WORD = 8192;
constexpr int ECAP = NTOK;
constexpr int TOFF_AT = 700, PSTART_AT = 330, CNT_AT = 364;
constexpr int NTH_ = 512;
constexpr bool PROBE_DUP_MOE2 = false;
namespace pg8 {
__device__ __forceinline__ unsigned cvt_pk_bf16(float lo, float hi) { unsigned r; asm volatile("v_cvt_pk_bf16_f32 %0, %1, %2" : "=v"(r) : "v"(lo), "v"(hi)); return r; }

struct EpiStoreBf16 {
    static constexpr bool PERM = true, AFTER_DRAIN = false;
    bf16_t* O; int ldc;
    __device__ __forceinline__ void operator()(const f32x4 (&acc)[2][2][4][2], const Unit& u, int wr, int wc, int fr, int fq) const {
        const int row0 = u.pm * BM + wr * 64 + fr, col0 = u.pn * BM + wc * 32 + 8 * fq;
#pragma unroll
        for (int ai = 0; ai < 2; ++ai)
#pragma unroll
            for (int m = 0; m < 4; ++m) { bf16_t* rowp = O + (size_t)(row0 + ai * HALF + m * 16) * ldc + col0;
#pragma unroll
                for (int bj = 0; bj < 2; ++bj) { const f32x4 v0 = acc[ai][bj][m][0], v1 = acc[ai][bj][m][1];
                    u32x4 w; w.x = cvt_pk_bf16(v0[0], v0[1]); w.y = cvt_pk_bf16(v0[2], v0[3]); w.z = cvt_pk_bf16(v1[0], v1[1]); w.w = cvt_pk_bf16(v1[2], v1[3]);
                    *(u32x4*)(rowp + bj * HALF) = w; } }
    }
};
struct EpiStoreF32 {
    static constexpr bool PERM = false, AFTER_DRAIN = false;
    float* O; int ldc; float wsc;
    __device__ __forceinline__ void operator()(const f32x4 (&acc)[2][2][4][2], const Unit& u, int wr, int wc, int fr_in, int fq_in) const {
        int fr = fr_in, fq = fq_in; asm volatile("s_nop 15\n\ts_nop 15" : "+v"(fr), "+v"(fq)); __builtin_amdgcn_sched_barrier(0);
        const int row0 = u.pm * BM + wr * 64 + fr, col0 = u.pn * BM + wc * 32 + 4 * fq;
#pragma unroll
        for (int ai = 0; ai < 2; ++ai)
#pragma unroll
            for (int m = 0; m < 4; ++m) { float* rowp = O + (size_t)(row0 + ai * HALF + m * 16) * ldc + col0;
#pragma unroll
                for (int bj = 0; bj < 2; ++bj)
#pragma unroll
                    for (int n = 0; n < 2; ++n) *(f32x4*)(rowp + bj * HALF + n * 16) = acc[ai][bj][m][n] * wsc; }
    }
};
typedef float f32x2v __attribute__((ext_vector_type(2)));
__device__ __forceinline__ f32x2v swiglu2(f32x2v g, f32x2v u) {
    g[0] = fminf(g[0], SW_LIMIT); g[1] = fminf(g[1], SW_LIMIT);
    u[0] = fminf(fmaxf(u[0], -SW_LIMIT), SW_LIMIT); u[1] = fminf(fmaxf(u[1], -SW_LIMIT), SW_LIMIT);
    const f32x2v t = g * (-SW_ALPHA * 1.4426950408889634f);
    f32x2v e; e[0] = __builtin_amdgcn_exp2f(t[0]); e[1] = __builtin_amdgcn_exp2f(t[1]);
    const f32x2v d = e + 1.0f;
    f32x2v r; r[0] = __builtin_amdgcn_rcpf(d[0]); r[1] = __builtin_amdgcn_rcpf(d[1]);
    return (g * r) * (u * ACT8_SCALE + ACT8_SCALE);
}
__device__ __forceinline__ float swiglu1(float g, float u) {
    g = fminf(g, SW_LIMIT); u = fminf(fmaxf(u, -SW_LIMIT), SW_LIMIT);
    return g * __builtin_amdgcn_rcpf(1.f + __builtin_amdgcn_exp2f(-SW_ALPHA * 1.4426950408889634f * g)) * (u + 1.f);
}
struct EpiMoe1 {
    static constexpr bool PERM = true, AFTER_DRAIN = false;
    bf16_t* ACT; const float* b_in; float wsc;
    __device__ __forceinline__ void operator()(const f32x4 (&acc)[2][2][4][2], const Unit& u, int wr, int wc, int fr, int fq) const {
        int fr_ = fr, fq_ = fq; asm volatile("s_nop 15\n\ts_nop 15" : "+v"(fr_), "+v"(fq_)); __builtin_amdgcn_sched_barrier(0);
        const int e = u.pn >> 3, pnl = u.pn & 7;
        const int row0 = u.pm * BM + wr * 64 + fr_, c0 = pnl * 128 + wc * 32 + 8 * fq_;
        f32x4 bg[2], bu[2];
#pragma unroll
        for (int n = 0; n < 2; ++n) { bg[n] = *(const f32x4*)(b_in + e * 2048 + c0 + 4 * n); bu[n] = *(const f32x4*)(b_in + e * 2048 + 1024 + c0 + 4 * n); }
#pragma unroll
        for (int ai = 0; ai < 2; ++ai)
#pragma unroll
            for (int m = 0; m < 4; ++m) {
                f32x2v a2[4];
#pragma unroll
                for (int n = 0; n < 2; ++n)
#pragma unroll
                    for (int hh = 0; hh < 2; ++hh) {
                        const f32x2v ga = {acc[ai][0][m][n][2 * hh], acc[ai][0][m][n][2 * hh + 1]}, ua = {acc[ai][1][m][n][2 * hh], acc[ai][1][m][n][2 * hh + 1]};
                        const f32x2v gb = {bg[n][2 * hh], bg[n][2 * hh + 1]}, ub = {bu[n][2 * hh], bu[n][2 * hh + 1]};
                        a2[2 * n + hh] = swiglu2(ga * wsc + gb, ua * wsc + ub);
                    }
                uint2 w; w.x = pk4_fp8(a2[0][0], a2[0][1], a2[1][0], a2[1][1]); w.y = pk4_fp8(a2[2][0], a2[2][1], a2[3][0], a2[3][1]);
                *(uint2*)((unsigned char*)ACT + (size_t)(row0 + ai * HALF + m * 16) * D + c0) = w;
            }
    }
};
struct EpiMoe2 {
    static constexpr bool PERM = true, AFTER_DRAIN = false;
    bf16_t* YP; const float* b_out; const float* slot_gate; float wsc; const PG8_LAS int* tile_off;
    __device__ __forceinline__ void operator()(const f32x4 (&acc)[2][2][4][2], const Unit& u, int wr, int wc, int fr, int fq) const {
        int fr_ = fr, fq_ = fq; asm volatile("s_nop 15\n\ts_nop 15" : "+v"(fr_), "+v"(fq_)); __builtin_amdgcn_sched_barrier(0);
        const int e = u.pn >> 2, pnl = u.pn & 3;
        const int row0 = u.pm * BM + wr * 64 + fr_, c0 = pnl * 256 + wc * 32 + 8 * fq_;
        f32x4 bv[2][2];
#pragma unroll
        for (int bj = 0; bj < 2; ++bj)
#pragma unroll
            for (int n = 0; n < 2; ++n) bv[bj][n] = *(const f32x4*)(b_out + e * 1024 + c0 + bj * HALF + 4 * n);
#pragma unroll
        for (int ai = 0; ai < 2; ++ai)
#pragma unroll
            for (int m = 0; m < 4; ++m) { const int row = row0 + ai * HALF + m * 16; const float gt = slot_gate[tile_off[u.pm] + row] * YP8_SCALE;
#pragma unroll
                for (int bj = 0; bj < 2; ++bj) {
                    f32x2v q[4];
#pragma unroll
                    for (int n = 0; n < 2; ++n)
#pragma unroll
                        for (int hh = 0; hh < 2; ++hh) { const f32x2v av = {acc[ai][bj][m][n][2 * hh], acc[ai][bj][m][n][2 * hh + 1]}, bb2 = {bv[bj][n][2 * hh], bv[bj][n][2 * hh + 1]}; q[2 * n + hh] = (av * wsc + bb2) * gt; }
                    uint2 w; w.x = pk4_fp8(q[0][0], q[0][1], q[1][0], q[1][1]); w.y = pk4_fp8(q[2][0], q[2][1], q[3][0], q[3][1]);
                    *(uint2*)((unsigned char*)YP + (size_t)row * D + c0 + bj * HALF) = w; } }
    }
};
struct MoeSched {
    int T, NTN, tb, te, j, MR, G, c;
    const PG8_LAS int* tile_e;
    __device__ __forceinline__ int aoff(int pm) const { return tile_e[TOFF_AT + pm]; }
    __device__ void init(int T_, int NTN_, int G_, int bx, const PG8_LAS int* te_) {
        T = T_; NTN = NTN_; G = G_; c = bx; tile_e = te_;
        const int ngrp = (G % 8 == 0) ? 8 : 1, per = G / ngrp;
        const int x = bx % ngrp; j = bx / ngrp;
        tb = (int)((long)x * T / ngrp); te = (int)((long)(x + 1) * T / ngrp); MR = per / NTN;
    }
    __device__ bool next(int i, Unit& u) const {
        if (MR == 0) { const long Lx = (long)i * G + c; if (Lx >= (long)T * NTN) return false; u.pm = (int)(Lx / NTN); u.pn = tile_e[u.pm] * NTN + (int)(Lx % NTN); return true; }
        if (j >= MR * NTN) return false;
        const int pm = tb + i * MR + j / NTN; if (pm >= te) return false;
        u.pm = pm; u.pn = tile_e[pm] * NTN + j % NTN; return true;
    }
    __device__ __forceinline__ void a_ready(const Unit&) const {}
    __device__ __forceinline__ void done(const Unit&) const {}
};
struct OprojSched {
    int nM, G, c; unsigned* flag;
    __device__ void init(int M, int G_, int c_, unsigned* flag_) { nM = M / BM; G = G_; c = c_; flag = flag_; }
    __device__ bool next(int i, Unit& u) const {
        const int L = i * G + c;
        if (G == 256) { if (L < 256) { u.pm = (L & 7) * 8 + (L >> 5); u.pn = (L >> 3) & 3; } else { const int j = L - 256; u.pm = 64 + (j >> 2); u.pn = j & 3; } }
        else { u.pm = L >> 2; u.pn = L & 3; }
        return u.pm < nM;
    }
    __device__ __forceinline__ void a_ready(const Unit&) const {}
    __device__ __forceinline__ void done(const Unit& u) const {
        asm volatile("s_waitcnt vmcnt(0)" ::: "memory");
        __syncthreads();
        if (threadIdx.x == 0) {
            __builtin_amdgcn_fence(__ATOMIC_RELEASE, "agent");
            asm volatile("s_waitcnt vmcnt(0)" ::: "memory");
            (void)__hip_atomic_fetch_add(&flag[u.pm], 1u, __ATOMIC_RELAXED, __HIP_MEMORY_SCOPE_AGENT);
        }
    }
};
}

__device__ __forceinline__ int tid_fresh() { int t = threadIdx.x; asm volatile("" : "+v"(t)); return t; }
constexpr int LDS_GEMM = 131072, LDS_MISC = 131072, LDS_PAR = 131072 + 4096, LDS_TOTAL = 131072 + 4096 + 20480;

__device__ __forceinline__ void conv_item(const float* W, int ldw, int k0, int n0, bf16_t* WT, int dst_row, LAS float* scr, int lane) {
    float4 v[16];
    const float* src = W + (size_t)(k0 + (lane >> 4)) * ldw + n0 + 4 * (lane & 15);
#pragma unroll
    for (int j = 0; j < 16; ++j) v[j] = *(const float4*)(src + (size_t)(4 * j) * ldw);
    LAS float* d = scr + (lane >> 4) * 65 + 4 * (lane & 15);
#pragma unroll
    for (int j = 0; j < 16; ++j) { d[(4 * j) * 65 + 0] = v[j].x; d[(4 * j) * 65 + 1] = v[j].y; d[(4 * j) * 65 + 2] = v[j].z; d[(4 * j) * 65 + 3] = v[j].w; }
    asm volatile("s_waitcnt lgkmcnt(0)" ::: "memory");
    const int kc = lane & 7;
#pragma unroll
    for (int j = 0; j < 8; ++j) { const int n = 8 * j + (lane >> 3); const LAS float* sp = scr + (8 * kc) * 65 + n;
        uint4 o; o.x = pk2(sp[0 * 65], sp[1 * 65]); o.y = pk2(sp[2 * 65], sp[3 * 65]); o.z = pk2(sp[4 * 65], sp[5 * 65]); o.w = pk2(sp[6 * 65], sp[7 * 65]);
        *(uint4*)(WT + (size_t)(dst_row + n) * 1024 + k0 + 8 * kc) = o; }
    asm volatile("s_waitcnt lgkmcnt(0)" ::: "memory");
}
__device__ __forceinline__ void conv_item8(const float* W, int ldw, int k0, int n0, unsigned char* WT8, int dst_row, LAS float* scr, int lane, float wscale) {
    float4 v[16];
    const float* src = W + (size_t)(k0 + (lane >> 4)) * ldw + n0 + 4 * (lane & 15);
#pragma unroll
    for (int j = 0; j < 16; ++j) v[j] = *(const float4*)(src + (size_t)(4 * j) * ldw);
    LAS float* d = scr + (lane >> 4) * 65 + 4 * (lane & 15);
#pragma unroll
    for (int j = 0; j < 16; ++j) { d[(4 * j) * 65 + 0] = v[j].x * wscale; d[(4 * j) * 65 + 1] = v[j].y * wscale; d[(4 * j) * 65 + 2] = v[j].z * wscale; d[(4 * j) * 65 + 3] = v[j].w * wscale; }
    asm volatile("s_waitcnt lgkmcnt(0)" ::: "memory");
    const int kc = lane & 3;
#pragma unroll
    for (int j = 0; j < 4; ++j) { const int n = 16 * j + (lane >> 2); const LAS float* sp = scr + (16 * kc) * 65 + n;
        uint4 o; o.x = pk4_fp8(sp[0 * 65], sp[1 * 65], sp[2 * 65], sp[3 * 65]); o.y = pk4_fp8(sp[4 * 65], sp[5 * 65], sp[6 * 65], sp[7 * 65]);
        o.z = pk4_fp8(sp[8 * 65], sp[9 * 65], sp[10 * 65], sp[11 * 65]); o.w = pk4_fp8(sp[12 * 65], sp[13 * 65], sp[14 * 65], sp[15 * 65]);
        *(uint4*)(WT8 + (size_t)(dst_row + n) * 1024 + k0 + 16 * kc) = o; }
    asm volatile("s_waitcnt lgkmcnt(0)" ::: "memory");
}
__device__ __forceinline__ void conv8_load(float4 (&v)[16], const float* W, int ldw, int k0, int n0, int lane) {
    const float* src = W + (size_t)(k0 + (lane >> 4)) * ldw + n0 + 4 * (lane & 15);
#pragma unroll
    for (int j = 0; j < 16; ++j) v[j] = *(const float4*)(src + (size_t)(4 * j) * ldw);
}
__device__ __forceinline__ void conv8_store(const float4 (&v)[16], unsigned char* WT8, int dst_row, int k0, LAS float* scr, int lane, float wscale) {
    LAS float* d = scr + (lane >> 4) * 65 + 4 * (lane & 15);
#pragma unroll
    for (int j = 0; j < 16; ++j) { d[(4 * j) * 65 + 0] = v[j].x * wscale; d[(4 * j) * 65 + 1] = v[j].y * wscale; d[(4 * j) * 65 + 2] = v[j].z * wscale; d[(4 * j) * 65 + 3] = v[j].w * wscale; }
    asm volatile("s_waitcnt lgkmcnt(0)" ::: "memory");
    const int kc = lane & 3;
#pragma unroll
    for (int j = 0; j < 4; ++j) { const int n = 16 * j + (lane >> 2); const LAS float* sp = scr + (16 * kc) * 65 + n;
        uint4 o; o.x = pk4_fp8(sp[0 * 65], sp[1 * 65], sp[2 * 65], sp[3 * 65]); o.y = pk4_fp8(sp[4 * 65], sp[5 * 65], sp[6 * 65], sp[7 * 65]);
        o.z = pk4_fp8(sp[8 * 65], sp[9 * 65], sp[10 * 65], sp[11 * 65]); o.w = pk4_fp8(sp[12 * 65], sp[13 * 65], sp[14 * 65], sp[15 * 65]);
        *(uint4*)(WT8 + (size_t)(dst_row + n) * 1024 + k0 + 16 * kc) = o; }
    asm volatile("s_waitcnt lgkmcnt(0)" ::: "memory");
}
__device__ __forceinline__ void conv8h_load(float4 (&v)[16], const float* W, int ldw, int k0, int n0, int lane) {
    const float* src = W + (size_t)(k0 + 4 * (lane >> 4)) * ldw + n0 + 4 * (lane & 15);
#pragma unroll
    for (int j = 0; j < 4; ++j)
#pragma unroll
        for (int i = 0; i < 4; ++i) v[4 * j + i] = *(const float4*)(src + (size_t)(16 * j + i) * ldw);
}
__device__ __forceinline__ void conv8h_stage(const float4 (&v)[16], LAS unsigned* img, int half, int lane, float s) {
    const int kq = lane >> 4, nq = lane & 15;
#pragma unroll
    for (int j = 0; j < 4; ++j) {
        LAS unsigned* d = img + (4 * nq) * 33 + 16 * half + 4 * j + kq;
        d[0 * 33] = pk4_fp8(v[4 * j].x * s, v[4 * j + 1].x * s, v[4 * j + 2].x * s, v[4 * j + 3].x * s);
        d[1 * 33] = pk4_fp8(v[4 * j].y * s, v[4 * j + 1].y * s, v[4 * j + 2].y * s, v[4 * j + 3].y * s);
        d[2 * 33] = pk4_fp8(v[4 * j].z * s, v[4 * j + 1].z * s, v[4 * j + 2].z * s, v[4 * j + 3].z * s);
        d[3 * 33] = pk4_fp8(v[4 * j].w * s, v[4 * j + 1].w * s, v[4 * j + 2].w * s, v[4 * j + 3].w * s);
    }
}
__device__ __forceinline__ void conv8h_flush(const LAS unsigned* img, unsigned char* WT8, int dst_row, int k0, int lane) {
    asm volatile("s_waitcnt lgkmcnt(0)" ::: "memory");
    const int ch = lane & 7;
#pragma unroll
    for (int j = 0; j < 8; ++j) { const int n = 8 * j + (lane >> 3); const LAS unsigned* sp = img + n * 33 + 4 * ch;
        uint4 o; o.x = sp[0]; o.y = sp[1]; o.z = sp[2]; o.w = sp[3];
        *(uint4*)(WT8 + (size_t)(dst_row + n) * 1024 + k0 + 16 * ch) = o; }
    asm volatile("s_waitcnt lgkmcnt(0)" ::: "memory");
}
struct MoeConvItem { const float* W; unsigned char* WT8; int ldw, k0, n0, drow; float scale; };
__device__ __forceinline__ MoeConvItem moe_conv_item(const Params& p, int r) {
    MoeConvItem it; const int le = r / 384, q = r % 384;
    if (q < 256) { it.n0 = (q % 32) * 64; it.k0 = (q / 32) * 128; it.ldw = 2048; it.W = p.moe_w_in + (size_t)le * 1024 * 2048; it.WT8 = p.ws + WS_WT_MIN + (size_t)le * 2048 * 1024;
        const int nn = it.n0 & 1023; it.drow = 256 * (nn >> 7) + (nn & 127) + (it.n0 >= 1024 ? 128 : 0); it.scale = W8_SCALE; }
    else { const int q2 = q - 256; it.n0 = (q2 % 16) * 64; it.k0 = (q2 / 16) * 128; it.ldw = 1024; it.W = p.moe_w_out + (size_t)le * 1024 * 1024; it.WT8 = p.ws + WS_WT_MOUT + (size_t)le * 1024 * 1024;
        it.drow = it.n0; it.scale = W8O_SCALE; }
    return it;
}
__device__ __forceinline__ void phase_pre(const Params& p, int bid, int nb, unsigned char* smem) {
    const int nth = blockDim.x, tid = threadIdx.x;
    const int lane = tid & 63, wv = tid >> 6, nw = nth / 64;
    float* MOD = (float*)(p.ws + WS_MOD);
    {
        LAS float* sl = (LAS float*)smem;
        LAS float* part = (LAS float*)(smem + 12288);
        for (int it = bid; it < 192; it += nb) {
            for (int i = tid; i < 3072; i += nth) { const float cv = i < 2048 ? p.c[i] : p.c_ctx[i - 2048]; sl[i] = silu_f(cv); }
            __syncthreads();
            const int L = it / 96, n = (it % 96) * 64 + lane;
            const float* W = p.mod_w + (size_t)L * 1024 * 6144 + n;
            float a0 = 0.f, a1 = 0.f, a2 = 0.f;
#pragma unroll 32
            for (int k = 128 * wv; k < 128 * wv + 128; ++k) { const float w = W[(size_t)k * 6144]; a0 += sl[k] * w; a1 += sl[1024 + k] * w; a2 += sl[2048 + k] * w; }
            part[(wv * 3 + 0) * 64 + lane] = a0; part[(wv * 3 + 1) * 64 + lane] = a1; part[(wv * 3 + 2) * 64 + lane] = a2;
            __syncthreads();
            if (tid < 192) { const int r = tid >> 6, nn = (it % 96) * 64 + (tid & 63); float sum = p.mod_b[L * 6144 + nn];
                for (int q = 0; q < nw; ++q) sum += part[(q * 3 + r) * 64 + (tid & 63)];
                MOD[(L * 3 + r) * 6144 + nn] = sum; }
            __syncthreads();
        }
    }
    const int gt = bid * nth + tid, gs = nb * nth;
    float2* ROPE = (float2*)(p.ws + WS_ROPE);
    for (int idx = gt; idx < 8192 * 32; idx += gs) {
        const int t = idx >> 5, i = idx & 31;
        const float pos = (i < 16) ? (float)(t >> 6) : (float)(t & 63);
        const float fr = powf(10000.0f, -(float)(i & 15) / 16.0f);
        const float ang = pos * fr;
        ROPE[idx] = make_float2(cosf(ang), sinf(ang));
    }
    if (bid == nb - 1 && wv == 0) {
        const float s1 = wave_sum(p.lq1[lane] * p.lk1[lane]), s2 = wave_sum(p.lq2[lane] * p.lk2[lane]);
        if (lane == 0) ((float*)(p.ws + WS_SCAL))[0] = expf(s1) - expf(s2) + 0.2f;
    }
    LAS float* scr = (LAS float*)(smem + wv * 16640);
    constexpr int I_ABIN = 16 * 48, I_ABOUT = 16 * 16, I_CDIN = 16 * 24, I_CDOUT = 16 * 16, I_MIN = 16 * 32, I_MOUT = 16 * 16;
    constexpr int I_SMALL = I_ABIN + I_ABOUT + I_CDIN + I_CDOUT;
    for (int it = bid * nw + wv; it < I_SMALL; it += nb * nw) {
        int r = it;
        if (r < I_ABIN) { conv_item8(p.ab_w_in, 3072, (r / 48) * 64, (r % 48) * 64, p.ws + WS_WT_ABIN, (r % 48) * 64, scr, lane, WQKV8_SCALE); continue; } r -= I_ABIN;
        if (r < I_ABOUT) { conv_item(p.ab_w_out, 1024, (r / 16) * 64, (r % 16) * 64, (bf16_t*)(p.ws + WS_WT_ABOUT), (r % 16) * 64, scr, lane); continue; } r -= I_ABOUT;
        if (r < I_CDIN) { const int n0 = (r % 24) * 64; const int np = n0 < 512 ? n0 : n0 < 640 ? 1024 + (n0 - 512) : n0 < 768 ? 1280 + (n0 - 640) : n0 < 1280 ? 512 + (n0 - 768) : n0 < 1408 ? 1152 + (n0 - 1280) : n0;
            conv_item8(p.cd_w_in, 1536, (r / 24) * 64, n0, p.ws + WS_WT_CDIN, np, scr, lane, WQKV8_SCALE); continue; } r -= I_CDIN;
        conv_item(p.cd_w_out, 1024, (r / 16) * 64, (r % 16) * 64, (bf16_t*)(p.ws + WS_WT_CDOUT), (r % 16) * 64, scr, lane);
    }
    {
        uint4* z0 = (uint4*)(p.ws + WS_XB); uint4* z1 = (uint4*)(p.ws + WS_XB + 4 * MiB);
        for (int i = gt; i < NE * ECAP / 4; i += gs) { z0[i] = make_uint4(0u, 0u, 0u, 0u); z1[i] = make_uint4(0u, 0u, 0u, 0u); }
    }
}

__device__ __forceinline__ void phase_h0(const Params& p, int bid, int nb) {
    const float* MOD = (const float*)(p.ws + WS_MOD);
    unsigned char* H8 = p.ws + WS_H;
    const int lane = threadIdx.x & 63, wv = threadIdx.x >> 6, nw = blockDim.x / 64;
    const int step = nb * nw;
    float4 vn[4][4], an[4], bn[4];
    auto load4 = [&](int rqx) {
        const int r0 = rqx * 4; const float* xin = r0 < NLAT ? p.x + (size_t)r0 * D : p.ctx + (size_t)(r0 - NLAT) * D;
        const float* shx = MOD + (0 * 3 + (r0 < NLAT ? (r0 >> 13) : 2)) * 6144; const float* scx = shx + 1024;
#pragma unroll
        for (int j = 0; j < 4; ++j) { an[j] = *(const float4*)(scx + 4 * lane + 256 * j); bn[j] = *(const float4*)(shx + 4 * lane + 256 * j); }
#pragma unroll
        for (int q = 0; q < 4; ++q)
#pragma unroll
            for (int j = 0; j < 4; ++j) vn[q][j] = *(const float4*)(xin + (size_t)q * D + 4 * lane + 256 * j);
    };
    if (bid * nw + wv < NTOK / 4) load4(bid * nw + wv);
    for (int rq = bid * nw + wv; rq < NTOK / 4; rq += step) {
        const int row0 = rq * 4;
        float4 v[4][4], a4[4], b4[4];
#pragma unroll
        for (int j = 0; j < 4; ++j) { a4[j] = an[j]; b4[j] = bn[j]; }
#pragma unroll
        for (int q = 0; q < 4; ++q)
#pragma unroll
            for (int j = 0; j < 4; ++j) v[q][j] = vn[q][j];
        if (rq + step < NTOK / 4) load4(rq + step);
#pragma unroll
        for (int j = 0; j < 4; ++j) {
            const int k = 4 * lane + 256 * j;
            const float4 a = a4[j], b = b4[j];
#pragma unroll
            for (int q = 0; q < 4; ++q)
                *(unsigned*)(H8 + (size_t)(row0 + q) * D + k) = pk4_fp8(v[q][j].x * (1.f + a.x) + b.x, v[q][j].y * (1.f + a.y) + b.y, v[q][j].z * (1.f + a.z) + b.z, v[q][j].w * (1.f + a.w) + b.w);
        }
    }
}

__device__ __forceinline__ void chunk_desc(int L, int ch, int& kind, int& idx, int& flags) {
    if (L == 0) {
        const int g = ch >> 3, u = ch & 7;
        kind = g % 3; idx = (g >= 3 ? 8 : 0) + u; flags = (g == 3 || g == 4) ? 1 : 0;
    } else {
        if (ch < 8) { kind = 0; idx = ch; flags = 0; }
        else if (ch < 16) { kind = 0; idx = ch; flags = 1; }
        else if (ch < 18) { kind = 1; idx = ch - 16; flags = 0; }
        else if (ch < 20) { kind = 1; idx = ch - 16; flags = 1; }
        else { kind = 2; idx = ch - 20; flags = 0; }
    }
}
namespace pg8 {
struct QkvSched {
    int L, nwg, G, c;
    __device__ __forceinline__ void init(int L_, int G_, int c_) { L = L_; G = G_; c = c_; nwg = 66 * (L_ == 0 ? 12 : 6); }
    __device__ __forceinline__ bool next(int i, Unit& u) const {
        const long Lx = (long)i * G + c; if (Lx >= nwg) return false;
        int wgid = (int)Lx; { const int q = nwg / NXCD, r = nwg % NXCD, xcd = wgid % NXCD, off = wgid / NXCD; wgid = (xcd < r ? xcd * (q + 1) : r * (q + 1) + (xcd - r) * q) + off; }
        if (L == 0) { const int t = wgid / 12, j = wgid % 12;
            if (j < 8) { u.pm = t; u.pn = 66 + (j < 4 ? j : j + 2); } else { u.pm = 66 + (j < 10 ? j - 4 : j); u.pn = t; } }
        else { const int t = wgid / 6, j = wgid % 6;
            if (j < 5) { u.pm = t; u.pn = 78 + j; } else { u.pm = 78 + 5; u.pn = t; } }
        return true;
    }
    __device__ __forceinline__ void a_ready(const Unit&) const {}
    __device__ __forceinline__ void done(const Unit&) const {}
};
struct EpiQkv {
    static constexpr bool PERM = true, AFTER_DRAIN = false;
    int L; bf16_t* Q; bf16_t* Kb; bf16_t* VT; const float2* ROPE; float wsc;
    __device__ __forceinline__ void operator()(const f32x4 (&acc)[2][2][4][2], const Unit& u, int wr, int wc, int fr_in, int fq_in) const {
        int fr = fr_in, fq = fq_in; asm volatile("s_nop 15\n\ts_nop 15" : "+v"(fr), "+v"(fq)); __builtin_amdgcn_sched_barrier(0);
        const int WT0 = L == 0 ? 66 : 78, NKH = L == 0 ? 16 : 4, NVR = L == 0 ? 1024 : 256;
        if (u.pm < 66) {
            const int wt = u.pn - WT0, cic = (wc & 1) * 32 + 8 * fq;
#pragma unroll
            for (int bj = 0; bj < 2; ++bj) {
                int kind, idx, flags; chunk_desc(L, wt * 4 + bj * 2 + (wc >> 1), kind, idx, flags);
                bf16_t* base = kind == 0 ? Q + (size_t)idx * SP * 64 : Kb + (size_t)idx * SP * 64;
                const size_t bstride = (size_t)(kind == 0 ? NQH : NKH) * SP * 64;
#pragma unroll
                for (int ai = 0; ai < 2; ++ai)
#pragma unroll
                    for (int m = 0; m < 4; ++m) {
                        const int row = u.pm * BM + ai * HALF + wr * 64 + m * 16 + fr;
                        const bool lat = row < NLAT;
                        const int b = lat ? (row >> 13) : ((row - NLAT) >> 8), t = row & 8191, pos = lat ? 256 + t : ((row - NLAT) & 255);
                        f32x4 v0 = acc[ai][bj][m][0] * wsc, v1 = acc[ai][bj][m][1] * wsc;
                        if ((flags & 1) && lat) {
                            const f32x4 c01 = *(const f32x4*)(ROPE + t * 32 + (cic >> 1)), c23 = *(const f32x4*)(ROPE + t * 32 + (cic >> 1) + 2);
                            const f32x4 a = v0, bq = v1;
                            v0[0] = a[0] * c01[0] - a[1] * c01[1]; v0[1] = a[0] * c01[1] + a[1] * c01[0];
                            v0[2] = a[2] * c01[2] - a[3] * c01[3]; v0[3] = a[2] * c01[3] + a[3] * c01[2];
                            v1[0] = bq[0] * c23[0] - bq[1] * c23[1]; v1[1] = bq[0] * c23[1] + bq[1] * c23[0];
                            v1[2] = bq[2] * c23[2] - bq[3] * c23[3]; v1[3] = bq[2] * c23[3] + bq[3] * c23[2];
                        }
                        u32x4 w; w.x = cvt_pk_bf16(v0[0], v0[1]); w.y = cvt_pk_bf16(v0[2], v0[3]); w.z = cvt_pk_bf16(v1[0], v1[1]); w.w = cvt_pk_bf16(v1[2], v1[3]);
                        *(u32x4*)(base + (size_t)b * bstride + (size_t)pos * 64 + cic) = w;
                    }
            }
        } else {
            const int wt = u.pm - WT0;
            const int vbase = L == 0 ? (wt == 4 ? 0 : wt == 5 ? 256 : wt == 10 ? 512 : 768) : 0;
            const int t = u.pn, b = t < 64 ? (t >> 5) : (t - 64), pos0 = t < 64 ? 256 + (t & 31) * 256 : 0;
#pragma unroll
            for (int ai = 0; ai < 2; ++ai)
#pragma unroll
                for (int m = 0; m < 4; ++m) {
                    bf16_t* rowp = VT + ((size_t)b * NVR + vbase + ai * HALF + wr * 64 + m * 16 + fr) * SP + pos0 + wc * 32 + 8 * fq;
#pragma unroll
                    for (int bj = 0; bj < 2; ++bj) { const f32x4 v0 = acc[ai][bj][m][0] * wsc, v1 = acc[ai][bj][m][1] * wsc;
                        u32x4 w; w.x = cvt_pk_bf16(v0[0], v0[1]); w.y = cvt_pk_bf16(v0[2], v0[3]); w.z = cvt_pk_bf16(v1[0], v1[1]); w.w = cvt_pk_bf16(v1[2], v1[3]);
                        *(u32x4*)(rowp + bj * HALF) = w; }
                }
        }
    }
};
}
__device__ __forceinline__ void phase_qkv(const Params& p, int L, int bid, int nb, unsigned char* smem) {
    pg8::Gemm g{(const bf16_t*)(p.ws + WS_H), (const bf16_t*)(p.ws + WS_H), 0, 0, D / 2};
    pg8::QkvSched So; So.init(L, nb, bid);
    pg8::EpiQkv E{L, (bf16_t*)(p.ws + WS_Q), (bf16_t*)(p.ws + WS_K), (bf16_t*)(p.ws + WS_VT), (const float2*)(p.ws + WS_ROPE), 1.0f / WQKV8_SCALE};
    pg8::gemm_phase<pg8::EpiQkv, pg8::QkvSched, true, true, true>((PG8_LAS unsigned char*)smem, g, So, E);
}

__device__ __forceinline__ void phase_knorm(const Params& p, int bid, int nb) {
    bf16_t* Kb = (bf16_t*)(p.ws + WS_K);
    const float2* ROPE = (const float2*)(p.ws + WS_ROPE);
    const int lane = threadIdx.x & 63, wv = threadIdx.x >> 6, nw = blockDim.x / 64;
    const float nwt = p.k_norm[lane];
    for (int it = bid * nw + wv; it < 2 * 2 * (SP / 8); it += nb * nw) {
        const int tile8 = it % (SP / 8), hb = it / (SP / 8), hd = hb & 1, b = hb >> 1;
        bf16_t* base = Kb + ((size_t)(b * 4 + hd) * SP + tile8 * 8) * 64 + lane;
#pragma unroll
        for (int i = 0; i < 8; ++i) {
            float v = bf2f(base[i * 64]);
            const float ss = wave_sum(v * v); v = v * rsqrtf(ss * (1.f / 64.f) + RMS_EPS) * nwt;
            if (tile8 >= 32) {
                const float2 cs = ROPE[(tile8 * 8 + i - 256) * 32 + (lane >> 1)];
                const float o = __shfl_xor(v, 1);
                v = (lane & 1) ? (o * cs.y + v * cs.x) : (v * cs.x - o * cs.y);
            }
            base[i * 64] = (bf16_t)f2bf(v);
        }
    }
}

__device__ __forceinline__ void phase_oproj(const Params& p, int L, int bid, int nb, unsigned char* smem) {
    const int M = L == 0 ? NTOK : NLAT;
    pg8::Gemm g{(const bf16_t*)(p.ws + WS_Y), (const bf16_t*)(p.ws + (L == 0 ? WS_WT_ABOUT : WS_WT_CDOUT)), M, D, D};
    pg8::OprojSched So; So.init(M, nb, bid, (unsigned*)(p.ws + WS_CTL) + FLAG_WORD + L * 128);
    pg8::EpiStoreBf16 E{(bf16_t*)(p.ws + WS_YO), D};
    pg8::gemm_phase<pg8::EpiStoreBf16, pg8::OprojSched, true, true, false>((PG8_LAS unsigned char*)smem, g, So, E);
    __syncthreads();
}

template <int CTRL> __device__ __forceinline__ float dpp_xmax(float v) { const int t = __builtin_amdgcn_update_dpp(__float_as_int(v), __float_as_int(v), CTRL, 0xf, 0xf, false); return fmaxf(v, __int_as_float(t)); }
__device__ __forceinline__ float half_max32(float v) {
    v = dpp_xmax<0xB1>(v); v = dpp_xmax<0x4E>(v); v = dpp_xmax<0x141>(v); v = dpp_xmax<0x140>(v);
    return fmaxf(v, __int_as_float(__builtin_amdgcn_ds_swizzle(__float_as_int(v), 0x401f)));
}
__device__ __forceinline__ void phase_ln1(const Params& p, int L, int bid, int nb, unsigned char* smem) {
    typedef float f32x4v __attribute__((ext_vector_type(4)));
    const float* MOD = (const float*)(p.ws + WS_MOD);
    const bf16_t* YO = (const bf16_t*)(p.ws + WS_YO);
    const bf16_t* X2 = (const bf16_t*)(p.ws + WS_X2);
    bf16_t* X1 = (bf16_t*)(p.ws + WS_X1);
    unsigned char* TOK8 = p.ws + WS_TOK;
    int* cnt = (int*)(p.ws + WS_CTL) + L * 32 * CNT_STRIDE;
    int* pair_e = (int*)(p.ws + WS_PAIR); int* pair_pos = pair_e + NTOK * 4; float* pair_gate = (float*)(pair_e + 3 * NTOK * 4);
    const int tidf = tid_fresh(); const int lane = tidf & 63, wv = tidf >> 6;
    constexpr int TKS = 1025;
    float* tokA = (float*)smem;
    float* part = (float*)(smem + 16 * TKS * 4 + 64);
    const LAS float* pl = (const LAS float*)(smem + LDS_PAR);
    int* lcnt = (int*)(smem + LDS_MISC);
    if (threadIdx.x < 2 * NE) lcnt[threadIdx.x] = 0;
    const int nrows = L == 0 ? NTOK : NLAT, ngrp = nrows / 16;
    const float* lg = p.ln1_g + L * D; const float* lb = p.ln1_b + L * D;
    const float* rw = p.router_w + (size_t)L * D * NE; const float* rb = p.router_b + L * NE;
    float4 xa[2][4]; uint2 ya[2][4];
    auto load_rows = [&](int g) {
        const int row0 = g * 16 + 2 * wv; const bool lt = row0 < NLAT;
        const float* xin0 = lt ? p.x + (size_t)row0 * D : p.ctx + (size_t)(row0 - NLAT) * D;
#pragma unroll
        for (int q = 0; q < 2; ++q)
#pragma unroll
            for (int j = 0; j < 4; ++j) { const int k = 4 * lane + 256 * j;
                if (L == 0) xa[q][j] = *(const float4*)(xin0 + (size_t)q * D + k);
                else { const uint2 xw = *(const uint2*)(X2 + (size_t)(row0 + q) * D + k); xa[q][j] = make_float4(bf2f(xw.x & 0xffffu), bf2f(xw.x >> 16), bf2f(xw.y & 0xffffu), bf2f(xw.y >> 16)); }
                ya[q][j] = *(const uint2*)(YO + (size_t)(row0 + q) * D + k); }
    };
    unsigned* oflag = (unsigned*)(p.ws + WS_CTL) + FLAG_WORD + L * 128;
    auto wait_tile = [&](int g) {
        if (threadIdx.x == 0) {
            unsigned sp = 0;
            while (__hip_atomic_load(&oflag[g >> 4], __ATOMIC_RELAXED, __HIP_MEMORY_SCOPE_AGENT) < 4u) { __builtin_amdgcn_s_sleep(1); if (++sp > (1u << 22)) break; }
            __builtin_amdgcn_fence(__ATOMIC_ACQUIRE, "agent");
            asm volatile("s_waitcnt vmcnt(0)" ::: "memory");
        }
    };
    float rwb0[32], rwb1[32];
    { const float* wb = rw + (size_t)(128 * wv + (lane >> 4)) * NE + (lane & 15);
#pragma unroll
      for (int ks = 0; ks < 32; ++ks) { rwb0[ks] = wb[(size_t)(4 * ks) * NE]; rwb1[ks] = wb[(size_t)(4 * ks) * NE + 16]; } }
    const int g0 = nb - 1 - bid;
    auto grp_at = [&](int k) -> int {
        if (L == 0 && nb == 256) {
            if (bid < 8) return k < 2 ? g0 + k * nb : -1;
            if (bid < 24 && k == 4) { const int i = bid - 8; return i < 8 ? 248 + i + 512 : 248 + (i - 8) + 768; }
        }
        const int g = g0 + k * nb; return (k >= 0 && g < ngrp) ? g : -1;
    };
    if (threadIdx.x == 0 && g0 < ngrp) {
        unsigned sp = 0;
        for (;;) {
            unsigned f[4];
#pragma unroll
            for (int j = 0; j < 4; ++j) { const int g = grp_at(j); f[j] = g >= 0 ? __hip_atomic_load(&oflag[g >> 4], __ATOMIC_RELAXED, __HIP_MEMORY_SCOPE_AGENT) : 4u; }
            if ((f[0] >= 4u && f[1] >= 4u && f[2] >= 4u && f[3] >= 4u) || ++sp > (1u << 22)) break;
            __builtin_amdgcn_s_sleep(1);
        }
        __builtin_amdgcn_fence(__ATOMIC_ACQUIRE, "agent");
        asm volatile("s_waitcnt vmcnt(0)" ::: "memory");
    }
    __syncthreads();
    if (g0 < ngrp) load_rows(g0);
    const float rbe = rb[lane & 31];
    int staged = -1;
    for (int kg = 0, grp = grp_at(0); grp >= 0; ++kg, grp = grp_at(kg)) {
        const int gnext = grp_at(kg + 1);
        const int rowb = grp * 16; const bool lat = rowb < NLAT; const int rbat = lat ? (rowb >> 13) : 2;
        {
            const float* modb = MOD + (L * 3 + rbat) * 6144;
            if (gnext >= 0 && kg + 1 >= 4) wait_tile(gnext);
            __syncthreads();
            if (rbat != staged) for (int i = threadIdx.x; i < 1280; i += blockDim.x) { const int vsel = i >> 8, idx = (i & 255) * 4;
                const float* src = vsel == 0 ? modb + 2048 : vsel == 1 ? modb + 3072 : vsel == 2 ? modb + 4096 : vsel == 3 ? lg : lb;
                const float4 t = *(const float4*)(src + idx);
                *(LAS float4v*)(smem + LDS_PAR + (vsel * 1024 + idx) * 4) = (float4v){t.x, t.y, t.z, t.w}; }
            staged = rbat;
            __syncthreads();
        }
        {
            const int row0 = rowb + 2 * wv;
            float4 vq[2][4]; float sq[2];
#pragma unroll
            for (int q = 0; q < 2; ++q) {
                sq[q] = 0.f;
#pragma unroll
                for (int j = 0; j < 4; ++j) {
                    const int k = 4 * lane + 256 * j;
                    const float4 a = xa[q][j]; const uint2 yw = ya[q][j]; const float4 y = make_float4(bf2f(yw.x & 0xffffu), bf2f(yw.x >> 16), bf2f(yw.y & 0xffffu), bf2f(yw.y >> 16)); const float4v g = *(const LAS float4v*)(pl + k);
                    vq[q][j] = make_float4(ALPHA * a.x + g.x * y.x, ALPHA * a.y + g.y * y.y, ALPHA * a.z + g.z * y.z, ALPHA * a.w + g.w * y.w);
                    sq[q] += (vq[q][j].x + vq[q][j].y) + (vq[q][j].z + vq[q][j].w);
                }
            }
            if (gnext >= 0) load_rows(gnext);
#pragma unroll
            for (int q = 0; q < 2; ++q) {
                const int row = row0 + q;
                float4 v[4]; float s = sq[q];
#pragma unroll
                for (int j = 0; j < 4; ++j) v[j] = vq[q][j];
                const float mean = wave_sum(s) * (1.f / D); float s2 = 0.f;
#pragma unroll
                for (int j = 0; j < 4; ++j) { v[j].x -= mean; v[j].y -= mean; v[j].z -= mean; v[j].w -= mean; s2 += (v[j].x * v[j].x + v[j].y * v[j].y) + (v[j].z * v[j].z + v[j].w * v[j].w); }
                const float rstd = rsqrtf(wave_sum(s2) * (1.f / D) + LN_EPS);
#pragma unroll
                for (int j = 0; j < 4; ++j) {
                    const int k = 4 * lane + 256 * j;
                    const float4v g = *(const LAS float4v*)(pl + 3072 + k), bb = *(const LAS float4v*)(pl + 4096 + k), a = *(const LAS float4v*)(pl + 2048 + k), b2 = *(const LAS float4v*)(pl + 1024 + k);
                    float4 x1 = make_float4(v[j].x * rstd * g.x + bb.x, v[j].y * rstd * g.y + bb.y, v[j].z * rstd * g.z + bb.z, v[j].w * rstd * g.w + bb.w);
                    { uint2 xo; xo.x = pk2(x1.x, x1.y); xo.y = pk2(x1.z, x1.w); *(uint2*)(X1 + (size_t)row * D + k) = xo; }
                    float4 tk = make_float4(x1.x * (1.f + a.x) + b2.x, x1.y * (1.f + a.y) + b2.y, x1.z * (1.f + a.z) + b2.z, x1.w * (1.f + a.w) + b2.w);
                    float* td = tokA + (2 * wv + q) * TKS + k; td[0] = tk.x; td[1] = tk.y; td[2] = tk.z; td[3] = tk.w;
                    *(unsigned*)(TOK8 + (size_t)row * D + k) = pk4_fp8(tk.x, tk.y, tk.z, tk.w);
                }
            }
        }
        __syncthreads();
        {
            f32x4v c0 = {0.f, 0.f, 0.f, 0.f}, c1 = {0.f, 0.f, 0.f, 0.f};
            const float* ta = tokA + (lane & 15) * TKS + 128 * wv + (lane >> 4);
            float av[32];
#pragma unroll
            for (int ks = 0; ks < 32; ++ks) av[ks] = ta[4 * ks];
#pragma unroll
            for (int ks = 0; ks < 32; ++ks) {
                c0 = __builtin_amdgcn_mfma_f32_16x16x4f32(av[ks], rwb0[ks], c0, 0, 0, 0);
                c1 = __builtin_amdgcn_mfma_f32_16x16x4f32(av[ks], rwb1[ks], c1, 0, 0, 0);
            }
            __builtin_amdgcn_sched_group_barrier(0x100, 4, 0);
#pragma unroll
            for (int g = 0; g < 12; ++g) { __builtin_amdgcn_sched_group_barrier(0x008, 4, 0); __builtin_amdgcn_sched_group_barrier(0x100, 1, 0); }
            __builtin_amdgcn_sched_group_barrier(0x008, 16, 0);
#pragma unroll
            for (int r = 0; r < 4; ++r) { float* pd = part + (wv * 16 + 4 * (lane >> 4) + r) * 32 + (lane & 15); pd[0] = c0[r]; pd[16] = c1[r]; }
        }
        __syncthreads();
        {
            const int e = lane & 31;
#pragma unroll 1
            for (int q = 0; q < 2; ++q) {
                const int rl = 2 * wv + q, row = rowb + rl;
                float val = rbe;
#pragma unroll
                for (int w8 = 0; w8 < 8; ++w8) val += part[(w8 * 16 + rl) * 32 + e];
                float tv[4]; int ti[4];
                float vcur = val;
#pragma unroll
                for (int rr = 0; rr < 4; ++rr) {
                    const float mxv = __builtin_bit_cast(float, __builtin_amdgcn_readfirstlane(__builtin_bit_cast(int, half_max32(vcur))));
                    const unsigned msk = (unsigned)__ballot(vcur == mxv);
                    const int idx = __builtin_amdgcn_readfirstlane(__builtin_ctz(msk));
                    ti[rr] = idx; tv[rr] = mxv;
                    vcur = (e == idx) ? -3.0e38f : vcur;
                }
                const float e0 = 1.f, e1 = __expf(tv[1] - tv[0]), e2 = __expf(tv[2] - tv[0]), e3 = __expf(tv[3] - tv[0]);
                const float inv = 1.f / (e0 + e1 + e2 + e3);
                const float gs4[4] = {e0 * inv, e1 * inv, e2 * inv, e3 * inv};
                if (lane < 4) {
                    const int el = lane == 0 ? ti[0] : lane == 1 ? ti[1] : lane == 2 ? ti[2] : ti[3];
                    const float gl = lane == 0 ? gs4[0] : lane == 1 ? gs4[1] : lane == 2 ? gs4[2] : gs4[3];
                    const int pos = atomicAdd(&lcnt[el], 1);
                    pair_e[row * 4 + lane] = el; pair_pos[row * 4 + lane] = pos; pair_gate[row * 4 + lane] = gl;
                }
            }
        }
    }
    __syncthreads();
    if (threadIdx.x < NE) lcnt[NE + threadIdx.x] = atomicAdd(&cnt[threadIdx.x * CNT_STRIDE], lcnt[threadIdx.x]);
    __syncthreads();
    int* etok = (int*)(p.ws + WS_XB); float* egate = (float*)(p.ws + WS_XB + 4 * MiB);
    for (int kg = threadIdx.x >> 6, grp = grp_at(kg); grp >= 0; kg += NTH_ / 64, grp = grp_at(kg)) {
        const int pr = grp * 64 + (threadIdx.x & 63), e = pair_e[pr], pos = pair_pos[pr] + lcnt[NE + e];
        pair_pos[pr] = pos; etok[e * ECAP + pos] = pr >> 2; egate[e * ECAP + pos] = pair_gate[pr]; }
    __syncthreads();
}

__device__ __forceinline__ int moe_tile_table(const Params& p, int L, unsigned char* smem, bool build = true) {
    const int* cnt = (const int*)(p.ws + WS_CTL) + L * 32 * CNT_STRIDE;
    LAS int* tab = (LAS int*)(smem + LDS_MISC);
    if (!build) return tab[320];
    __syncthreads();
    if (threadIdx.x < NE) {
        const int e = threadIdx.x, n = (cnt[e * CNT_STRIDE] + 255) / 256;
        int f = 0;
#pragma unroll
        for (int j = 0; j < NE; ++j) { const int nj = __builtin_amdgcn_readlane(n, j); f += j < e ? nj : 0; }
        tab[PSTART_AT + e] = f * 256;
        for (int q = 0; q < n; ++q) { tab[TOFF_AT + f + q] = e * ECAP - f * 256; tab[f + q] = e; }
        if (e == NE - 1) tab[320] = f + n;
    }
    __syncthreads();
    return tab[320];
}
__device__ __forceinline__ void phase_moe1(const Params& p, int L, int bid, int nb, unsigned char* smem) {
    const int T = moe_tile_table(p, L, smem);
    pg8::Gemm g{(const bf16_t*)(p.ws + WS_TOK), (const bf16_t*)(p.ws + WS_WT_MIN + (size_t)L * 32 * 2048 * 1024), MAXSLOT, 32 * 2048, D / 2, (const int*)(p.ws + WS_XB)};
    pg8::MoeSched So; So.init(T, 8, nb, bid, (const PG8_LAS int*)(smem + LDS_MISC));
    pg8::EpiMoe1 E{(bf16_t*)(p.ws + WS_ACT), p.moe_b_in + (size_t)L * 32 * 2048, 1.0f / W8_SCALE};
    pg8::gemm_phase<pg8::EpiMoe1, pg8::MoeSched, true, true, true, true>((PG8_LAS unsigned char*)smem, g, So, E);
    {
        const PG8_LAS int* tab = (const PG8_LAS int*)(smem + LDS_MISC);
        const int* pair_e = (const int*)(p.ws + WS_PAIR); const int* pair_pos = pair_e + NTOK * 4; int* pair_slot = (int*)pair_e + 2 * NTOK * 4;
        const int npairs = (L == 0 ? NTOK : NLAT) * 4;
        for (int pr = bid * blockDim.x + threadIdx.x; pr < npairs; pr += nb * blockDim.x) pair_slot[pr] = tab[PSTART_AT + pair_e[pr]] + pair_pos[pr];
    }
}
__device__ __forceinline__ void phase_moe2(const Params& p, int L, int bid, int nb, unsigned char* smem) {
    const int T = moe_tile_table(p, L, smem, PROBE_DUP_MOE2);
    pg8::Gemm g{(const bf16_t*)(p.ws + WS_ACT), (const bf16_t*)(p.ws + WS_WT_MOUT + (size_t)L * 32 * 1024 * 1024), MAXSLOT, 32 * 1024, D / 2};
    pg8::MoeSched So; So.init(T, 4, nb, bid, (const PG8_LAS int*)(smem + LDS_MISC));
    pg8::EpiMoe2 E{(bf16_t*)(p.ws + WS_YP), p.moe_b_out + (size_t)L * 32 * 1024, (const float*)(p.ws + WS_XB + 4 * MiB), 1.0f / (ACT8_SCALE * W8O_SCALE), (const PG8_LAS int*)(smem + LDS_MISC) + TOFF_AT};
    pg8::gemm_phase<pg8::EpiMoe2, pg8::MoeSched, true, true, true>((PG8_LAS unsigned char*)smem, g, So, E);
}

__device__ __forceinline__ void phase_ln2(const Params& p, int L, int bid, int nb) {
    const float* MOD = (const float*)(p.ws + WS_MOD);
    const bf16_t* X1 = (const bf16_t*)(p.ws + WS_X1);
    const unsigned char* YP8 = p.ws + WS_YP;
    const int* pair_slot = (const int*)(p.ws + WS_PAIR) + 2 * NTOK * 4;
    bf16_t* X2 = (bf16_t*)(p.ws + WS_X2); unsigned char* H8 = p.ws + WS_H;
    const int lane = threadIdx.x & 63, wv = threadIdx.x >> 6, nw = blockDim.x / 64;
    const int nrows = L == 0 ? NTOK : NLAT;
    const float* lg = p.ln2_g + L * D; const float* lb = p.ln2_b + L * D;
    const int step = nb * nw, nitem = nrows / 2;
    uint2 xw[2][4]; unsigned yw[2][4][4]; int sl[2][4];
    auto load_slots = [&](int rpx) {
#pragma unroll
        for (int q = 0; q < 2; ++q)
#pragma unroll
            for (int t = 0; t < 4; ++t) sl[q][t] = pair_slot[(rpx * 2 + q) * 4 + t];
    };
    auto load_rows2 = [&](int rpx) {
#pragma unroll
        for (int q = 0; q < 2; ++q)
#pragma unroll
            for (int j = 0; j < 4; ++j) { const int k = 4 * lane + 256 * j; xw[q][j] = *(const uint2*)(X1 + (size_t)(rpx * 2 + q) * D + k);
#pragma unroll
                for (int t = 0; t < 4; ++t) yw[q][j][t] = *(const unsigned*)(YP8 + (size_t)sl[q][t] * D + k); }
    };
    int rp = bid * nw + wv;
    if (rp < nitem) { load_slots(rp); load_rows2(rp); }
    if (rp + step < nitem) load_slots(rp + step);
    for (; rp < nitem; rp += step) {
        const int row0 = rp * 2;
        const bool lat = row0 < NLAT; const int r = lat ? (row0 >> 13) : 2;
        const float* mod = MOD + (L * 3 + r) * 6144; const float* g2 = mod + 5120;
        const float* modn = MOD + ((L == 0 ? 1 : 0) * 3 + r) * 6144;
        float4 xa[2][4];
#pragma unroll
        for (int q = 0; q < 2; ++q)
#pragma unroll
            for (int j = 0; j < 4; ++j) { const uint2 w2 = xw[q][j]; xa[q][j] = make_float4(bf2f(w2.x & 0xffffu), bf2f(w2.x >> 16), bf2f(w2.y & 0xffffu), bf2f(w2.y >> 16)); }
        float4 fs[2][4];
#pragma unroll
        for (int q = 0; q < 2; ++q)
#pragma unroll
            for (int j = 0; j < 4; ++j) { float4 f = make_float4(0.f, 0.f, 0.f, 0.f);
#pragma unroll
                for (int t = 0; t < 4; ++t) { const unsigned w = yw[q][j][t]; const f2v lo = __builtin_amdgcn_cvt_pk_f32_fp8(w, false), hi = __builtin_amdgcn_cvt_pk_f32_fp8(w, true); f.x += lo.x; f.y += lo.y; f.z += hi.x; f.w += hi.y; }
                fs[q][j] = make_float4(f.x * (1.f / YP8_SCALE), f.y * (1.f / YP8_SCALE), f.z * (1.f / YP8_SCALE), f.w * (1.f / YP8_SCALE)); }
        if (rp + step < nitem) { load_rows2(rp + step); if (rp + 2 * step < nitem) load_slots(rp + 2 * step); }
#pragma unroll 1
        for (int q = 0; q < 2; ++q) {
            const int row = row0 + q;
            float4 v[4]; float s = 0.f;
#pragma unroll
            for (int j = 0; j < 4; ++j) {
                const int k = 4 * lane + 256 * j;
                float4 f = q == 0 ? fs[0][j] : fs[1][j];
                const float4 a = q == 0 ? xa[0][j] : xa[1][j], g = *(const float4*)(g2 + k);
                v[j] = make_float4(ALPHA * a.x + g.x * f.x, ALPHA * a.y + g.y * f.y, ALPHA * a.z + g.z * f.z, ALPHA * a.w + g.w * f.w);
                s += (v[j].x + v[j].y) + (v[j].z + v[j].w);
            }
            const float mean = wave_sum(s) * (1.f / D); float s2 = 0.f;
#pragma unroll
            for (int j = 0; j < 4; ++j) { v[j].x -= mean; v[j].y -= mean; v[j].z -= mean; v[j].w -= mean; s2 += (v[j].x * v[j].x + v[j].y * v[j].y) + (v[j].z * v[j].z + v[j].w * v[j].w); }
            const float rstd = rsqrtf(wave_sum(s2) * (1.f / D) + LN_EPS);
#pragma unroll
            for (int j = 0; j < 4; ++j) {
                const int k = 4 * lane + 256 * j;
                const float4 g = *(const float4*)(lg + k), bb = *(const float4*)(lb + k);
                const float4 x2 = make_float4(v[j].x * rstd * g.x + bb.x, v[j].y * rstd * g.y + bb.y, v[j].z * rstd * g.z + bb.z, v[j].w * rstd * g.w + bb.w);
                if (L == 0) {
                    { uint2 xo; xo.x = pk2(x2.x, x2.y); xo.y = pk2(x2.z, x2.w); *(uint2*)(X2 + (size_t)row * D + k) = xo; }
                    const float4 b = *(const float4*)(modn + k), a = *(const float4*)(modn + 1024 + k);
                    *(unsigned*)(H8 + (size_t)row * D + k) = pk4_fp8(x2.x * (1.f + a.x) + b.x, x2.y * (1.f + a.y) + b.y, x2.z * (1.f + a.z) + b.z, x2.w * (1.f + a.w) + b.w);
                } else {
                    *(float4*)(p.out + (size_t)row * D + k) = x2;
                }
            }
        }
    }
}

namespace att {
typedef short bf16x8 __attribute__((ext_vector_type(8)));
typedef float f32x16 __attribute__((ext_vector_type(16)));
typedef unsigned u4v __attribute__((ext_vector_type(4)));
typedef unsigned u2v __attribute__((ext_vector_type(2)));
constexpr int KROWB = 144, VROWB = 136, KBUF = 64 * KROWB, VBUF = 128 * VROWB;
constexpr int L_K = 0, L_V = 4 * KBUF, L_BIAS = 4 * KBUF + 4 * VBUF, L_X = L_BIAS + 2048, L_END = L_X + 2048;
constexpr float LOG2E = 1.4426950408889634f, C2 = 0.125f * LOG2E, NEGBIG = -1e30f;
constexpr float THR_L2 = 8.0f;
__device__ __forceinline__ int crow(int r, int hi) { return (r & 3) + 8 * (r >> 2) + 4 * hi; }
__device__ __forceinline__ unsigned cvtpk(float lo, float hi) { unsigned r; asm volatile("v_cvt_pk_bf16_f32 %0, %1, %2" : "=v"(r) : "v"(lo), "v"(hi)); return r; }
__device__ __forceinline__ float xhalf_max(float v) { auto rr = __builtin_amdgcn_permlane32_swap(__float_as_uint(v), __float_as_uint(v), false, false); return fmaxf(__uint_as_float(rr[0]), __uint_as_float(rr[1])); }
__device__ __forceinline__ float xhalf_sum(float v) { auto rr = __builtin_amdgcn_permlane32_swap(__float_as_uint(v), __float_as_uint(v), false, false); return __uint_as_float(rr[0]) + __uint_as_float(rr[1]); }

template <int VR> struct TileRegs { u4v k; u4v v[VR / 64]; };
template <int VR>
__device__ __forceinline__ void tile_load(TileRegs<VR>& t, const bf16_t* Kh, const bf16_t* VTh, int pos0, int tid) {
    const int row = tid >> 3, ch = tid & 7;
    t.k = *(const u4v*)(Kh + (size_t)(pos0 + row) * 64 + ch * 8);
#pragma unroll
    for (int i = 0; i < VR / 64; ++i) t.v[i] = *(const u4v*)(VTh + (size_t)(row + 64 * i) * SP + pos0 + ch * 8);
}
template <int VR>
__device__ __forceinline__ void tile_store(const TileRegs<VR>& t, LAS unsigned char* lds, int buf, int tid) {
    const int row = tid >> 3, ch = tid & 7;
    *(LAS u4v*)(lds + L_K + buf * KBUF + row * KROWB + ch * 16) = t.k;
#pragma unroll
    for (int i = 0; i < VR / 64; ++i) {
        LAS u2v* d = (LAS u2v*)(lds + L_V + buf * VBUF + (row + 64 * i) * VROWB + ch * 16);
        d[0] = (u2v){t.v[i].x, t.v[i].y}; d[1] = (u2v){t.v[i].z, t.v[i].w};
    }
}

struct MaskArgs { int rq, cq; const LAS float* biasL; };

template <int MODE>
__device__ __forceinline__ void softmax_half(f32x16& p, bf16x8 (&pb)[2], f32x16 (&o)[2], float& m, float& l, bf16x8& qx, int kpos0  , bool lat, int qp, int rq, int cq, const LAS float* biasL, int hi) {
    float mx = NEGBIG;
#pragma unroll
    for (int r = 0; r < 16; ++r) {
        float t = p[r];
        if (MODE == 1) { if (lat) { const int dd = qp - (kpos0 + crow(r, hi)); if (dd > 128 || dd < -128) t = NEGBIG; } }
        if (MODE == 2) {
            if (lat) {
                const int krow = (kpos0 - 256) >> 6, kc = ((kpos0 - 256) & 63) + crow(r, hi);
                const int ws = min(max(cq - 8, 0), 48);
                const bool valid = (unsigned)(kc - ws) < 16u;
                const int dc = min(max(kc - cq + 15, 0), 30);
                const float bv = biasL[(krow - rq + 7) * 31 + dc];
                t = valid ? t + bv : NEGBIG; } }
        if (MODE != 0) p[r] = t;
        mx = fmaxf(mx, t);
    }
    mx = xhalf_max(mx);
    if (__any(mx > THR_L2)) {
        const float mn = bf2f(f2bf(m + fmaxf(mx, 0.f))), dl = mn - m, alpha = __builtin_amdgcn_exp2f(-dl);
        m = mn; l *= alpha;
#pragma unroll
        for (int dt = 0; dt < 2; ++dt)
#pragma unroll
            for (int r = 0; r < 16; ++r) o[dt][r] *= alpha;
#pragma unroll
        for (int r = 0; r < 16; ++r) p[r] -= dl;
        qx[0] = (short)(hi == 0 ? f2bf(-mn) : 0u);
    }
    float sum = 0.f;
#pragma unroll
    for (int r = 0; r < 16; ++r) { const float e = __builtin_amdgcn_exp2f(p[r]); p[r] = e; sum += e; }
    l += sum;
#pragma unroll
    for (int s = 0; s < 2; ++s) {
        const int s8 = s * 8;
        u4v w; w.x = cvtpk(p[s8 + 0], p[s8 + 1]); w.y = cvtpk(p[s8 + 2], p[s8 + 3]); w.z = cvtpk(p[s8 + 4], p[s8 + 5]); w.w = cvtpk(p[s8 + 6], p[s8 + 7]);
        pb[s] = __builtin_bit_cast(bf16x8, w);
    }
}

template <int VR, int MODE, bool QPROC = false>
__device__ __forceinline__ void attn_pass(LAS unsigned char* lds, const bf16_t* Qh, const bf16_t* Kh, const bf16_t* VTh, int qpw, int vrow, bool wave_on, int ta0, int na, int tb0, int nbt,
                                          f32x16 (&o)[2][2], float (&m)[2], float (&l)[2], int rq, const LAS float* biasL, const float* qw = nullptr, const float2* ROPE = nullptr) {
    int tid = threadIdx.x; asm volatile("" : "+v"(tid));
    const int lane = tid & 63, r32 = lane & 31, hi = lane >> 5;
    bf16x8 qf[2][4];
#pragma unroll
    for (int j = 0; j < 2; ++j)
#pragma unroll
        for (int ks = 0; ks < 4; ++ks) qf[j][ks] = *(const bf16x8*)(Qh + (size_t)(qpw + 32 * j + r32) * 64 + ks * 16 + hi * 8);
    if (QPROC) {
#pragma unroll
        for (int j = 0; j < 2; ++j) {
            float v[4][8]; float ss = 0.f;
#pragma unroll
            for (int ks = 0; ks < 4; ++ks)
#pragma unroll
                for (int e = 0; e < 8; ++e) { v[ks][e] = bf2f((unsigned short)qf[j][ks][e]); ss += v[ks][e] * v[ks][e]; }
            const float sc = rsqrtf(xhalf_sum(ss) * (1.f / 64.f) + RMS_EPS) * C2;
            const int t = qpw + 32 * j + r32 - 256;
#pragma unroll
            for (int ks = 0; ks < 4; ++ks) {
                const int d0 = 16 * ks + 8 * hi;
                const float4 w0 = *(const float4*)(qw + d0), w1 = *(const float4*)(qw + d0 + 4);
                const float4 c01 = *(const float4*)(ROPE + t * 32 + (d0 >> 1)), c23 = *(const float4*)(ROPE + t * 32 + (d0 >> 1) + 2);
                const float x0 = v[ks][0] * sc * w0.x, x1 = v[ks][1] * sc * w0.y, x2 = v[ks][2] * sc * w0.z, x3 = v[ks][3] * sc * w0.w;
                const float x4 = v[ks][4] * sc * w1.x, x5 = v[ks][5] * sc * w1.y, x6 = v[ks][6] * sc * w1.z, x7 = v[ks][7] * sc * w1.w;
                u4v w; w.x = cvtpk(x0 * c01.x - x1 * c01.y, x0 * c01.y + x1 * c01.x); w.y = cvtpk(x2 * c01.z - x3 * c01.w, x2 * c01.w + x3 * c01.z);
                w.z = cvtpk(x4 * c23.x - x5 * c23.y, x4 * c23.y + x5 * c23.x); w.w = cvtpk(x6 * c23.z - x7 * c23.w, x6 * c23.w + x7 * c23.z);
                qf[j][ks] = __builtin_bit_cast(bf16x8, w);
            }
        }
    }
    if (!QPROC) {
#pragma unroll
        for (int j = 0; j < 2; ++j)
#pragma unroll
            for (int ks = 0; ks < 4; ++ks) { u4v w;
#pragma unroll
                for (int e2 = 0; e2 < 4; ++e2) w[e2] = cvtpk(bf2f((unsigned short)qf[j][ks][2 * e2]) * C2, bf2f((unsigned short)qf[j][ks][2 * e2 + 1]) * C2);
                qf[j][ks] = __builtin_bit_cast(bf16x8, w); }
    }
    bf16x8 qx[2]; bf16x8 kone;
#pragma unroll
    for (int e = 0; e < 8; ++e) { qx[0][e] = 0; qx[1][e] = 0; kone[e] = 0; }
    kone[0] = (short)(hi == 0 ? 0x3f80 : 0);
#pragma unroll
    for (int j = 0; j < 2; ++j) {
        m[j] = 0.f; l[j] = 0.f;
#pragma unroll
        for (int dt = 0; dt < 2; ++dt)
#pragma unroll
            for (int r = 0; r < 16; ++r) o[j][dt][r] = 0.f;
    }
    const int n = na + nbt;
    TileRegs<VR> tr;
#define ATT_TPOS(i_) (((i_) < na ? ta0 + (i_) : tb0 + ((i_) - na)) * 64)
    {
        TileRegs<VR> tr1;
        tile_load<VR>(tr, Kh, VTh, ATT_TPOS(0), tid);
        if (n > 1) tile_load<VR>(tr1, Kh, VTh, ATT_TPOS(1), tid);
        tile_store<VR>(tr, lds, 0, tid);
        if (n > 1) tile_store<VR>(tr1, lds, 1, tid);
    }
    __syncthreads();
    for (int ip = 0; 2 * ip < n; ++ip) {
        const int cb = ip & 1;
#pragma unroll
        for (int h2 = 0; h2 < 2; ++h2) {
            const int i = 2 * ip + h2, inx = i + 2;
            if (inx < n) tile_load<VR>(tr, Kh, VTh, ATT_TPOS(inx), tid);
            if (i < n) {
                const int pos0 = ATT_TPOS(i), slot = 2 * cb + h2;
                bool active = wave_on;
                if (MODE == 1 && pos0 >= 256) active = active && (pos0 <= qpw + 63 + 128) && (pos0 + 63 >= qpw - 128);
                if (MODE == 2 && pos0 >= 256) { const int krow = (pos0 - 256) >> 6, rs = min(max(rq - 4, 0), 120); active = active && (krow >= rs) && (krow < rs + 8); }
        if (active) {
                    const LAS unsigned char* kb = lds + L_K + slot * KBUF;
                    const LAS unsigned char* vb = lds + L_V + slot * VBUF + vrow * VROWB;
        #pragma unroll
                    for (int kt = 0; kt < 2; ++kt) {
                        f32x16 p[2];
        #pragma unroll
                        for (int r = 0; r < 16; ++r) { p[0][r] = 0.f; p[1][r] = 0.f; }
        #pragma unroll
                        for (int ks = 0; ks < 4; ++ks) {
                            const bf16x8 a = *(const LAS bf16x8*)(kb + (32 * kt + r32) * KROWB + ks * 32 + hi * 16);
                            p[0] = __builtin_amdgcn_mfma_f32_32x32x16_bf16(a, qf[0][ks], p[0], 0, 0, 0);
                            p[1] = __builtin_amdgcn_mfma_f32_32x32x16_bf16(a, qf[1][ks], p[1], 0, 0, 0);
                        }
                        p[0] = __builtin_amdgcn_mfma_f32_32x32x16_bf16(kone, qx[0], p[0], 0, 0, 0);
                        p[1] = __builtin_amdgcn_mfma_f32_32x32x16_bf16(kone, qx[1], p[1], 0, 0, 0);
                        bf16x8 pb[2][2];
                        softmax_half<MODE>(p[0], pb[0], o[0], m[0], l[0], qx[0], pos0 + 32 * kt, pos0 >= 256, qpw + r32, rq, r32, biasL, hi);
                        softmax_half<MODE>(p[1], pb[1], o[1], m[1], l[1], qx[1], pos0 + 32 * kt, pos0 >= 256, qpw + 32 + r32, rq, 32 + r32, biasL, hi);
        #pragma unroll
                        for (int s = 0; s < 2; ++s)
        #pragma unroll
                            for (int dt = 0; dt < 2; ++dt) {
                                const int sp = 2 * kt + s;
                                const LAS unsigned char* vp = vb + (32 * dt + r32) * VROWB + (16 * sp + 4 * hi) * 2;
                                const u2v lo = *(const LAS u2v*)vp, hi2 = *(const LAS u2v*)(vp + 16);
                                const bf16x8 a = __builtin_bit_cast(bf16x8, (u4v){lo.x, lo.y, hi2.x, hi2.y});
                                o[0][dt] = __builtin_amdgcn_mfma_f32_32x32x16_bf16(a, pb[0][s], o[0][dt], 0, 0, 0);
                                o[1][dt] = __builtin_amdgcn_mfma_f32_32x32x16_bf16(a, pb[1][s], o[1][dt], 0, 0, 0);
                            }
                    }
                }
            }
            if (inx < n) tile_store<VR>(tr, lds, 2 * (cb ^ 1) + h2, tid);
        }
        __syncthreads();
    }
#undef ATT_TPOS
}

__device__ __forceinline__ void store_out(bf16_t* yrow  , const f32x16 (&o)[2], float sc, int hi) {
#pragma unroll
    for (int dt = 0; dt < 2; ++dt)
#pragma unroll
        for (int g = 0; g < 4; ++g) {
            uint2 w; w.x = cvtpk(o[dt][4 * g + 0] * sc, o[dt][4 * g + 1] * sc); w.y = cvtpk(o[dt][4 * g + 2] * sc, o[dt][4 * g + 3] * sc);
            *(uint2*)(yrow + 32 * dt + 8 * g + 4 * hi) = w;
        }
}
}


constexpr int BG_OFF = 110592;
__device__ __forceinline__ int bg_region(int w) { return w < 5 ? BG_OFF + w * 4096 : LDS_PAR + (w - 5) * 4096; }
constexpr int BG_SLOTS = 96, BG_VB = 256;
struct BgConv { int s, end; bool fly; const float* src; unsigned char* dst; };
__device__ __forceinline__ void bg_seek(const Params& p, BgConv& bg, int vb) {
    if (bg.s < 64) {
        const int n0 = (vb & 31) * 64, k0 = (vb >> 5) * 128, nn = n0 & 1023, drow = 256 * (nn >> 7) + (nn & 127) + (n0 >= 1024 ? 128 : 0);
        bg.src = p.moe_w_in + (size_t)bg.s * 1024 * 2048 + (size_t)k0 * 2048 + n0;
        bg.dst = p.ws + WS_WT_MIN + (size_t)bg.s * 2048 * 1024 + (size_t)drow * 1024 + k0;
    } else {
        const int le = 2 * (bg.s - 64) + (vb >> 7), q2 = vb & 127, n0 = (q2 & 15) * 64, k0 = (q2 >> 4) * 128;
        bg.src = p.moe_w_out + (size_t)le * 1024 * 1024 + (size_t)k0 * 1024 + n0;
        bg.dst = p.ws + WS_WT_MOUT + (size_t)le * 1024 * 1024 + (size_t)n0 * 1024 + k0;
    }
}
__device__ __forceinline__ void bg_start(LAS unsigned char* lds, BgConv& bg) {
    if (bg.s < bg.end) {
        int tid = threadIdx.x; asm volatile("" : "+v"(tid));
        const int lane = tid & 63, w = __builtin_amdgcn_readfirstlane(tid >> 6);
        const int sh = bg.s < 64 ? 11 : 10;
        bg.fly = true;
        const float* src = bg.src + (((size_t)(16 * w + (lane >> 4))) << sh) + 4 * (lane & 15);
        const unsigned l0 = __builtin_amdgcn_readfirstlane((unsigned)(size_t)(lds + bg_region(w)));
        const size_t st = (size_t)4 << sh;
        const float* s1 = src + st; const float* s2 = src + 2 * st; const float* s3 = src + 3 * st;
        asm volatile("s_mov_b32 m0, %4\n\ts_nop 0\n\tglobal_load_lds_dwordx4 %0, off\n\t"
                     "s_mov_b32 m0, %5\n\ts_nop 0\n\tglobal_load_lds_dwordx4 %1, off\n\t"
                     "s_mov_b32 m0, %6\n\ts_nop 0\n\tglobal_load_lds_dwordx4 %2, off\n\t"
                     "s_mov_b32 m0, %7\n\ts_nop 0\n\tglobal_load_lds_dwordx4 %3, off"
                     :: "v"(src), "v"(s1), "v"(s2), "v"(s3), "s"(l0), "s"(l0 + 1024u), "s"(l0 + 2048u), "s"(l0 + 3072u) : "m0", "memory");
    }
}
__device__ __forceinline__ void bg_finish(const Params& p, LAS unsigned char* lds, BgConv& bg, int vb) {
    if (bg.fly) {
        asm volatile("s_waitcnt vmcnt(0)" ::: "memory");
        int tid = threadIdx.x; asm volatile("" : "+v"(tid));
        const int lane = tid & 63, w = __builtin_amdgcn_readfirstlane(tid >> 6);
        const LAS float* sp = (const LAS float*)(lds + bg_region(w)) + lane;
        const float sc = bg.s < 64 ? W8_SCALE : W8O_SCALE;
        float v[16];
#pragma unroll
        for (int i = 0; i < 16; ++i) v[i] = sp[i * 64] * sc;
        uint4 o; o.x = pk4_fp8(v[0], v[1], v[2], v[3]); o.y = pk4_fp8(v[4], v[5], v[6], v[7]); o.z = pk4_fp8(v[8], v[9], v[10], v[11]); o.w = pk4_fp8(v[12], v[13], v[14], v[15]);
        *(uint4*)(bg.dst + (size_t)lane * 1024 + 16 * w) = o;
        asm volatile("s_waitcnt lgkmcnt(0)" ::: "memory");
        bg.fly = false; ++bg.s;
        if (bg.s == 64) bg_seek(p, bg, vb); else { bg.src += 2 * 1024 * 1024; bg.dst += 2 * 1024 * 1024; }
    }
}
namespace attd {
typedef short bf16x8 __attribute__((ext_vector_type(8)));
typedef float f32x16 __attribute__((ext_vector_type(16)));
typedef unsigned u4v __attribute__((ext_vector_type(4)));
typedef unsigned u2v __attribute__((ext_vector_type(2)));
constexpr int KROWB = 144, VROWB = 136, KBUF = 64 * KROWB, VBUF = 128 * VROWB;
constexpr int L_K = 0, L_V = 4 * KBUF, L_BIAS = 4 * KBUF + 4 * VBUF, L_END = L_BIAS + 2048;
constexpr float LOG2E = 1.4426950408889634f, C2 = 0.125f * LOG2E, NEGBIG = -1e30f;
__device__ __forceinline__ int crow(int r, int hi) { return (r & 3) + 8 * (r >> 2) + 4 * hi; }
__device__ __forceinline__ unsigned cvtpk(float lo, float hi) { unsigned r; asm volatile("v_cvt_pk_bf16_f32 %0, %1, %2" : "=v"(r) : "v"(lo), "v"(hi)); return r; }

template <int DV> struct TileRegs { u4v k; u4v v[DV / 64]; };
template <int DV>
__device__ __forceinline__ void tile_load(TileRegs<DV>& t, const bf16_t* Kh, const bf16_t* VTh, int pos0, int tid) {
    const int row = tid >> 3, ch = tid & 7;
    t.k = *(const u4v*)(Kh + (size_t)(pos0 + row) * 64 + ch * 8);
#pragma unroll
    for (int i = 0; i < DV / 64; ++i) t.v[i] = *(const u4v*)(VTh + (size_t)(row + 64 * i) * SP + pos0 + ch * 8);
}
template <int DV>
__device__ __forceinline__ void tile_store(const TileRegs<DV>& t, LAS unsigned char* lds, int kbuf, int vbuf, int tid) {
    const int row = tid >> 3, ch = tid & 7;
    *(LAS u4v*)(lds + L_K + kbuf * KBUF + row * KROWB + ch * 16) = t.k;
#pragma unroll
    for (int i = 0; i < DV / 64; ++i) {
        LAS u2v* d = (LAS u2v*)(lds + L_V + vbuf * VBUF + (row + 64 * i) * VROWB + ch * 16);
        d[0] = (u2v){t.v[i].x, t.v[i].y}; d[1] = (u2v){t.v[i].z, t.v[i].w};
    }
}

struct MaskArgs { int rq, cq; const LAS float* biasL; };
constexpr float THR_L2 = 8.0f;

__device__ __forceinline__ void qk_step(f32x16 (&p)[2], const LAS unsigned char* kb, const bf16x8 (&qf)[4], int r32, int hi) {
    constexpr int PF = 4;
    const LAS unsigned char* kp = kb + r32 * KROWB + hi * 16;
    auto ldk = [&](int g) -> bf16x8 { return *(const LAS bf16x8*)(kp + (32 * (g & 1)) * KROWB + (g >> 1) * 32); };
    bf16x8 fr[PF];
#pragma unroll
    for (int g = 0; g < PF; ++g) fr[g] = ldk(g);
#pragma unroll
    for (int kt = 0; kt < 2; ++kt)
#pragma unroll
        for (int r = 0; r < 16; ++r) p[kt][r] = 0.f;
#pragma unroll
    for (int g = 0; g < 8; ++g) {
        p[g & 1] = __builtin_amdgcn_mfma_f32_32x32x16_bf16(fr[g % PF], qf[g >> 1], p[g & 1], 0, 0, 0);
        if (g + PF < 8) fr[g % PF] = ldk(g + PF);
    }
    __builtin_amdgcn_sched_group_barrier(0x100, PF, 0);
#pragma unroll
    for (int g = 0; g < 8 - PF; ++g) { __builtin_amdgcn_sched_group_barrier(0x008, 1, 0); __builtin_amdgcn_sched_group_barrier(0x100, 1, 0); }
    __builtin_amdgcn_sched_group_barrier(0x008, PF, 0);
}
template <int DV, int MODE>
__device__ __forceinline__ void softmax_step(f32x16 (&p)[2], bf16x8 (&pb)[4], f32x16 (&o)[DV / 32], float& m, float& l, int pos0, int qp, const MaskArgs& ma, int hi) {
    constexpr float XS = (MODE == 2) ? 1.0f : C2;
    constexpr float THR = THR_L2 / XS;
    float mx; float mxp[4] = {NEGBIG, NEGBIG, NEGBIG, NEGBIG};
#pragma unroll
    for (int kt = 0; kt < 2; ++kt)
#pragma unroll
        for (int r = 0; r < 16; ++r) {
            float t = p[kt][r];
            if (MODE == 1) { if (pos0 >= 256) { const int dd = qp - (pos0 + 32 * kt + crow(r, hi)); if (dd > 128 || dd < -128) t = NEGBIG; } }
            if (MODE == 2) {
                t *= C2;
                if (pos0 >= 256) {
                    const int krow = (pos0 - 256) >> 6, kc = 32 * kt + crow(r, hi);
                    const int ws = min(max(ma.cq - 8, 0), 48);
                    const bool valid = (unsigned)(kc - ws) < 16u;
                    const int dc = min(max(kc - ma.cq + 15, 0), 30);
                    const float bv = ma.biasL[(krow - ma.rq + 7) * 31 + dc];
                    t = valid ? t + bv : NEGBIG; } }
            p[kt][r] = t; mxp[r & 3] = fmaxf(mxp[r & 3], t);
        }
    mx = fmaxf(fmaxf(mxp[0], mxp[1]), fmaxf(mxp[2], mxp[3]));
    { auto rr = __builtin_amdgcn_permlane32_swap(__float_as_uint(mx), __float_as_uint(mx), false, false);
      mx = fmaxf(__uint_as_float(rr[0]), __uint_as_float(rr[1])); }
    if (__any(mx > m + THR)) {
        const float mn = fmaxf(m, mx), alpha = __builtin_amdgcn_exp2f((m - mn) * XS);
        m = mn; l *= alpha;
#pragma unroll
        for (int dt = 0; dt < DV / 32; ++dt)
#pragma unroll
            for (int r = 0; r < 16; ++r) o[dt][r] *= alpha;
    }
    const float nm = -m * XS;
    float sm[4] = {0.f, 0.f, 0.f, 0.f};
#pragma unroll
    for (int kt = 0; kt < 2; ++kt)
#pragma unroll
        for (int r = 0; r < 16; ++r) { const float e = __builtin_amdgcn_exp2f(MODE == 2 ? p[kt][r] + nm : fmaf(p[kt][r], C2, nm)); p[kt][r] = e; sm[r & 3] += e; }
    l += (sm[0] + sm[1]) + (sm[2] + sm[3]);
#pragma unroll
    for (int sp = 0; sp < 4; ++sp) {
        const int kt = sp >> 1, s8 = (sp & 1) * 8;
        u4v w; w.x = cvtpk(p[kt][s8 + 0], p[kt][s8 + 1]); w.y = cvtpk(p[kt][s8 + 2], p[kt][s8 + 3]); w.z = cvtpk(p[kt][s8 + 4], p[kt][s8 + 5]); w.w = cvtpk(p[kt][s8 + 6], p[kt][s8 + 7]);
        pb[sp] = __builtin_bit_cast(bf16x8, w);
    }
}
template <int DV>
__device__ __forceinline__ void pv_step(f32x16 (&o)[DV / 32], const LAS unsigned char* vb, const bf16x8 (&pb)[4], int r32, int hi) {
    constexpr int NF = (DV / 32) * 4, PF = 4;
    const LAS unsigned char* vp0 = vb + r32 * VROWB + (4 * hi) * 2;
    auto ldf = [&](int g) -> u4v { const int dt = g & 3, sp = g >> 2; const LAS unsigned char* vp = vp0 + (32 * dt) * VROWB + (16 * sp) * 2;
        const u2v lo = *(const LAS u2v*)vp, hi2 = *(const LAS u2v*)(vp + 16); return (u4v){lo.x, lo.y, hi2.x, hi2.y}; };
    u4v fr[PF];
#pragma unroll
    for (int g = 0; g < PF; ++g) fr[g] = ldf(g);
#pragma unroll
    for (int g = 0; g < NF; ++g) {
        const int dt = g & 3, sp = g >> 2;
        o[dt] = __builtin_amdgcn_mfma_f32_32x32x16_bf16(__builtin_bit_cast(bf16x8, fr[g % PF]), pb[sp], o[dt], 0, 0, 0);
        if (g + PF < NF) fr[g % PF] = ldf(g + PF);
    }
    __builtin_amdgcn_sched_group_barrier(0x100, PF, 0);
#pragma unroll
    for (int g = 0; g < NF - PF; ++g) { __builtin_amdgcn_sched_group_barrier(0x008, 1, 0); __builtin_amdgcn_sched_group_barrier(0x100, 1, 0); }
    __builtin_amdgcn_sched_group_barrier(0x008, PF, 0);
}

template <int DV, int MODE, int PINGPONG = 1>
__device__ __forceinline__ void attn_pass(LAS unsigned char* lds, const bf16_t* Qh, const bf16_t* Kh, const bf16_t* VTh, int qpos0, int ta0, int na, int tb0, int nbt,
                                          f32x16 (&o)[DV / 32], float& m, float& l, const MaskArgs& ma, const float* qnorm_w, const Params& prm, BgConv& bg, int bid, int nb) {
    int tid = threadIdx.x; asm volatile("" : "+v"(tid));
    const int lane = tid & 63, w = __builtin_amdgcn_readfirstlane(tid >> 6), r32 = lane & 31, hi = lane >> 5;
    const int qp = qpos0 + 32 * w + r32;
    bf16x8 qf[4];
#pragma unroll
    for (int ks = 0; ks < 4; ++ks) qf[ks] = *(const bf16x8*)(Qh + (size_t)qp * 64 + ks * 16 + hi * 8);
#pragma unroll
    for (int dt = 0; dt < DV / 32; ++dt)
#pragma unroll
        for (int r = 0; r < 16; ++r) o[dt][r] = 0.f;
    m = NEGBIG; l = 0.f;
    const int n = na + nbt;
    TileRegs<DV> tr, tr1;
#define ATT_TPOS(i_) (((i_) < na ? ta0 + (i_) : tb0 + ((i_) - na)) * 64)
    static_assert(PINGPONG == 0, "the pair loop is the in-step form");
    tile_load<DV>(tr, Kh, VTh, ATT_TPOS(0), tid);
    if (n > 1) tile_load<DV>(tr1, Kh, VTh, ATT_TPOS(1), tid);
    tile_store<DV>(tr, lds, 0, 0, tid);
    if (n > 1) tile_store<DV>(tr1, lds, 1, 1, tid);
    __syncthreads();
    const int qlo = qpos0 + 32 * w;
    f32x16 p[2]; bf16x8 pb[4];
    for (int ip = 0; 2 * ip < n; ++ip) {
        const int cb = ip & 1, i0 = 2 * ip + 2;
        if (i0 < n) tile_load<DV>(tr, Kh, VTh, ATT_TPOS(i0), tid);
        if (i0 + 1 < n) tile_load<DV>(tr1, Kh, VTh, ATT_TPOS(i0 + 1), tid);
        bg_start(lds, bg);
#pragma unroll
        for (int h2 = 0; h2 < 2; ++h2) {
            const int i = 2 * ip + h2;
            if (i < n) {
                const int pos0 = ATT_TPOS(i), slot = 2 * cb + h2;
                bool active = true;
                if (MODE == 1 && pos0 >= 256) active = (pos0 <= qlo + 31 + 128) && (pos0 + 63 >= qlo - 128);
                if (MODE == 2 && pos0 >= 256) { const int krow = (pos0 - 256) >> 6, rs = min(max(ma.rq - 4, 0), 120); active = (krow >= rs) && (krow < rs + 8); }
                if (active) {
                    qk_step(p, lds + L_K + slot * KBUF, qf, r32, hi);
                    softmax_step<DV, MODE>(p, pb, o, m, l, pos0, qp, ma, hi);
                    pv_step<DV>(o, lds + L_V + slot * VBUF, pb, r32, hi);
                }
            }
        }
        if (i0 < n) tile_store<DV>(tr, lds, 2 * (cb ^ 1), 2 * (cb ^ 1), tid);
        if (i0 + 1 < n) tile_store<DV>(tr1, lds, 2 * (cb ^ 1) + 1, 2 * (cb ^ 1) + 1, tid);
        __syncthreads();
        bg_finish(prm, lds, bg, bid);
    }
#undef ATT_TPOS
}

template <int DV>
__device__ __forceinline__ void store_out(bf16_t* yrow  , const f32x16 (&o)[DV / 32], float sc, int hi) {
#pragma unroll
    for (int dt = 0; dt < DV / 32; ++dt)
#pragma unroll
        for (int g = 0; g < 4; ++g) {
            uint2 w; w.x = cvtpk(o[dt][4 * g + 0] * sc, o[dt][4 * g + 1] * sc); w.y = cvtpk(o[dt][4 * g + 2] * sc, o[dt][4 * g + 3] * sc);
            *(uint2*)(yrow + 32 * dt + 8 * g + 4 * hi) = w;
        }
}
}
__device__ __forceinline__ void diff_unit(const Params& p, LAS unsigned char* lds, int b, int hd, int qpos0, int ntile_a, size_t yrow0, int scr_unit, BgConv& bg, int bid, int nb) {
    const bf16_t* Q = (const bf16_t*)(p.ws + WS_Q); const bf16_t* Kb = (const bf16_t*)(p.ws + WS_K); const bf16_t* VT = (const bf16_t*)(p.ws + WS_VT);
    const bf16_t* VTh = VT + ((size_t)b * 1024 + 512 + hd * 128) * SP;
    attd::MaskArgs ma{0, 0, nullptr};
    attd::f32x16 o[4]; float m, l;
    attd::attn_pass<128, 0, 0>(lds, Q + (size_t)(b * NQH + 8 + 2 * hd) * SP * 64, Kb + (size_t)(b * 16 + 8 + 2 * hd) * SP * 64, VTh, qpos0, 0, ntile_a, 0, 0, o, m, l, ma, nullptr, p, bg, bid, nb);
    { int t1 = threadIdx.x; asm volatile("" : "+v"(t1));
      float4* SCR = (float4*)(p.ws + WS_SCR) + ((size_t)(scr_unit * 8 + (t1 >> 6)) * 16) * 64 + (t1 & 63);
      float lt = l; { auto rr = __builtin_amdgcn_permlane32_swap(__float_as_uint(lt), __float_as_uint(lt), false, false); lt = __uint_as_float(rr[0]) + __uint_as_float(rr[1]); }
      const float il = 1.f / lt;
#pragma unroll
      for (int dt = 0; dt < 4; ++dt)
#pragma unroll
          for (int g = 0; g < 4; ++g) SCR[(dt * 4 + g) * 64] = make_float4(o[dt][4 * g] * il, o[dt][4 * g + 1] * il, o[dt][4 * g + 2] * il, o[dt][4 * g + 3] * il); }
    attd::attn_pass<128, 0, 0>(lds, Q + (size_t)(b * NQH + 8 + 2 * hd + 1) * SP * 64, Kb + (size_t)(b * 16 + 8 + 2 * hd + 1) * SP * 64, VTh, qpos0, 0, ntile_a, 0, 0, o, m, l, ma, nullptr, p, bg, bid, nb);
    int t2 = threadIdx.x; asm volatile("" : "+v"(t2));
    const int lane = t2 & 63, w = t2 >> 6, r32 = lane & 31, hi = lane >> 5;
    const float4* SCR = (const float4*)(p.ws + WS_SCR) + ((size_t)(scr_unit * 8 + w) * 16) * 64 + lane;
    const float lam = ((const float*)(p.ws + WS_SCAL))[0];
    float lt = l; { auto rr = __builtin_amdgcn_permlane32_swap(__float_as_uint(lt), __float_as_uint(lt), false, false); lt = __uint_as_float(rr[0]) + __uint_as_float(rr[1]); }
    const float il2 = lam / lt;
    float ss = 0.f;
#pragma unroll
    for (int dt = 0; dt < 4; ++dt)
#pragma unroll
        for (int g = 0; g < 4; ++g) {
            const float4 a = SCR[(dt * 4 + g) * 64];
            o[dt][4 * g] = a.x - o[dt][4 * g] * il2; o[dt][4 * g + 1] = a.y - o[dt][4 * g + 1] * il2; o[dt][4 * g + 2] = a.z - o[dt][4 * g + 2] * il2; o[dt][4 * g + 3] = a.w - o[dt][4 * g + 3] * il2;
            ss += o[dt][4 * g] * o[dt][4 * g] + o[dt][4 * g + 1] * o[dt][4 * g + 1] + o[dt][4 * g + 2] * o[dt][4 * g + 2] + o[dt][4 * g + 3] * o[dt][4 * g + 3];
        }
    { auto rr = __builtin_amdgcn_permlane32_swap(__float_as_uint(ss), __float_as_uint(ss), false, false); ss = __uint_as_float(rr[0]) + __uint_as_float(rr[1]); }
    const float sc = rsqrtf(ss * (1.f / 128.f) + RMS_EPS) * 0.8f;
    bf16_t* yrow = (bf16_t*)(p.ws + WS_Y) + (yrow0 + 32 * w + r32) * D + 512 + hd * 128;
#pragma unroll
    for (int dt = 0; dt < 4; ++dt)
#pragma unroll
        for (int g = 0; g < 4; ++g) {
            const int d0 = 32 * dt + 8 * g + 4 * hi;
            const float4 sw = *(const float4*)(p.subln + d0);
            uint2 wv; wv.x = attd::cvtpk(o[dt][4 * g] * sc * sw.x, o[dt][4 * g + 1] * sc * sw.y); wv.y = attd::cvtpk(o[dt][4 * g + 2] * sc * sw.z, o[dt][4 * g + 3] * sc * sw.w);
            *(uint2*)(yrow + d0) = wv;
        }
}
__device__ __forceinline__ void phase_attn0(const Params& p, int bid, int nb, unsigned char* smem) {
    LAS unsigned char* lds = (LAS unsigned char*)smem;
    const bf16_t* Q = (const bf16_t*)(p.ws + WS_Q); const bf16_t* Kb = (const bf16_t*)(p.ws + WS_K); const bf16_t* VT = (const bf16_t*)(p.ws + WS_VT);
    bf16_t* Y = (bf16_t*)(p.ws + WS_Y);
    constexpr int U_B = 256, U_A = 256, U_C = 16, U_D = 8;
    BgConv bg; bg.s = 0; bg.end = bid < BG_VB ? BG_SLOTS : 0; bg.fly = false; bg_seek(p, bg, bid);
    for (int u = bid; u < U_B; u += nb) {
        const int qb = u >> 3, hd = u & 3, b = (u >> 2) & 1;
        diff_unit(p, lds, b, hd, 256 + 256 * qb, SP / 64, (size_t)b * S + 256 * qb, u, bg, bid, nb);
    }
    for (int u2 = bid; u2 < U_A; u2 += nb) {
        int tid = threadIdx.x; asm volatile("" : "+v"(tid));
        const int lane = tid & 63, r32 = lane & 31, hi = lane >> 5; const int w = __builtin_amdgcn_readfirstlane(tid >> 6);
        const int qb = u2 & 15, h = (u2 >> 4) & 7, b = u2 >> 7;
        LAS float* biasL = (LAS float*)(lds + att::L_BIAS);
        for (int i = tid; i < 15 * 31; i += blockDim.x) biasL[i] = p.na_rpb[h * 465 + i] * att::LOG2E;
        const int r0 = 8 * qb;
        const int tb0 = 4 + min(max(r0 - 4, 0), 120), tb1 = 4 + min(max(r0 + 3, 0), 120) + 8;
        att::f32x16 o[2][2]; float m[2], l[2];
        att::attn_pass<64, 2>(lds, Q + (size_t)(b * NQH + h) * SP * 64, Kb + (size_t)(b * 16 + h) * SP * 64, VT + ((size_t)b * 1024 + h * 64) * SP, 256 + 512 * qb + 64 * w, 0, true, 0, 4, tb0, tb1 - tb0, o, m, l, r0 + w, biasL);
#pragma unroll
        for (int j = 0; j < 2; ++j) att::store_out(Y + ((size_t)b * S + 512 * qb + 64 * w + 32 * j + r32) * D + h * 64, o[j], 1.f / att::xhalf_sum(l[j]), hi);
    }
    const bool edge = (bid & 15) == 0 || (bid & 15) == 15;
    const int vfirst = nb == 256 ? (edge ? (bid >> 4) * 2 + ((bid & 15) == 15 ? 1 : 0) : U_C + U_D) : bid, vstep = nb == 256 ? U_C + U_D : nb;
    for (int u2 = vfirst; u2 < U_C; u2 += vstep) {
        int tid = threadIdx.x; asm volatile("" : "+v"(tid));
        const int lane = tid & 63, r32 = lane & 31, hi = lane >> 5; const int w = __builtin_amdgcn_readfirstlane(tid >> 6);
        const int h = u2 & 7, b = u2 >> 3;
        att::f32x16 o[2][2]; float m[2], l[2];
        att::attn_pass<64, 0>(lds, Q + (size_t)(b * NQH + h) * SP * 64, Kb + (size_t)(b * 16 + h) * SP * 64, VT + ((size_t)b * 1024 + h * 64) * SP, 64 * (w & 3), 0, w < 4, 0, 4, 0, 0, o, m, l, 0, nullptr);
        if (w < 4) {
#pragma unroll
            for (int j = 0; j < 2; ++j) att::store_out(Y + ((size_t)NLAT + b * CTX + 64 * w + 32 * j + r32) * D + h * 64, o[j], 1.f / att::xhalf_sum(l[j]), hi);
        }
    }
    for (int v2 = vfirst; v2 < U_C + U_D; v2 += vstep) {
        if (v2 < U_C) continue;
        const int u2 = v2 - U_C, hd = u2 & 3, b = u2 >> 2;
        diff_unit(p, lds, b, hd, 0, 4, (size_t)NLAT + b * CTX, U_B + u2, bg, bid, nb);
    }
    while (bg.s < bg.end) { bg_start(lds, bg); bg_finish(p, lds, bg, bid); }
    for (int vb = bid + nb; vb < BG_VB; vb += nb) { bg.s = 0; bg.end = BG_SLOTS; bg_seek(p, bg, vb); while (bg.s < bg.end) { bg_start(lds, bg); bg_finish(p, lds, bg, vb); } }
}
__device__ __forceinline__ void phase_attn1(const Params& p, int bid, int nb, unsigned char* smem) {
    LAS unsigned char* lds = (LAS unsigned char*)smem;
    const bf16_t* Q = (const bf16_t*)(p.ws + WS_Q); const bf16_t* Kb = (const bf16_t*)(p.ws + WS_K); const bf16_t* VT = (const bf16_t*)(p.ws + WS_VT);
    bf16_t* Y = (bf16_t*)(p.ws + WS_Y);
    for (int u = bid; u < 256; u += nb) {
        int tid = threadIdx.x; asm volatile("" : "+v"(tid));
        const int lane = tid & 63, r32 = lane & 31, hi = lane >> 5; const int w = __builtin_amdgcn_readfirstlane(tid >> 6);
        att::f32x16 o[2][2]; float m[2], l[2];
        const int xc = (u & 7) >> 1, idx = (u & 1) * 32 + (u >> 3);
        const int b = xc >> 1, qh = (xc & 1) * 4 + (idx >> 4), qb = idx & 15;
        att::attn_pass<64, 0, true>(lds, Q + (size_t)(b * NQH + qh) * SP * 64, Kb + (size_t)(b * 4 + (qh >> 2)) * SP * 64, VT + ((size_t)b * 256 + (qh >> 2) * 64) * SP, 256 + 512 * qb + 64 * w, 0, true, 0, SP / 64, 0, 0, o, m, l, 0, nullptr, p.q_norm, (const float2*)(p.ws + WS_ROPE));
#pragma unroll
        for (int j = 0; j < 2; ++j) att::store_out(Y + ((size_t)b * S + 512 * qb + 64 * w + 32 * j + r32) * D + qh * 64, o[j], 1.f / att::xhalf_sum(l[j]), hi);
    }
    for (int u2 = bid; u2 < 256; u2 += nb) {
        int tid = threadIdx.x; asm volatile("" : "+v"(tid));
        const int lane = tid & 63, r32 = lane & 31, hi = lane >> 5; const int w = __builtin_amdgcn_readfirstlane(tid >> 6);
        att::f32x16 o[2][2]; float m[2], l[2];
        const int qb = u2 & 15, qh = (u2 >> 4) & 7, b = u2 >> 7;
        const int t0 = 512 * qb;
        const int tb0 = 4 + max(t0 - 128, 0) / 64, tb1 = 4 + min(t0 + 511 + 128, S - 1) / 64 + 1;
        att::attn_pass<64, 1>(lds, Q + (size_t)(b * NQH + 8 + qh) * SP * 64, Kb + (size_t)(b * 4 + 2 + (qh >> 2)) * SP * 64, VT + ((size_t)b * 256 + 128 + (qh >> 2) * 64) * SP, 256 + t0 + 64 * w, 0, true, 0, 4, tb0, tb1 - tb0, o, m, l, 0, nullptr);
        const float sk = p.sink[qh] * att::LOG2E;
#pragma unroll
        for (int j = 0; j < 2; ++j) {
            const float lt = att::xhalf_sum(l[j]), ml2 = m[j];
            const float mn = fmaxf(ml2, sk), corr = __builtin_amdgcn_exp2f(ml2 - mn);
            const float den = lt * corr + __builtin_amdgcn_exp2f(sk - mn);
            att::store_out(Y + ((size_t)b * S + t0 + 64 * w + 32 * j + r32) * D + 512 + qh * 64, o[j], corr / den, hi);
        }
    }
}
#define XB_TMO      128
#define XB_XCNT(j)  (256  + 64 * (j))
#define XB_XSUB(j)  (1280 + 64 * (j))
#define XB_XGEN(j)  (2304 + 64 * (j))
#define XB_TOP      3328
#define XB_TOPGEN   3392
#define XCD_BAR_WORDS 3456
#define XB_SPIN_CAP (1u << 18)

__device__ __forceinline__ unsigned xb_ld(unsigned* p)              { return __hip_atomic_load(p, __ATOMIC_RELAXED, __HIP_MEMORY_SCOPE_AGENT); }
__device__ __forceinline__ unsigned xb_add(unsigned* p, unsigned v) { return __hip_atomic_fetch_add(p, v, __ATOMIC_RELAXED, __HIP_MEMORY_SCOPE_AGENT); }
__device__ __forceinline__ unsigned xb_xcc_id() { return (unsigned)__builtin_amdgcn_s_getreg((3 << 11) | 20) & 0xFu; }
#define XB_SPIN(cond, bar) do { unsigned _sp = 0; while (cond) { __builtin_amdgcn_s_sleep(1); \
    if ((++_sp & 255u) == 0u) { if (xb_ld(&(bar)[XB_TMO])) break; if (_sp > XB_SPIN_CAP) { atomicAdd(&(bar)[XB_TMO], 1u); break; } } } } while (0)

struct XcdBarrier {
    unsigned* bar; unsigned x;
    volatile LAS unsigned* st;
};

__device__ __forceinline__ XcdBarrier xcd_barrier_post(unsigned* bar, volatile LAS unsigned* st) {
    XcdBarrier b; b.bar = bar; b.x = xb_xcc_id(); b.st = st;
    if (threadIdx.x == 0) (void)xb_add(&bar[XB_XCNT(b.x)], 1u);
    return b;
}
__device__ __forceinline__ void xcd_barrier_complete(unsigned* bar, unsigned x, unsigned& nloc, unsigned& nx) {
    const unsigned G = gridDim.x * gridDim.y * gridDim.z;
    unsigned sum, cnt, mine, sp = 0u;
    for (;;) {
        sum = 0u; cnt = 0u; mine = 0u;
#pragma unroll
        for (unsigned j = 0; j < 16; ++j) { const unsigned c = xb_ld(&bar[XB_XCNT(j)]); sum += c; cnt += (c > 0u) ? 1u : 0u; mine = (j == x) ? c : mine; }
        if (sum == G) break;
        __builtin_amdgcn_s_sleep(1);
        if ((++sp & 255u) == 0u) { if (xb_ld(&bar[XB_TMO])) break; if (sp > XB_SPIN_CAP) { atomicAdd(&bar[XB_TMO], 1u); break; } }
    }
    nloc = mine > 0u ? mine : 1u; nx = cnt > 0u ? cnt : 1u;
}

__device__ __forceinline__ void xcd_barrier(const XcdBarrier& b) {
    asm volatile("s_waitcnt vmcnt(0)" ::: "memory");
    __syncthreads();
    if (threadIdx.x == 0) {
        unsigned* bar = b.bar;
        __builtin_amdgcn_s_waitcnt(0);
        unsigned nloc = b.st[0], nx = b.st[1];
        if (nloc == 0u) { xcd_barrier_complete(bar, b.x, nloc, nx); b.st[0] = nloc; b.st[1] = nx; }
        const unsigned old = xb_add(&bar[XB_XSUB(b.x)], 1u);
        const unsigned gen = old / nloc;
        if (old + 1u == (gen + 1u) * nloc) {
            __builtin_amdgcn_fence(__ATOMIC_RELEASE, "agent");
            asm volatile("s_waitcnt vmcnt(0)" ::: "memory");
            const unsigned og = xb_add(&bar[XB_TOP], 1u);
            const unsigned tg = og / nx;
            if (og + 1u == (tg + 1u) * nx) xb_add(&bar[XB_TOPGEN], 1u);
            else XB_SPIN(xb_ld(&bar[XB_TOPGEN]) == tg, bar);
            __builtin_amdgcn_fence(__ATOMIC_ACQUIRE, "agent");
            xb_add(&bar[XB_XGEN(b.x)], 1u);
            asm volatile("s_waitcnt vmcnt(0)" ::: "memory");
        } else {
            XB_SPIN(xb_ld(&bar[XB_XGEN(b.x)]) == gen, bar);
            __builtin_amdgcn_fence(__ATOMIC_ACQUIRE, "agent");
            asm volatile("s_waitcnt vmcnt(0)" ::: "memory");
        }
    }
    __syncthreads();
}

constexpr int NPHASE = 2 + 9 * 2;
constexpr int NTH = 512;
constexpr int PROBE_DUP = -1;
constexpr int CTL_BAR_WORD = 4096;
constexpr int CTL_BYTES = 65536;
template <bool COOP>
__global__ void __launch_bounds__(NTH, 2) fwd_kernel(Params p, int lo, int hi) {
    extern __shared__ __attribute__((aligned(16))) unsigned char smem[];
    const int bid = blockIdx.x, nb = gridDim.x;
    XcdBarrier bar; bar.bar = nullptr; bar.x = 0; bar.st = nullptr;
    if (COOP) {
        volatile LAS unsigned* st = (volatile LAS unsigned*)((LAS unsigned char*)smem + LDS_MISC + 2048);
        if (threadIdx.x < 2) st[threadIdx.x] = 0u;
        __syncthreads();
        if (bid == 0) { uint4* z = (uint4*)(p.ws + WS_CTL); for (int i = threadIdx.x; i < CTL_BYTES / 16; i += NTH) z[i] = make_uint4(0u, 0u, 0u, 0u); }
    }
#define SEAM(k) do { if (COOP) { if ((k) == 0) { cg::this_grid().sync(); bar = xcd_barrier_post((unsigned*)(p.ws + WS_CTL) + CTL_BAR_WORD, (volatile LAS unsigned*)((LAS unsigned char*)smem + LDS_MISC + 2048)); } else xcd_barrier(bar); } } while (0)
#define RUN(k, stmt) if (lo <= (k) && (k) < hi) { stmt; if (PROBE_DUP == (k)) { SEAM(1); stmt; } if ((k) + 1 < hi) SEAM(k); }
    RUN(0, phase_pre(p, bid, nb, smem))
    RUN(1, phase_h0(p, bid, nb))
    RUN(2, phase_qkv(p, 0, bid, nb, smem))
    RUN(4, phase_attn0(p, bid, nb, smem))
    RUN(5, { phase_oproj(p, 0, bid, nb, smem); phase_ln1(p, 0, bid, nb, smem); })
    RUN(8, phase_moe1(p, 0, bid, nb, smem))
    RUN(9, phase_moe2(p, 0, bid, nb, smem))
    RUN(10, phase_ln2(p, 0, bid, nb))
    RUN(11, phase_qkv(p, 1, bid, nb, smem))
    RUN(12, phase_knorm(p, bid, nb))
    RUN(13, phase_attn1(p, bid, nb, smem))
    RUN(14, { phase_oproj(p, 1, bid, nb, smem); phase_ln1(p, 1, bid, nb, smem); })
    RUN(17, phase_moe1(p, 1, bid, nb, smem))
    RUN(18, phase_moe2(p, 1, bid, nb, smem))
    RUN(19, phase_ln2(p, 1, bid, nb))
#undef RUN
#undef SEAM
}

extern "C" void kernel_launch(void* const* d_in, const int* in_sizes, int n_in, void* d_out, int out_size, void* d_ws, size_t ws_size, hipStream_t stream) {
    static int grid = 0;
    if (grid == 0) {
        if (n_in != 29 || ws_size < WS_END) { fprintf(stderr, "kernel_launch: unexpected n_in %d / ws %zu (need %zu)\n", n_in, ws_size, (size_t)WS_END); grid = -1; return; }
        int dev = 0, cus = 0, per_cu = 0;
        (void)hipGetDevice(&dev); (void)hipDeviceGetAttribute(&cus, hipDeviceAttributeMultiprocessorCount, dev);
        if (hipFuncSetAttribute((const void*)fwd_kernel<true>, hipFuncAttributeMaxDynamicSharedMemorySize, LDS_TOTAL) != hipSuccess) { fprintf(stderr, "kernel_launch: hipFuncSetAttribute failed\n"); grid = -1; return; }
        if (hipOccupancyMaxActiveBlocksPerMultiprocessor(&per_cu, (const void*)fwd_kernel<true>, NTH, LDS_TOTAL) != hipSuccess || per_cu < 1) { fprintf(stderr, "kernel_launch: occupancy query says %d\n", per_cu); per_cu = 1; }
        grid = cus;
        (void)hipGetLastError();
    }
    if (grid < 0) return;
    Params p{};
    const float* const* in = (const float* const*)d_in;
    p.x = in[0]; p.c = in[1]; p.ctx = in[2]; p.c_ctx = in[3]; p.mod_w = in[4]; p.mod_b = in[5]; p.ln1_g = in[6]; p.ln1_b = in[7]; p.ln2_g = in[8]; p.ln2_b = in[9];
    p.router_w = in[10]; p.router_b = in[11]; p.moe_w_in = in[12]; p.moe_b_in = in[13]; p.moe_w_out = in[14]; p.moe_b_out = in[15]; p.ab_w_in = in[16]; p.ab_w_out = in[17];
    p.na_rpb = in[18]; p.lq1 = in[19]; p.lk1 = in[20]; p.lq2 = in[21]; p.lk2 = in[22]; p.subln = in[23]; p.cd_w_in = in[24]; p.cd_w_out = in[25]; p.q_norm = in[26]; p.k_norm = in[27]; p.sink = in[28];
    p.out = (float*)d_out; p.ws = (unsigned char*)d_ws;
    int lo = 0, hi = NPHASE;
    void* args[] = {(void*)&p, (void*)&lo, (void*)&hi};
    hipError_t e = hipLaunchCooperativeKernel((const void*)fwd_kernel<true>, dim3(grid), dim3(NTH), args, LDS_TOTAL, stream);
    if (e != hipSuccess) fprintf(stderr, "kernel_launch: cooperative launch failed: %s (grid %d)\n", hipGetErrorString(e), grid);
}
```
